# Optimizing an MI355X kernel written in HIP

```python
import math
import jax
import jax.numpy as jnp
from jax import lax
import numpy as np

D_MODEL = 1024
BATCH = 4
SEQ = 8192
DEPTH = 1

GRID_W = 64
CTX_LEN = 256
EPS = 1e-6

GLA_HEADS = 4
GLA_DK = 64
GLA_DV = 128
GLA_QK = GLA_HEADS * GLA_DK
GLA_V = GLA_HEADS * GLA_DV
GLA_RANK = 16
GLA_GATE_NORM = 16.0
GLA_CHUNK = 16

SSD_HEADDIM = 64
SSD_INNER = 512
SSD_HEADS = SSD_INNER // SSD_HEADDIM
SSD_GROUPS = 2
SSD_HEADS_PER_GROUP = SSD_HEADS // SSD_GROUPS
SSD_STATE = 128
SSD_CHUNK = 128
SSD_CONV_DIM = SSD_INNER + 2 * SSD_GROUPS * SSD_STATE
SSD_CONV_K = 3

MIX_WIDTH = GLA_V + SSD_INNER

IN_SPLITS = (GLA_QK, GLA_QK, GLA_V, GLA_V, GLA_RANK, SSD_INNER, SSD_CONV_DIM, SSD_HEADS)
IN_DIM = sum(IN_SPLITS)
IN_OFFSETS = tuple(int(o) for o in np.cumsum(IN_SPLITS)[:-1])

N_EXPERTS = 32
TOP_K = 4
D_FF = 1024
SWIGLU_LIMIT = 7.0
SWIGLU_ALPHA = 1.702
MOE_BLOCK = 256

kernel_name = "hybrid_gla_ssd_moe_prefix_dit"


def rmsnorm(x, w):
    x32 = x.astype(jnp.float32)
    y = x32 * lax.rsqrt(jnp.mean(x32 * x32, axis=-1, keepdims=True) + EPS)
    return (y * w.astype(jnp.float32)).astype(x.dtype)


def modulate(h, shift, scale):
    return h * (1.0 + scale) + shift


def _identity(a):
    return a


def _flip(a):
    return jnp.flip(a, axis=1)


def gla_scan(q, k, v, log_a, s0):
    Bsz, L, H, DK = q.shape
    DV = v.shape[-1]
    C = GLA_CHUNK
    n = L // C
    qc = q.reshape(Bsz, n, C, H, DK).astype(jnp.float32)
    kc = k.reshape(Bsz, n, C, H, DK).astype(jnp.float32)
    vc = v.reshape(Bsz, n, C, H, DV).astype(jnp.float32)
    b = jnp.cumsum(log_a.reshape(Bsz, n, C, H, DK).astype(jnp.float32), axis=2)
    b_last = b[:, :, -1]
    mask = jnp.tril(jnp.ones((C, C), dtype=bool))[:, :, None, None]
    decay = jnp.exp(jnp.where(mask, b[:, :, :, None] - b[:, :, None], -jnp.inf))
    scores = jnp.einsum('bnihd,bnijhd,bnjhd->bnhij', qc, decay, kc)
    o_intra = jnp.einsum('bnhij,bnjhv->bnihv', scores, vc)
    q_dec = qc * jnp.exp(b)
    k_dec = kc * jnp.exp(b_last[:, :, None] - b)
    u = jnp.einsum('bnjhd,bnjhv->bnhdv', k_dec, vc)

    def step(S, inp):
        qd, uc, a_tot = inp
        o = jnp.einsum('bihd,bhdv->bihv', qd, S)
        return S * a_tot[..., None] + uc, o

    s_fin, o_inter = lax.scan(step, s0, (jnp.moveaxis(q_dec, 1, 0), jnp.moveaxis(u, 1, 0),
                                         jnp.moveaxis(jnp.exp(b_last), 1, 0)))
    o = o_intra + jnp.moveaxis(o_inter, 0, 1)
    return o.reshape(Bsz, L, H, DV).astype(v.dtype), s_fin


def ssd_scan(xh, dt, A, Bm, Cm, s0):
    Bsz, L, G, R, P = xh.shape
    N = Bm.shape[-1]
    C = SSD_CHUNK
    n = L // C
    dt32 = dt.astype(jnp.float32)
    a = (dt32 * A).reshape(Bsz, n, C, G, R)
    xdt = (xh.astype(jnp.float32) * dt32[..., None]).reshape(Bsz, n, C, G, R, P)
    Bc = Bm.reshape(Bsz, n, C, G, N).astype(jnp.float32)
    Cc = Cm.reshape(Bsz, n, C, G, N).astype(jnp.float32)
    acum = jnp.cumsum(a, axis=2)
    mask = jnp.tril(jnp.ones((C, C), dtype=bool))[:, :, None, None]
    seg = jnp.exp(jnp.where(mask, acum[:, :, :, None] - acum[:, :, None], -jnp.inf))
    cb = jnp.einsum('bnigs,bnjgs->bnijg', Cc, Bc)
    y_diag = jnp.einsum('bnijg,bnijgr,bnjgrp->bnigrp', cb, seg, xdt)
    a_last = acum[:, :, -1]
    w_state = jnp.exp(a_last[:, :, None] - acum)
    u = jnp.einsum('bnjgs,bnjgr,bnjgrp->bngrps', Bc, w_state, xdt)
    c_dec = jnp.exp(acum)

    def step(S, inp):
        cn, cd, uc, a_tot = inp
        o = jnp.einsum('bigs,bigr,bgrps->bigrp', cn, cd, S)
        return S * a_tot[..., None, None] + uc, o

    s_fin, y_off = lax.scan(step, s0, (jnp.moveaxis(Cc, 1, 0), jnp.moveaxis(c_dec, 1, 0),
                                       jnp.moveaxis(u, 1, 0), jnp.moveaxis(jnp.exp(a_last), 1, 0)))
    y = y_diag + jnp.moveaxis(y_off, 0, 1)
    return y.reshape(Bsz, L, G, R, P).astype(xh.dtype), s_fin


def gla_heads(q, k, v):
    Bsz, L, _ = q.shape
    return (q.reshape(Bsz, L, GLA_HEADS, GLA_DK) * (GLA_DK ** -0.5),
            k.reshape(Bsz, L, GLA_HEADS, GLA_DK),
            v.reshape(Bsz, L, GLA_HEADS, GLA_DV))


def gla_log_decay(gk_low, w_up, b_up):
    Bsz, L, _ = gk_low.shape
    g = jax.nn.log_sigmoid((gk_low @ w_up + b_up).astype(jnp.float32)) / GLA_GATE_NORM
    return g.reshape(Bsz, L, GLA_HEADS, GLA_DK)


def gla_output(o, g, w_norm):
    Bsz, L = o.shape[:2]
    y = rmsnorm(o, w_norm) * jax.nn.silu(g.reshape(Bsz, L, GLA_HEADS, GLA_DV))
    return y.reshape(Bsz, L, GLA_V)


def gla_mixer(p, pc, w_gk_up, b_gk, w_norm, with_ctx):
    q, k, v, g, gk_low = p
    qc, kc, vc, gc, gkc_low = pc
    ql, kl, vl = gla_heads(q, k, v)
    qx, kx, vx = gla_heads(qc, kc, vc)
    s0 = jnp.zeros((qx.shape[0], GLA_HEADS, GLA_DK, GLA_DV), jnp.float32)
    o_lat, o_ctx = None, None
    for d in range(2):
        f = _identity if d == 0 else _flip
        ld_c = gla_log_decay(gkc_low, w_gk_up[d], b_gk[d])
        ld_l = gla_log_decay(gk_low, w_gk_up[d], b_gk[d])
        oc, sc = gla_scan(f(qx), f(kx), f(vx), f(ld_c), s0)
        ol, _ = gla_scan(f(ql), f(kl), f(vl), f(ld_l), sc)
        o_lat = f(ol) if o_lat is None else o_lat + f(ol)
        o_ctx = f(oc) if o_ctx is None else o_ctx + f(oc)
    y = gla_output(o_lat, g, w_norm)
    yc = gla_output(o_ctx, gc, w_norm) if with_ctx else None
    return y, yc


def conv_latent(xbc, w, b):
    Bsz, L, Ch = xbc.shape
    rows = L // GRID_W
    y = lax.conv_general_dilated(xbc.reshape(Bsz, rows, GRID_W, Ch), w[:, :, None, :], (1, 1), 'SAME',
                                 dimension_numbers=('NHWC', 'HWIO', 'NHWC'), feature_group_count=Ch)
    return jax.nn.silu(y.reshape(Bsz, L, Ch) + b)


def conv_context(xbc, w, b):
    Ch = xbc.shape[-1]
    y = lax.conv_general_dilated(xbc, w[1][:, None, :], (1,), 'SAME',
                                 dimension_numbers=('NWC', 'WIO', 'NWC'), feature_group_count=Ch)
    return jax.nn.silu(y + b)


def ssd_heads(xbc_act):
    Bsz, L, _ = xbc_act.shape
    xs, Bm, Cm = jnp.split(xbc_act, [SSD_INNER, SSD_INNER + SSD_GROUPS * SSD_STATE], axis=-1)
    return (xs.reshape(Bsz, L, SSD_GROUPS, SSD_HEADS_PER_GROUP, SSD_HEADDIM),
            Bm.reshape(Bsz, L, SSD_GROUPS, SSD_STATE),
            Cm.reshape(Bsz, L, SSD_GROUPS, SSD_STATE))


def ssd_output(y, z, w_norm):
    Bsz, L = y.shape[:2]
    u = (y.reshape(Bsz, L, SSD_INNER) * jax.nn.silu(z)).reshape(Bsz, L, SSD_GROUPS, SSD_INNER // SSD_GROUPS)
    return rmsnorm(u, w_norm.reshape(SSD_GROUPS, SSD_INNER // SSD_GROUPS)).reshape(Bsz, L, SSD_INNER)


def ssd_mixer(p, pc, conv_w, conv_b, dt_bias, A_log, D_skip, w_norm, with_ctx):
    z, xbc, dt_raw = p
    zc, xbcc, dtc_raw = pc
    xl, Bl, Cl = ssd_heads(conv_latent(xbc, conv_w, conv_b))
    xc, Bc, Cc = ssd_heads(conv_context(xbcc, conv_w, conv_b))
    Dg = D_skip.reshape(SSD_GROUPS, SSD_HEADS_PER_GROUP, 1)
    y_lat = Dg * xl
    y_ctx = Dg * xc
    gr = (SSD_GROUPS, SSD_HEADS_PER_GROUP)
    s0 = jnp.zeros((xc.shape[0], SSD_GROUPS, SSD_HEADS_PER_GROUP, SSD_HEADDIM, SSD_STATE), jnp.float32)
    for d in range(2):
        f = _identity if d == 0 else _flip
        A = -jnp.exp(A_log[d].astype(jnp.float32)).reshape(gr)
        bias = dt_bias[d].astype(jnp.float32)
        dtl = jax.nn.softplus(dt_raw.astype(jnp.float32) + bias).reshape(dt_raw.shape[:2] + gr)
        dtc = jax.nn.softplus(dtc_raw.astype(jnp.float32) + bias).reshape(dtc_raw.shape[:2] + gr)
        yc, sc = ssd_scan(f(xc), f(dtc), A, f(Bc), f(Cc), s0)
        yl, _ = ssd_scan(f(xl), f(dtl), A, f(Bl), f(Cl), sc)
        y_lat = y_lat + f(yl)
        y_ctx = y_ctx + f(yc)
    y = ssd_output(y_lat, z, w_norm)
    yc_out = ssd_output(y_ctx, zc, w_norm) if with_ctx else None
    return y, yc_out


def moe_ffn(h, w_router, b_router, w_gate_up, b_gate_up, w_down, b_down):
    T, D = h.shape
    logits = (h @ w_router + b_router).astype(jnp.float32)
    top_val, top_idx = lax.top_k(logits, TOP_K)
    gates = jax.nn.softmax(top_val, axis=-1).astype(h.dtype)
    A_n = T * TOP_K
    flat_e = top_idx.reshape(-1).astype(jnp.int32)
    flat_tok = jnp.repeat(jnp.arange(T, dtype=jnp.int32), TOP_K)
    flat_w = gates.reshape(-1)
    order = jnp.argsort(flat_e)
    se, stok, sw = flat_e[order], flat_tok[order], flat_w[order]
    counts = jnp.bincount(flat_e, length=N_EXPERTS).astype(jnp.int32)
    padded = ((counts + MOE_BLOCK - 1) // MOE_BLOCK) * MOE_BLOCK
    start = jnp.cumsum(counts) - counts
    pend = jnp.cumsum(padded)
    pstart = pend - padded
    dest = pstart[se] + (jnp.arange(A_n, dtype=jnp.int32) - start[se])
    n_blocks = -(-A_n // MOE_BLOCK) + N_EXPERTS
    P = n_blocks * MOE_BLOCK
    tok_buf = jnp.full((P,), T, jnp.int32).at[dest].set(stok)
    w_buf = jnp.zeros((P,), h.dtype).at[dest].set(sw)
    blk_e = jnp.minimum(jnp.searchsorted(pend, jnp.arange(n_blocks, dtype=jnp.int32) * MOE_BLOCK,
                                         side='right'), N_EXPERTS - 1)
    h_pad = jnp.concatenate([h, jnp.zeros((1, D), h.dtype)], axis=0)

    def expert_block(args):
        e, toks, wts = args
        xb = h_pad[toks]
        gu = xb @ w_gate_up[e] + b_gate_up[e]
        gate, up = gu[:, :D_FF], gu[:, D_FF:]
        gate = jnp.minimum(gate, SWIGLU_LIMIT)
        up = jnp.clip(up, -SWIGLU_LIMIT, SWIGLU_LIMIT)
        glu = gate * jax.nn.sigmoid(SWIGLU_ALPHA * gate)
        y = ((up + 1.0) * glu) @ w_down[e] + b_down[e]
        return y * wts[:, None]

    y = lax.map(expert_block, (blk_e, tok_buf.reshape(n_blocks, MOE_BLOCK), w_buf.reshape(n_blocks, MOE_BLOCK)))
    out = jnp.zeros((T + 1, D), h.dtype).at[tok_buf].add(y.reshape(P, D).astype(h.dtype))
    return out[:T]


def setup_inputs(seed: int = 0) -> dict:
    key = jax.random.key(seed)
    ks = jax.random.split(key, 26)

    def nrm(k, shape, scale):
        return jax.random.normal(k, shape, jnp.float32) * scale

    dt0 = jnp.exp(jax.random.uniform(ks[13], (DEPTH, 2, SSD_HEADS), jnp.float32,
                                     minval=math.log(1e-3), maxval=math.log(1e-1)))
    return {
        "x": nrm(ks[0], (BATCH, SEQ, D_MODEL), 1.0),
        "c": nrm(ks[1], (BATCH, D_MODEL), 1.0),
        "ctx": nrm(ks[2], (BATCH, CTX_LEN, D_MODEL), 1.0),
        "c_ctx": nrm(ks[3], (D_MODEL,), 1.0),
        "w_mod": nrm(ks[4], (DEPTH, D_MODEL, 6 * D_MODEL), D_MODEL ** -0.5),
        "b_mod": nrm(ks[5], (DEPTH, 6 * D_MODEL), 0.02),
        "norm1": 1.0 + nrm(ks[6], (DEPTH, D_MODEL), 0.02),
        "w_in": nrm(ks[7], (DEPTH, D_MODEL, IN_DIM), D_MODEL ** -0.5),
        "gla_w_gk_up": nrm(ks[8], (DEPTH, 2, GLA_RANK, GLA_QK), GLA_RANK ** -0.5),
        "gla_b_gk": nrm(ks[9], (DEPTH, 2, GLA_QK), 0.1),
        "gla_norm": 1.0 + nrm(ks[10], (DEPTH, GLA_DV), 0.02),
        "ssd_conv_w": nrm(ks[11], (DEPTH, SSD_CONV_K, SSD_CONV_K, SSD_CONV_DIM), 1.0 / SSD_CONV_K),
        "ssd_conv_b": nrm(ks[12], (DEPTH, SSD_CONV_DIM), 0.02),
        "ssd_dt_bias": dt0 + jnp.log(-jnp.expm1(-dt0)),
        "ssd_A_log": jnp.log(jax.random.uniform(ks[14], (DEPTH, 2, SSD_HEADS), jnp.float32, minval=1.0, maxval=16.0)),
        "ssd_D": 1.0 + nrm(ks[15], (DEPTH, SSD_HEADS), 0.02),
        "ssd_norm": 1.0 + nrm(ks[16], (DEPTH, SSD_INNER), 0.02),
        "w_out": nrm(ks[17], (DEPTH, MIX_WIDTH, D_MODEL), MIX_WIDTH ** -0.5),
        "norm2": 1.0 + nrm(ks[18], (DEPTH, D_MODEL), 0.02),
        "w_router": nrm(ks[19], (DEPTH, D_MODEL, N_EXPERTS), D_MODEL ** -0.5),
        "b_router": nrm(ks[20], (DEPTH, N_EXPERTS), 0.01),
        "w_gate_up": nrm(ks[21], (DEPTH, N_EXPERTS, D_MODEL, 2 * D_FF), D_MODEL ** -0.5),
        "b_gate_up": nrm(ks[22], (DEPTH, N_EXPERTS, 2 * D_FF), 0.01),
        "w_down": nrm(ks[23], (DEPTH, N_EXPERTS, D_FF, D_MODEL), D_FF ** -0.5),
        "b_down": nrm(ks[24], (DEPTH, N_EXPERTS, D_MODEL), 0.01),
        "final_norm": 1.0 + nrm(ks[25], (D_MODEL,), 0.02),
    }


def reference(x, c, ctx, c_ctx, w_mod, b_mod, norm1, w_in, gla_w_gk_up, gla_b_gk, gla_norm,
              ssd_conv_w, ssd_conv_b, ssd_dt_bias, ssd_A_log, ssd_D, ssd_norm, w_out,
              norm2, w_router, b_router, w_gate_up, b_gate_up, w_down, b_down, final_norm):
    Bsz, L, D = x.shape
    xc = ctx
    for l in range(DEPTH):
        update_ctx = l < DEPTH - 1
        mod = (jax.nn.silu(c) @ w_mod[l] + b_mod[l])[:, None, :]
        mod_c = jax.nn.silu(c_ctx) @ w_mod[l] + b_mod[l]
        sh1, sc1, g1, sh2, sc2, g2 = jnp.split(mod, 6, axis=-1)
        sh1c, sc1c, g1c, sh2c, sc2c, g2c = jnp.split(mod_c, 6, axis=-1)
        h = modulate(rmsnorm(x, norm1[l]), sh1, sc1)
        hc = modulate(rmsnorm(xc, norm1[l]), sh1c, sc1c)
        p = jnp.split(h @ w_in[l], IN_OFFSETS, axis=-1)
        pc = jnp.split(hc @ w_in[l], IN_OFFSETS, axis=-1)
        y_gla, yc_gla = gla_mixer(p[:5], pc[:5], gla_w_gk_up[l], gla_b_gk[l], gla_norm[l], update_ctx)
        y_ssd, yc_ssd = ssd_mixer(p[5:], pc[5:], ssd_conv_w[l], ssd_conv_b[l], ssd_dt_bias[l],
                                  ssd_A_log[l], ssd_D[l], ssd_norm[l], update_ctx)
        x = x + g1 * (jnp.concatenate([y_gla, y_ssd], axis=-1) @ w_out[l])
        h2 = modulate(rmsnorm(x, norm2[l]), sh2, sc2).reshape(Bsz * L, D)
        if update_ctx:
            xc = xc + g1c * (jnp.concatenate([yc_gla, yc_ssd], axis=-1) @ w_out[l])
            h2c = modulate(rmsnorm(xc, norm2[l]), sh2c, sc2c).reshape(-1, D)
            f_all = moe_ffn(jnp.concatenate([h2, h2c], axis=0), w_router[l], b_router[l],
                            w_gate_up[l], b_gate_up[l], w_down[l], b_down[l])
            x = x + g2 * f_all[:Bsz * L].reshape(Bsz, L, D)
            xc = xc + g2c * f_all[Bsz * L:].reshape(xc.shape)
        else:
            f_lat = moe_ffn(h2, w_router[l], b_router[l], w_gate_up[l], b_gate_up[l], w_down[l], b_down[l])
            x = x + g2 * f_lat.reshape(Bsz, L, D)
    return rmsnorm(x, final_norm)
```

```cpp
#include <hip/hip_runtime.h>
#include <hip/hip_cooperative_groups.h>
#include <cstdio>
#include <cstdint>
namespace cg = cooperative_groups;

#ifndef MK_FUSED
#define MK_FUSED 0
#endif

#define LAS __attribute__((address_space(3)))
#define GAS __attribute__((address_space(1)))
typedef unsigned short bf16_t;
typedef short bf16x8 __attribute__((ext_vector_type(8)));
typedef float f32x4 __attribute__((ext_vector_type(4)));
typedef float f32x2 __attribute__((ext_vector_type(2)));
typedef unsigned u32x4 __attribute__((ext_vector_type(4)));
typedef unsigned u32x2 __attribute__((ext_vector_type(2)));

constexpr int NB = 4, SEQ = 8192, CTXL = 256, DM = 1024;
constexpr int TL = NB * SEQ;
constexpr int TCX = NB * CTXL;
constexpr int TT = TL + TCX;
constexpr int NP = 3328;
constexpr int CQ = 0, CK = 256, CV = 512, CG = 1024, CZ = 1536, CX = 2048, CGK = 3072, CDT = 3088;
constexpr int NEXP = 32, DFF = 1024;
constexpr float EPS = 1e-6f;
constexpr int MAXTILES = 544;
constexpr int ZROW = TL;

constexpr size_t MiB = 1u << 20;
constexpr size_t WS_CTL = 0, CTL_BYTES = 1 * MiB;
constexpr size_t WS_MOD = 1 * MiB;
constexpr size_t WS_WIN = 2 * MiB;
constexpr size_t WS_WOUT = 9 * MiB;
constexpr size_t WS_WGU = 11 * MiB;
constexpr size_t WS_WD = 139 * MiB;
constexpr size_t WS_TOKE = 203 * MiB;
constexpr size_t WS_TOKP = WS_TOKE + 512 * 1024;
constexpr size_t WS_TOKG = WS_TOKP + 512 * 1024;
constexpr size_t WS_ROWTOK = 205 * MiB;
constexpr size_t WS_H = 209 * MiB;
constexpr size_t WS_P = 276 * MiB;
constexpr size_t WS_XBC = 491 * MiB;
constexpr size_t WS_G = 557 * MiB;
constexpr size_t WS_OG = 623 * MiB;
constexpr size_t WS_OS = 687 * MiB;
constexpr size_t WS_Y = 751 * MiB;
constexpr size_t WS_ACT = 276 * MiB;
constexpr size_t WS_YP = 548 * MiB;
constexpr size_t WS_END = 820 * MiB;
static_assert(WS_P + (size_t)TT * NP * 2 <= WS_XBC && WS_XBC + (size_t)TT * 1024 * 2 <= WS_G && WS_G + (size_t)2 * TT * 256 * 4 <= WS_OG, "ws map");
static_assert(WS_ACT + (size_t)MAXTILES * 256 * 2048 <= WS_YP && WS_YP + (size_t)MAXTILES * 256 * 2048 <= WS_END, "ws map 2");
static_assert(WS_H + (size_t)(TT + 256) * 2048 <= WS_P, "ws map 3");
constexpr int CW_CNT = 1024;
constexpr int CW_BAR = 8192;

constexpr int RING_BYTES = 131072;
constexpr int MISC_OFF = 132096;
constexpr int LDS_BYTES = 147456;

struct Params { const float* in[26]; float* out; unsigned char* ws; int ph_lo, ph_hi; };

__device__ __forceinline__ unsigned f2bf(float f) { unsigned u = __builtin_bit_cast(unsigned, f); return (u + 0x7fffu + ((u >> 16) & 1u)) >> 16; }
__device__ __forceinline__ unsigned pk2(float lo, float hi) { return f2bf(lo) | (f2bf(hi) << 16); }
__device__ __forceinline__ float bf2f(unsigned short h) { return __builtin_bit_cast(float, (unsigned)h << 16); }
__device__ __forceinline__ float bflo(unsigned w) { return __builtin_bit_cast(float, w << 16); }
__device__ __forceinline__ float bfhi(unsigned w) { return __builtin_bit_cast(float, w & 0xffff0000u); }
__device__ __forceinline__ float wave_sum(float v) {
#pragma unroll
    for (int o = 1; o < 64; o <<= 1) v += __shfl_xor(v, o);
    return v;
}
__device__ __forceinline__ float silu_f(float v) { return v / (1.f + __expf(-v)); }
__device__ __forceinline__ float sigmoid_f(float v) { return 1.f / (1.f + __expf(-v)); }
__device__ __forceinline__ float softplus_f(float v) { return fmaxf(v, 0.f) + log1pf(__expf(-fabsf(v))); }
__device__ __forceinline__ float logsigmoid_f(float v) { return fminf(v, 0.f) - log1pf(__expf(-fabsf(v))); }
#define LDS_WAIT() asm volatile("s_waitcnt lgkmcnt(0)" ::: "memory")

namespace pg8 {
constexpr int BM = 256, BK = 64, HALF = 128, HTB = HALF * BK * 2, STAGE_BYTES = 8 * HTB, NXCD = 8, WGM = 8;
constexpr int KD = 1024;
constexpr unsigned ROWB = KD * 2;
__host__ __device__ __forceinline__ int lds_byte(int r, int c) { const int st = (r >> 4) * 2 + (c >> 5), rr = r & 15, cc = c & 31, ob = rr * 64 + cc * 2; return st * 1024 + (ob ^ (((ob >> 9) & 1) << 5)); }
__host__ __device__ __forceinline__ void stage_rc(int b, int& R, int& C) { const int st = b / 1024, sb = b % 1024, swz = sb ^ (((sb >> 9) & 1) << 5); R = (st >> 1) * 16 + swz / 64; C = (st & 1) * 32 + (swz % 64) / 2; }
__host__ __device__ __forceinline__ int perm32(int rho) { const int n = rho >> 4, i = rho & 15; return 8 * (i >> 2) + 4 * n + (i & 3); }

struct Unit { int pm, pn, e, mt; };

__device__ __forceinline__ void tile_of(int L, int nM, int nN, int& pm, int& pn) {
    const int nwg = nM * nN; int wgid = L;
    { const int q = nwg / NXCD, r = nwg % NXCD, xcd = wgid % NXCD, off = wgid / NXCD; wgid = (xcd < r ? xcd * (q + 1) : r * (q + 1) + (xcd - r) * q) + off; }
    const int nig = WGM * nN, gid = wgid / nig, fm = gid * WGM, gsz = (nM - fm) < WGM ? (nM - fm) : WGM;
    pm = fm + ((wgid % nig) % gsz); pn = (wgid % nig) / gsz;
}
struct DenseOrder {
    static constexpr bool GATHER = false;
    int nM, nN, G, c; const char* Bt;
    __device__ __forceinline__ bool next(int i, Unit& u) const { const long L = (long)i * G + c; if (L >= (long)nM * nN) return false; tile_of((int)L, nM, nN, u.pm, u.pn); u.e = 0; u.mt = u.pm; return true; }
    __device__ __forceinline__ const char* bbase(const Unit& u) const { return Bt + (size_t)u.pn * BM * ROWB; }
    __device__ __forceinline__ unsigned arow(const Unit& u, int rl) const { return 0u; }
};
template <bool GATHER_> struct MoeOrder {
    static constexpr bool GATHER = GATHER_;
    int nMt, nN, G, c; const char* Bt; int brows; const LAS int* tb; const LAS int* cn; const int* rowtok;
    __device__ __forceinline__ bool next(int i, Unit& u) const {
        const long L = (long)i * G + c; if (L >= (long)nMt * nN) return false; tile_of((int)L, nMt, nN, u.pm, u.pn);
        int e = 0;
#pragma unroll
        for (int q = 1; q < NEXP; ++q) e += (tb[q] <= u.pm) ? 1 : 0;
        e = __builtin_amdgcn_readfirstlane(e); u.e = e; u.mt = u.pm - __builtin_amdgcn_readfirstlane(tb[e]); return true;
    }
    __device__ __forceinline__ const char* bbase(const Unit& u) const { return Bt + (size_t)(u.e * brows + u.pn * BM) * ROWB; }
    __device__ __forceinline__ unsigned arow(const Unit& u, int rl) const {
        const int pos = u.mt * BM + rl; const int lim = __builtin_amdgcn_readfirstlane(cn[u.e]); int tok = ZROW; if (pos < lim) tok = rowtok[u.e * TL + pos]; return (unsigned)tok;
    }
};

__device__ __forceinline__ unsigned cvt_pk_bf16(float lo, float hi) { unsigned r; asm volatile("v_cvt_pk_bf16_f32 %0, %1, %2" : "=v"(r) : "v"(lo), "v"(hi)); return r; }

struct EpiBf16 {
    static constexpr bool PERM = true;
    bf16_t* O; int ldc; const float* bias; int bstride;
    __device__ __forceinline__ void operator()(const f32x4 (&acc)[2][2][4][2], const Unit& u, int wr, int wc, int fr, int fq) const {
        const int row0 = u.pm * BM + wr * 64 + fr; const int col0 = u.pn * BM + wc * 32 + 8 * fq;
        f32x4 bv[2][2];
#pragma unroll
        for (int bj = 0; bj < 2; ++bj)
#pragma unroll
            for (int n = 0; n < 2; ++n) bv[bj][n] = bias ? *(const f32x4*)(bias + (size_t)u.e * bstride + col0 + bj * HALF + 4 * n) : (f32x4){0.f, 0.f, 0.f, 0.f};
#pragma unroll
        for (int ai = 0; ai < 2; ++ai)
#pragma unroll
            for (int m = 0; m < 4; ++m) { bf16_t* rowp = O + (size_t)(row0 + ai * HALF + m * 16) * ldc + col0;
#pragma unroll
                for (int bj = 0; bj < 2; ++bj) { const f32x4 v0 = acc[ai][bj][m][0] + bv[bj][0], v1 = acc[ai][bj][m][1] + bv[bj][1];
                    u32x4 w; w.x = cvt_pk_bf16(v0[0], v0[1]); w.y = cvt_pk_bf16(v0[2], v0[3]); w.z = cvt_pk_bf16(v1[0], v1[1]); w.w = cvt_pk_bf16(v1[2], v1[3]);
                    *(u32x4*)(rowp + bj * HALF) = w; } }
    }
};
struct EpiSwiglu {
    static constexpr bool PERM = true;
    bf16_t* O; const float* bias;
    __device__ __forceinline__ void operator()(const f32x4 (&acc)[2][2][4][2], const Unit& u, int wr, int wc, int fr, int fq) const {
        const int row0 = u.pm * BM + wr * 64 + fr; const int ff0 = u.pn * HALF + wc * 32 + 8 * fq;
        f32x4 bg[2], bu[2];
#pragma unroll
        for (int n = 0; n < 2; ++n) { bg[n] = *(const f32x4*)(bias + (size_t)u.e * 2048 + ff0 + 4 * n); bu[n] = *(const f32x4*)(bias + (size_t)u.e * 2048 + 1024 + ff0 + 4 * n); }
#pragma unroll
        for (int ai = 0; ai < 2; ++ai)
#pragma unroll
            for (int m = 0; m < 4; ++m) { bf16_t* rowp = O + (size_t)(row0 + ai * HALF + m * 16) * DFF + ff0;
                float r[8];
#pragma unroll
                for (int n = 0; n < 2; ++n)
#pragma unroll
                    for (int j = 0; j < 4; ++j) {
                        float g = fminf(acc[ai][0][m][n][j] + bg[n][j], 7.0f);
                        float up = fminf(fmaxf(acc[ai][1][m][n][j] + bu[n][j], -7.0f), 7.0f);
                        const float glu = g * __builtin_amdgcn_rcpf(1.f + __expf(-1.702f * g));
                        r[4 * n + j] = (up + 1.0f) * glu; }
                u32x4 w; w.x = cvt_pk_bf16(r[0], r[1]); w.y = cvt_pk_bf16(r[2], r[3]); w.z = cvt_pk_bf16(r[4], r[5]); w.w = cvt_pk_bf16(r[6], r[7]);
                *(u32x4*)rowp = w; }
    }
};
struct EpiResGate {
    static constexpr bool PERM = false;
    const float* x; float* out; const float* mod;
    __device__ __forceinline__ void operator()(const f32x4 (&acc)[2][2][4][2], const Unit& u, int wr, int wc, int fr, int fq) const {
        const int row0 = u.pm * BM + wr * 64 + fr, col0 = u.pn * BM + wc * 32 + 4 * fq;
        const float* g1 = mod + (size_t)((u.pm * BM) >> 13) * 6144 + 2048;
        f32x4 gv[2][2];
#pragma unroll
        for (int bj = 0; bj < 2; ++bj)
#pragma unroll
            for (int n = 0; n < 2; ++n) gv[bj][n] = *(const f32x4*)(g1 + col0 + bj * HALF + n * 16);
#pragma unroll
        for (int ai = 0; ai < 2; ++ai)
#pragma unroll
            for (int m = 0; m < 4; ++m) { const size_t off = (size_t)(row0 + ai * HALF + m * 16) * DM + col0;
#pragma unroll
                for (int bj = 0; bj < 2; ++bj)
#pragma unroll
                    for (int n = 0; n < 2; ++n) { const f32x4 xv = *(const f32x4*)(x + off + bj * HALF + n * 16);
                        *(f32x4*)(out + off + bj * HALF + n * 16) = xv + gv[bj][n] * acc[ai][bj][m][n]; } }
    }
};

template <class Epi, class Sched, bool ALIGN_EPI>
__device__ __forceinline__ void gemm_phase(LAS unsigned char* lds, const bf16_t* Aglob, const Sched& S, const Epi& E) {
    const int tid = threadIdx.x, wid = __builtin_amdgcn_readfirstlane(tid >> 6), lane = tid & 63, wr = wid >> 2, wc = wid & 3, fr = lane & 15, fq = lane >> 4;
    constexpr int nt = KD / BK;
    unsigned voffA[2], voffB[2];
#pragma unroll
    for (int i = 0; i < 2; ++i) { int R, C; stage_rc(tid * 16 + i * 8192, R, C); const int Rb = Epi::PERM ? ((R & ~31) + perm32(R & 31)) : R;
        voffA[i] = (unsigned)(R * KD + C) * 2u; voffB[i] = (unsigned)(Rb * KD + C) * 2u; }
    constexpr size_t kstep = (size_t)(BK * 2);
    constexpr size_t hstep = (size_t)HALF * KD * 2;
    constexpr size_t tstep = 2 * hstep;
    const unsigned ldsw = (unsigned)wid * 1024u;
    const int aoff = lds_byte(wr * 64 + fr, fq * 8), boff = lds_byte(wc * 32 + fr, fq * 8);
    const char* Ab = (const char*)Aglob;
#define PG8_SA(b, h) (((b) * 2 + (h)) * HTB)
#define PG8_SB(b, h) ((4 + (b) * 2 + (h)) * HTB)
#define PG8_STAGE_B(bufoff, gbase) do { _Pragma("unroll") for (int _i = 0; _i < 2; ++_i) \
        __builtin_amdgcn_global_load_lds((const unsigned*)((const char*)(gbase) + voffB[_i]), (LAS unsigned*)(lds + (bufoff) + ldsw + _i * 8192), 16, 0, 0); } while (0)
#define PG8_STAGE_A(bufoff, pa, tk, h, kb) do { _Pragma("unroll") for (int _i = 0; _i < 2; ++_i) { \
        const char* _src = Sched::GATHER ? (Ab + (kb) + (size_t)((((tk)[_i] >> (16 * (h))) & 0xffffu) * ROWB + (voffA[_i] & 127u))) : ((pa) + (size_t)(h) * hstep + (kb) + voffA[_i]); \
        __builtin_amdgcn_global_load_lds((const unsigned*)_src, (LAS unsigned*)(lds + (bufoff) + ldsw + _i * 8192), 16, 0, 0); } } while (0)
#define PG8_LDA(dst, b, h) do { _Pragma("unroll") for (int m = 0; m < 4; ++m) _Pragma("unroll") for (int k = 0; k < 2; ++k) dst[m][k] = *(const LAS bf16x8*)(lds + PG8_SA(b, h) + aoff + m * 2048 + k * 1024); } while (0)
#define PG8_LDB(dst, b, h) do { _Pragma("unroll") for (int n = 0; n < 2; ++n) _Pragma("unroll") for (int k = 0; k < 2; ++k) dst[n][k] = *(const LAS bf16x8*)(lds + PG8_SB(b, h) + boff + n * 2048 + k * 1024); } while (0)
#define PG8_MMA(ai, bj, At, Bt) do { __builtin_amdgcn_s_setprio(1); _Pragma("unroll") for (int m = 0; m < 4; ++m) _Pragma("unroll") for (int n = 0; n < 2; ++n) _Pragma("unroll") for (int k = 0; k < 2; ++k) \
        acc[ai][bj][m][n] = __builtin_amdgcn_mfma_f32_16x16x32_bf16(Bt[n][k], At[m][k], acc[ai][bj][m][n], 0, 0, 0); __builtin_amdgcn_s_setprio(0); } while (0)
#define PG8_WAIT_V(n) asm volatile("s_waitcnt vmcnt(" #n ")" ::: "memory")
#define PG8_WAIT_L(n) asm volatile("s_waitcnt lgkmcnt(" #n ")" ::: "memory")
#define PG8_BAR __builtin_amdgcn_s_barrier()
#define PG8_SCHED __builtin_amdgcn_sched_barrier(0)
#define PG8_TOKS(dst, u) do { if constexpr (Sched::GATHER) { _Pragma("unroll") for (int _i = 0; _i < 2; ++_i) { const int _R = (int)(voffA[_i] >> 11); \
        dst[_i] = S.arow(u, _R) | (S.arow(u, HALF + _R) << 16); } } } while (0)
    Unit cur, nxt; int ui = 0;
    if (!S.next(0, cur)) return;
    f32x4 acc[2][2][4][2];
#pragma unroll
    for (int a = 0; a < 2; ++a)
#pragma unroll
        for (int b = 0; b < 2; ++b)
#pragma unroll
            for (int m = 0; m < 4; ++m)
#pragma unroll
                for (int n = 0; n < 2; ++n) acc[a][b][m][n] = (f32x4){0.f, 0.f, 0.f, 0.f};
    bf16x8 At[4][2], B0[2][2], B1[2][2];
    unsigned tokC[2] = {0u, 0u}, tokN[2] = {0u, 0u};
    PG8_TOKS(tokC, cur);
    const char* cA = Ab + (size_t)cur.pm * tstep;
    const char* cB = S.bbase(cur);
    PG8_STAGE_B(PG8_SB(0, 0), cB); PG8_STAGE_B(PG8_SB(0, 1), cB + hstep); PG8_STAGE_A(PG8_SA(0, 0), cA, tokC, 0, 0); PG8_STAGE_A(PG8_SA(0, 1), cA, tokC, 1, 0);
    if (wr == 1) PG8_BAR;
    PG8_WAIT_V(2); PG8_BAR;
    PG8_STAGE_B(PG8_SB(1, 0), cB + kstep); PG8_STAGE_A(PG8_SA(1, 0), cA, tokC, 0, kstep); PG8_STAGE_B(PG8_SB(1, 1), cB + hstep + kstep);
    PG8_WAIT_V(6); PG8_BAR;
    for (;;) {
        const bool has_next = S.next(ui + 1, nxt);
        const char* nA = has_next ? Ab + (size_t)nxt.pm * tstep : cA; const char* nB = has_next ? S.bbase(nxt) : cB;
        for (int t = 0; t < nt; t += 2) {
            const bool last = (t == nt - 2);
            if (last) { if (has_next) { PG8_TOKS(tokN, nxt); } else { tokN[0] = tokC[0]; tokN[1] = tokC[1]; } }
            const size_t k1 = (size_t)(t + 1) * kstep;
            const size_t k2 = last ? 0 : (size_t)(t + 2) * kstep, k3 = k2 + kstep;
            const char* a2 = last ? nA : cA;
            const char* b2 = last ? nB : cB + (size_t)(t + 2) * kstep; const char* b3 = b2 + kstep;
            unsigned tk2[2]; tk2[0] = last ? tokN[0] : tokC[0]; tk2[1] = last ? tokN[1] : tokC[1];
            PG8_LDB(B0, 0, 0); PG8_LDB(B1, 0, 1); PG8_SCHED; PG8_LDA(At, 0, 0); PG8_STAGE_A(PG8_SA(1, 1), cA, tokC, 1, k1);
            PG8_WAIT_V(8); PG8_WAIT_L(0); PG8_BAR; PG8_MMA(0, 0, At, B0); PG8_MMA(0, 1, At, B1); PG8_BAR; PG8_SCHED;
            PG8_LDA(At, 0, 1); PG8_STAGE_B(PG8_SB(0, 0), b2); PG8_STAGE_B(PG8_SB(0, 1), b2 + hstep); PG8_STAGE_A(PG8_SA(0, 0), a2, tk2, 0, k2);
            PG8_WAIT_V(8); PG8_WAIT_L(0); PG8_BAR; PG8_MMA(1, 0, At, B0); PG8_MMA(1, 1, At, B1); PG8_BAR; PG8_SCHED;
            PG8_LDB(B0, 1, 0); PG8_LDB(B1, 1, 1); PG8_SCHED; PG8_LDA(At, 1, 0); PG8_STAGE_A(PG8_SA(0, 1), a2, tk2, 1, k2);
            PG8_WAIT_V(8); PG8_WAIT_L(0); PG8_BAR; PG8_MMA(0, 0, At, B0); PG8_MMA(0, 1, At, B1); PG8_BAR; PG8_SCHED;
            PG8_LDA(At, 1, 1); PG8_STAGE_B(PG8_SB(1, 0), b3); PG8_STAGE_B(PG8_SB(1, 1), b3 + hstep); PG8_STAGE_A(PG8_SA(1, 0), a2, tk2, 0, k3);
            PG8_WAIT_V(8); PG8_WAIT_L(0); PG8_BAR; PG8_MMA(1, 0, At, B0); PG8_MMA(1, 1, At, B1); PG8_BAR; PG8_SCHED;
        }
        if constexpr (ALIGN_EPI) { if (wr == 0) PG8_BAR; }
        E(acc, cur, wr, wc, fr, fq);
        if (!has_next) break;
#pragma unroll
        for (int a = 0; a < 2; ++a)
#pragma unroll
            for (int b = 0; b < 2; ++b)
#pragma unroll
                for (int m = 0; m < 4; ++m)
#pragma unroll
                    for (int n = 0; n < 2; ++n) acc[a][b][m][n] = (f32x4){0.f, 0.f, 0.f, 0.f};
        cur = nxt; cA = nA; cB = nB; ++ui; tokC[0] = tokN[0]; tokC[1] = tokN[1];
        if constexpr (ALIGN_EPI) { if (wr == 1) PG8_BAR; }
    }
    PG8_WAIT_V(0);
    if constexpr (!ALIGN_EPI) { if (wr == 0) PG8_BAR; }
    PG8_BAR;
#undef PG8_SA
#undef PG8_SB
#undef PG8_STAGE_A
#undef PG8_STAGE_B
#undef PG8_LDA
#undef PG8_LDB
#undef PG8_MMA
#undef PG8_WAIT_V
#undef PG8_WAIT_L
#undef PG8_BAR
#undef PG8_SCHED
#undef PG8_TOKS
}
}

struct Ctx {
    LAS unsigned char* lds; int tid, lane, wave, bid, G;
    const float* in[26]; float* out; unsigned char* ws;
};
#define IN_X 0
#define IN_C 1
#define IN_CTX 2
#define IN_CCTX 3
#define IN_WMOD 4
#define IN_BMOD 5
#define IN_NORM1 6
#define IN_WIN 7
#define IN_GKUP 8
#define IN_GKB 9
#define IN_GLANORM 10
#define IN_CONVW 11
#define IN_CONVB 12
#define IN_DTBIAS 13
#define IN_ALOG 14
#define IN_SSDD 15
#define IN_SSDNORM 16
#define IN_WOUT 17
#define IN_NORM2 18
#define IN_WR 19
#define IN_BR 20
#define IN_WGU 21
#define IN_BGU 22
#define IN_WD 23
#define IN_BD 24
#define IN_FNORM 25

__device__ __forceinline__ int map_in(int n) {
    if (n < 1536) return n;
    if (n < 3072) return n + 16;
    if (n < 3088) return n - 1536;
    if (n < 3096) return n;
    return -1;
}
__device__ __forceinline__ void tr_item(const float* W, int N, int k0, int sc, bf16_t* WT, LAS float* scr, int lane) {
#pragma unroll 8
    for (int i = 0; i < 32; ++i) { const int kk = 2 * i + (lane >> 5); scr[kk * 33 + (lane & 31)] = (sc >= 0) ? W[(size_t)(k0 + kk) * N + sc] : 0.f; }
    LDS_WAIT(); asm volatile("" ::: "memory");
    const int c = lane & 7;
#pragma unroll
    for (int j = 0; j < 4; ++j) { const int n = (lane >> 3) + 8 * j; const LAS float* s = scr + (8 * c) * 33 + n;
        u32x4 o; o.x = pk2(s[0 * 33], s[1 * 33]); o.y = pk2(s[2 * 33], s[3 * 33]); o.z = pk2(s[4 * 33], s[5 * 33]); o.w = pk2(s[6 * 33], s[7 * 33]);
        *(u32x4*)(WT + (size_t)n * 1024 + k0 + 8 * c) = o; }
    LDS_WAIT(); asm volatile("" ::: "memory");
}

__device__ __forceinline__ void ph_prologue(Ctx& F) {
    float* mod = (float*)(F.ws + WS_MOD);
    for (int item = F.bid; item < 192; item += F.G) {
        LAS float* sc = (LAS float*)F.lds;
        for (int i = F.tid; i < 5 * 1024; i += 512) { const int j = i >> 10, k = i & 1023; const float v = (j < 4) ? F.in[IN_C][j * 1024 + k] : F.in[IN_CCTX][k]; sc[i] = silu_f(v); }
        __syncthreads();
        const int nn = F.tid & 31, kq = F.tid >> 5, n = item * 32 + nn;
        float a0 = 0.f, a1 = 0.f, a2 = 0.f, a3 = 0.f, a4 = 0.f;
        const float* wm = F.in[IN_WMOD];
#pragma unroll 8
        for (int i = 0; i < 64; ++i) { const int k = kq + 16 * i; const float w = wm[(size_t)k * 6144 + n];
            a0 += sc[k] * w; a1 += sc[1024 + k] * w; a2 += sc[2048 + k] * w; a3 += sc[3072 + k] * w; a4 += sc[4096 + k] * w; }
        LAS float* red = (LAS float*)(F.lds + 20480);
        red[(kq * 5 + 0) * 32 + nn] = a0; red[(kq * 5 + 1) * 32 + nn] = a1; red[(kq * 5 + 2) * 32 + nn] = a2; red[(kq * 5 + 3) * 32 + nn] = a3; red[(kq * 5 + 4) * 32 + nn] = a4;
        __syncthreads();
        if (F.tid < 160) { const int j = F.tid >> 5; float s = F.in[IN_BMOD][n];
            for (int q = 0; q < 16; ++q) s += red[(q * 5 + j) * 32 + nn];
            mod[j * 6144 + n] = s; }
        __syncthreads();
    }
    LAS float* scr = (LAS float*)(F.lds + F.wave * 16384);
    const int gw = F.bid * 8 + F.wave, NGW = F.G * 8;
    constexpr int I_IN = 16 * (NP / 32), I_OUT = 16 * 32, I_GU = NEXP * 16 * 64, I_D = NEXP * 16 * 32;
    bf16_t* WinT = (bf16_t*)(F.ws + WS_WIN); bf16_t* WoutT = (bf16_t*)(F.ws + WS_WOUT); bf16_t* WguT = (bf16_t*)(F.ws + WS_WGU); bf16_t* WdT = (bf16_t*)(F.ws + WS_WD);
    for (int it = gw; it < I_IN + I_OUT + I_GU + I_D; it += NGW) {
        int r = it; const int l31 = F.lane & 31;
        if (r < I_IN) { const int nb = r % (NP / 32), kb = r / (NP / 32); tr_item(F.in[IN_WIN], 3096, kb * 64, map_in(nb * 32 + l31), WinT + (size_t)nb * 32 * 1024, scr, F.lane); continue; } r -= I_IN;
        if (r < I_OUT) { const int nb = r % 32, kb = r / 32; tr_item(F.in[IN_WOUT], 1024, kb * 64, nb * 32 + l31, WoutT + (size_t)nb * 32 * 1024, scr, F.lane); continue; } r -= I_OUT;
        if (r < I_GU) { const int e = r / (16 * 64), q = r % (16 * 64), nb = q % 64, kb = q / 64; const int n0 = nb * 32, tile = n0 >> 8, w = n0 & 255;
            const int sc0 = (w < 128) ? tile * 128 + w : 1024 + tile * 128 + (w - 128);
            tr_item(F.in[IN_WGU] + (size_t)e * 1024 * 2048, 2048, kb * 64, sc0 + l31, WguT + ((size_t)e * 2048 + n0) * 1024, scr, F.lane); continue; } r -= I_GU;
        { const int e = r / (16 * 32), q = r % (16 * 32), nb = q % 32, kb = q / 32;
            tr_item(F.in[IN_WD] + (size_t)e * 1024 * 1024, 1024, kb * 64, nb * 32 + l31, WdT + ((size_t)e * 1024 + nb * 32) * 1024, scr, F.lane); }
    }
}

__device__ __forceinline__ void ph_norm1(Ctx& F) {
    const float* mod = (const float*)(F.ws + WS_MOD); bf16_t* H = (bf16_t*)(F.ws + WS_H);
    const int gw = F.bid * 8 + F.wave, NGW = F.G * 8;
    for (int r = gw; r < TT; r += NGW) {
        const float* src = (r < TL) ? F.in[IN_X] + (size_t)r * DM : F.in[IN_CTX] + (size_t)(r - TL) * DM;
        const int j = (r < TL) ? (r >> 13) : 4;
        const float* sh = mod + j * 6144; const float* scl = sh + 1024;
        f32x4 v[4]; float ss = 0.f;
#pragma unroll
        for (int q = 0; q < 4; ++q) { v[q] = ((const f32x4*)src)[F.lane + 64 * q]; ss += (v[q].x * v[q].x + v[q].y * v[q].y) + (v[q].z * v[q].z + v[q].w * v[q].w); }
        const float rstd = rsqrtf(wave_sum(ss) * (1.f / DM) + EPS);
#pragma unroll
        for (int q = 0; q < 4; ++q) { const int idx = 4 * (F.lane + 64 * q);
            const f32x4 w = *(const f32x4*)(F.in[IN_NORM1] + idx), s1 = *(const f32x4*)(scl + idx), h1 = *(const f32x4*)(sh + idx);
            const f32x4 o = (v[q] * rstd * w) * (s1 + 1.0f) + h1;
            u32x2 pk; pk.x = pk2(o.x, o.y); pk.y = pk2(o.z, o.w);
            *(u32x2*)(H + (size_t)r * DM + idx) = pk; }
    }
}

__device__ __forceinline__ void ph_conv_g(Ctx& F) {
    const bf16_t* P = (const bf16_t*)(F.ws + WS_P); bf16_t* XBC = (bf16_t*)(F.ws + WS_XBC);
    const float* cw = F.in[IN_CONVW]; const float* cbias = F.in[IN_CONVB];
    for (int grp = F.bid; grp < TT / 4; grp += F.G) {
        const int r = grp * 4 + (F.tid >> 7), ch = (F.tid & 127) * 8;
        float a[8];
#pragma unroll
        for (int i = 0; i < 8; ++i) a[i] = cbias[ch + i];
        if (r < TL) {
            const int b = r >> 13, t = r & 8191, gy = t >> 6, gx = t & 63;
#pragma unroll
            for (int ky = 0; ky < 3; ++ky)
#pragma unroll
                for (int kx = 0; kx < 3; ++kx) { const int yy = gy + ky - 1, xx = gx + kx - 1;
                    if (yy >= 0 && yy < 128 && xx >= 0 && xx < 64) {
                        const u32x4 v = *(const u32x4*)(P + (size_t)(b * 8192 + yy * 64 + xx) * NP + CX + ch);
                        const float* w = cw + (ky * 3 + kx) * 1024 + ch;
                        a[0] += bflo(v.x) * w[0]; a[1] += bfhi(v.x) * w[1]; a[2] += bflo(v.y) * w[2]; a[3] += bfhi(v.y) * w[3];
                        a[4] += bflo(v.z) * w[4]; a[5] += bfhi(v.z) * w[5]; a[6] += bflo(v.w) * w[6]; a[7] += bfhi(v.w) * w[7]; } }
        } else {
            const int rr = r - TL, b = rr >> 8, t = rr & 255;
#pragma unroll
            for (int kx = 0; kx < 3; ++kx) { const int tt = t + kx - 1;
                if (tt >= 0 && tt < 256) {
                    const u32x4 v = *(const u32x4*)(P + (size_t)(TL + b * 256 + tt) * NP + CX + ch);
                    const float* w = cw + (3 + kx) * 1024 + ch;
                    a[0] += bflo(v.x) * w[0]; a[1] += bfhi(v.x) * w[1]; a[2] += bflo(v.y) * w[2]; a[3] += bfhi(v.y) * w[3];
                    a[4] += bflo(v.z) * w[4]; a[5] += bfhi(v.z) * w[5]; a[6] += bflo(v.w) * w[6]; a[7] += bfhi(v.w) * w[7]; } }
        }
        u32x4 o; o.x = pk2(silu_f(a[0]), silu_f(a[1])); o.y = pk2(silu_f(a[2]), silu_f(a[3])); o.z = pk2(silu_f(a[4]), silu_f(a[5])); o.w = pk2(silu_f(a[6]), silu_f(a[7]));
        *(u32x4*)(XBC + (size_t)r * 1024 + ch) = o;
    }
    float* Gb = (float*)(F.ws + WS_G);
    LAS float* gk = (LAS float*)F.lds;
    const int dir = F.tid >> 8, d = F.tid & 255;
    float wcol[16];
#pragma unroll
    for (int k = 0; k < 16; ++k) wcol[k] = F.in[IN_GKUP][(dir * 16 + k) * 256 + d];
    const float bias = F.in[IN_GKB][dir * 256 + d];
    for (int tile = F.bid; tile < TT / 64; tile += F.G) {
        const int r0 = tile * 64;
        __syncthreads();
        if (F.tid < 128) { const int tok = F.tid >> 1, hf = F.tid & 1; const u32x4 v = *(const u32x4*)(P + (size_t)(r0 + tok) * NP + CGK + hf * 8);
            LAS float* o = gk + tok * 16 + hf * 8; o[0] = bflo(v.x); o[1] = bfhi(v.x); o[2] = bflo(v.y); o[3] = bfhi(v.y); o[4] = bflo(v.z); o[5] = bfhi(v.z); o[6] = bflo(v.w); o[7] = bfhi(v.w); }
        __syncthreads();
        for (int tok = 0; tok < 64; ++tok) { float xx = bias;
#pragma unroll
            for (int k = 0; k < 16; ++k) xx += gk[tok * 16 + k] * wcol[k];
            Gb[((size_t)dir * TT + r0 + tok) * 256 + d] = logsigmoid_f(xx) * (1.f / 16.f); }
    }
}

__device__ __forceinline__ int scan_row(int b, int dir, int s) {
    if (s < CTXL) { const int t = dir ? (CTXL - 1 - s) : s; return TL + b * CTXL + t; }
    const int s2 = s - CTXL; const int t = dir ? (SEQ - 1 - s2) : s2; return b * SEQ + t;
}

__device__ __forceinline__ void ph_scan_naive(Ctx& F) {
    const bf16_t* P = (const bf16_t*)(F.ws + WS_P); const bf16_t* XBC = (const bf16_t*)(F.ws + WS_XBC); const float* Gb = (const float*)(F.ws + WS_G);
    bf16_t* OG = (bf16_t*)(F.ws + WS_OG); bf16_t* OS = (bf16_t*)(F.ws + WS_OS);
    constexpr int NSTEP = CTXL + SEQ, BT = 16;
    for (int item = F.bid; item < 96; item += F.G) {
        if (item < 32) {
            const int b = item >> 3, h = (item >> 1) & 3, dir = item & 1;
            LAS float* qs = (LAS float*)F.lds; LAS float* ks = qs + BT * 64; LAS float* as = ks + BT * 64; LAS float* vs = as + BT * 64;
            const int v = F.tid >> 2, d0 = (F.tid & 3) * 16;
            float S[16];
#pragma unroll
            for (int d = 0; d < 16; ++d) S[d] = 0.f;
#pragma unroll 1
            for (int s0 = 0; s0 < NSTEP; s0 += BT) {
                __syncthreads();
#pragma unroll 1
                for (int i = F.tid; i < BT * 64; i += 512) { const int tk = i >> 6, d = i & 63; const int row = scan_row(b, dir, s0 + tk);
                    qs[i] = bf2f(P[(size_t)row * NP + CQ + h * 64 + d]) * 0.125f; ks[i] = bf2f(P[(size_t)row * NP + CK + h * 64 + d]);
                    as[i] = __expf(Gb[((size_t)dir * TT + row) * 256 + h * 64 + d]); }
#pragma unroll 1
                for (int i = F.tid; i < BT * 128; i += 512) { const int tk = i >> 7, vv = i & 127; const int row = scan_row(b, dir, s0 + tk); vs[i] = bf2f(P[(size_t)row * NP + CV + h * 128 + vv]); }
                __syncthreads();
#pragma unroll 1
                for (int tk = 0; tk < BT; ++tk) { const float vt = vs[tk * 128 + v]; float o = 0.f;
#pragma unroll
                    for (int d = 0; d < 16; ++d) { S[d] = as[tk * 64 + d0 + d] * S[d] + ks[tk * 64 + d0 + d] * vt; o += qs[tk * 64 + d0 + d] * S[d]; }
                    o += __shfl_xor(o, 1); o += __shfl_xor(o, 2);
                    const int row = scan_row(b, dir, s0 + tk);
                    if (row < TL && (F.tid & 3) == 0) OG[((size_t)dir * TL + row) * 512 + h * 128 + v] = (bf16_t)f2bf(o); }
            }
        } else {
            const int it = item - 32, b = it >> 4, hh = (it >> 1) & 7, dir = it & 1, g = hh >> 2;
            LAS float* Bs = (LAS float*)F.lds; LAS float* Cs = Bs + BT * 128; LAS float* xs = Cs + BT * 128; LAS float* dts = xs + BT * 64; LAS float* das = dts + BT;
            const int pp = F.tid >> 3, sb = (F.tid & 7) * 16;
            const float Ah = -__expf(F.in[IN_ALOG][dir * 8 + hh]), dtb = F.in[IN_DTBIAS][dir * 8 + hh];
            float S[16];
#pragma unroll
            for (int s = 0; s < 16; ++s) S[s] = 0.f;
#pragma unroll 1
            for (int s0 = 0; s0 < NSTEP; s0 += BT) {
                __syncthreads();
#pragma unroll 1
                for (int i = F.tid; i < BT * 128; i += 512) { const int tk = i >> 7, ss = i & 127; const int row = scan_row(b, dir, s0 + tk);
                    Bs[i] = bf2f(XBC[(size_t)row * 1024 + 512 + g * 128 + ss]); Cs[i] = bf2f(XBC[(size_t)row * 1024 + 768 + g * 128 + ss]); }
#pragma unroll 1
                for (int i = F.tid; i < BT * 64; i += 512) { const int tk = i >> 6, c = i & 63; const int row = scan_row(b, dir, s0 + tk); xs[i] = bf2f(XBC[(size_t)row * 1024 + hh * 64 + c]); }
                if (F.tid < BT) { const int row = scan_row(b, dir, s0 + F.tid);
                    const float dt = softplus_f(bf2f(P[(size_t)row * NP + CDT + hh]) + dtb);
                    dts[F.tid] = dt; das[F.tid] = __expf(dt * Ah); }
                __syncthreads();
#pragma unroll 1
                for (int tk = 0; tk < BT; ++tk) { const float dt = dts[tk], dA = das[tk]; const float xdt = xs[tk * 64 + pp] * dt; float y = 0.f;
#pragma unroll
                    for (int s = 0; s < 16; ++s) { S[s] = dA * S[s] + xdt * Bs[tk * 128 + sb + s]; y += Cs[tk * 128 + sb + s] * S[s]; }
                    y += __shfl_xor(y, 1); y += __shfl_xor(y, 2); y += __shfl_xor(y, 4);
                    const int row = scan_row(b, dir, s0 + tk);
                    if (row < TL && (F.tid & 7) == 0) OS[((size_t)dir * TL + row) * 512 + hh * 64 + pp] = (bf16_t)f2bf(y); }
            }
        }
        __syncthreads();
    }
}

__device__ __forceinline__ void ph_combine(Ctx& F) {
    const bf16_t* P = (const bf16_t*)(F.ws + WS_P); const bf16_t* XBC = (const bf16_t*)(F.ws + WS_XBC);
    const bf16_t* OG = (const bf16_t*)(F.ws + WS_OG); const bf16_t* OS = (const bf16_t*)(F.ws + WS_OS); bf16_t* Y = (bf16_t*)(F.ws + WS_Y);
    const int gw = F.bid * 8 + F.wave, NGW = F.G * 8, l = F.lane;
    for (int r = gw; r < TL; r += NGW) {
        float v[16]; const bool gla = l < 32; const int c0 = gla ? 16 * l : 16 * (l - 32);
        const bf16_t* o0 = (gla ? OG : OS) + (size_t)r * 512 + c0; const bf16_t* o1 = o0 + (size_t)TL * 512;
        const bf16_t* gz = P + (size_t)r * NP + (gla ? CG : CZ) + c0;
        u32x4 a0 = *(const u32x4*)o0, a1 = *(const u32x4*)(o0 + 8), b0 = *(const u32x4*)o1, b1 = *(const u32x4*)(o1 + 8), g0 = *(const u32x4*)gz, g1 = *(const u32x4*)(gz + 8);
        float gt[16];
#define UNP(dst, w0, w1) dst[0] = bflo(w0.x); dst[1] = bfhi(w0.x); dst[2] = bflo(w0.y); dst[3] = bfhi(w0.y); dst[4] = bflo(w0.z); dst[5] = bfhi(w0.z); dst[6] = bflo(w0.w); dst[7] = bfhi(w0.w); \
        dst[8] = bflo(w1.x); dst[9] = bfhi(w1.x); dst[10] = bflo(w1.y); dst[11] = bfhi(w1.y); dst[12] = bflo(w1.z); dst[13] = bfhi(w1.z); dst[14] = bflo(w1.w); dst[15] = bfhi(w1.w)
        float t0[16], t1[16]; UNP(t0, a0, a1); UNP(t1, b0, b1); UNP(gt, g0, g1);
#pragma unroll
        for (int i = 0; i < 16; ++i) v[i] = t0[i] + t1[i];
        if (!gla) { const u32x4 x0 = *(const u32x4*)(XBC + (size_t)r * 1024 + c0), x1 = *(const u32x4*)(XBC + (size_t)r * 1024 + c0 + 8); float xv[16]; UNP(xv, x0, x1);
            const float Dh = F.in[IN_SSDD][c0 >> 6];
#pragma unroll
            for (int i = 0; i < 16; ++i) v[i] = (v[i] + Dh * xv[i]) * silu_f(gt[i]); }
        float ss = 0.f;
#pragma unroll
        for (int i = 0; i < 16; ++i) ss += v[i] * v[i];
        ss += __shfl_xor(ss, 1); ss += __shfl_xor(ss, 2); ss += __shfl_xor(ss, 4);
        const float s8 = __shfl_xor(ss, 8); if (!gla) ss += s8;
        const float rstd = rsqrtf(ss * (gla ? (1.f / 128.f) : (1.f / 256.f)) + EPS);
        const float* nw = gla ? F.in[IN_GLANORM] + (c0 & 127) : F.in[IN_SSDNORM] + c0;
        float o[16];
#pragma unroll
        for (int i = 0; i < 16; ++i) { float y = v[i] * rstd * nw[i]; if (gla) y *= silu_f(gt[i]); o[i] = y; }
        u32x4 w0, w1; w0.x = pk2(o[0], o[1]); w0.y = pk2(o[2], o[3]); w0.z = pk2(o[4], o[5]); w0.w = pk2(o[6], o[7]); w1.x = pk2(o[8], o[9]); w1.y = pk2(o[10], o[11]); w1.z = pk2(o[12], o[13]); w1.w = pk2(o[14], o[15]);
        bf16_t* yp = Y + (size_t)r * 1024 + (gla ? 0 : 512) + c0;
        *(u32x4*)yp = w0; *(u32x4*)(yp + 8) = w1;
    }
}

constexpr int WRS = 1028;
__device__ __forceinline__ void ph_router(Ctx& F) {
    const float* mod = (const float*)(F.ws + WS_MOD); bf16_t* H2 = (bf16_t*)(F.ws + WS_H);
    unsigned* ctl = (unsigned*)(F.ws + WS_CTL);
    int* tok_e = (int*)(F.ws + WS_TOKE); int* tok_p = (int*)(F.ws + WS_TOKP); float* tok_g = (float*)(F.ws + WS_TOKG); int* rowtok = (int*)(F.ws + WS_ROWTOK);
    LAS float* wrT = (LAS float*)F.lds;
    LAS int* lcnt = (LAS int*)(F.lds + MISC_OFF);
    LAS int* gbase = lcnt + 32;
    LAS int* rec_e = gbase + 32;
    LAS int* rec_p = rec_e + 512;
    if (F.bid == 0) { for (int i = F.tid; i < 512; i += 512) ((unsigned*)(H2 + (size_t)ZROW * DM))[i] = 0u; }
    for (int i = F.tid; i < 1024 * 32; i += 512) { const int k = i >> 5, e = i & 31; wrT[e * WRS + k] = F.in[IN_WR][i]; }
    if (F.tid < 32) lcnt[F.tid] = 0;
    __syncthreads();
    for (int tile = F.bid; tile < TL / 128; tile += F.G) {
        for (int j = 0; j < 16; ++j) {
            const int tl = F.wave * 16 + j, r = tile * 128 + tl;
            const float* src = F.out + (size_t)r * DM; const int b = r >> 13;
            const float* sh = mod + b * 6144 + 3 * 1024; const float* scl = sh + 1024;
            f32x4 v[4]; float ss = 0.f;
#pragma unroll
            for (int q = 0; q < 4; ++q) { v[q] = ((const f32x4*)src)[F.lane + 64 * q]; ss += (v[q].x * v[q].x + v[q].y * v[q].y) + (v[q].z * v[q].z + v[q].w * v[q].w); }
            const float rstd = rsqrtf(wave_sum(ss) * (1.f / DM) + EPS);
#pragma unroll
            for (int q = 0; q < 4; ++q) { const int idx = 4 * (F.lane + 64 * q);
                const f32x4 w = *(const f32x4*)(F.in[IN_NORM2] + idx), s1 = *(const f32x4*)(scl + idx), h1 = *(const f32x4*)(sh + idx);
                v[q] = (v[q] * rstd * w) * (s1 + 1.0f) + h1;
                u32x2 pk; pk.x = pk2(v[q].x, v[q].y); pk.y = pk2(v[q].z, v[q].w);
                *(u32x2*)(H2 + (size_t)r * DM + idx) = pk; }
            float lg[32];
#pragma unroll
            for (int e = 0; e < 32; ++e) { float a = 0.f;
#pragma unroll
                for (int q = 0; q < 4; ++q) { const f32x4 w = *(const LAS f32x4*)(wrT + e * WRS + 4 * (F.lane + 64 * q)); a += (v[q].x * w.x + v[q].y * w.y) + (v[q].z * w.z + v[q].w * w.w); }
                lg[e] = wave_sum(a) + F.in[IN_BR][e]; }
            int ei[4]; float ev[4];
#pragma unroll
            for (int k = 0; k < 4; ++k) { float best = -3.0e38f; int bi = 0;
#pragma unroll
                for (int e = 0; e < 32; ++e) { if (lg[e] > best) { best = lg[e]; bi = e; } }
#pragma unroll
                for (int e = 0; e < 32; ++e) lg[e] = (e == bi) ? -3.3e38f : lg[e];
                ei[k] = bi; ev[k] = best; }
            const float e1 = __expf(ev[1] - ev[0]), e2 = __expf(ev[2] - ev[0]), e3 = __expf(ev[3] - ev[0]); const float inv = 1.f / (1.f + e1 + e2 + e3);
            if (F.lane == 0) {
                const float gts[4] = {inv, e1 * inv, e2 * inv, e3 * inv};
#pragma unroll
                for (int k = 0; k < 4; ++k) { const int lp = __hip_atomic_fetch_add(lcnt + ei[k], 1, __ATOMIC_RELAXED, __HIP_MEMORY_SCOPE_WORKGROUP);
                    rec_e[tl * 4 + k] = ei[k]; rec_p[tl * 4 + k] = lp; tok_g[(size_t)r * 4 + k] = gts[k]; }
            }
        }
        __syncthreads();
        if (F.tid < 32) gbase[F.tid] = (int)__hip_atomic_fetch_add(ctl + CW_CNT + 64 * F.tid, (unsigned)lcnt[F.tid], __ATOMIC_RELAXED, __HIP_MEMORY_SCOPE_AGENT);
        __syncthreads();
        { const int tl = F.tid >> 2, r = tile * 128 + tl; const int e = rec_e[F.tid], pos = gbase[e] + rec_p[F.tid];
          tok_e[(size_t)r * 4 + (F.tid & 3)] = e; tok_p[(size_t)r * 4 + (F.tid & 3)] = pos; rowtok[(size_t)e * TL + pos] = r; }
        __syncthreads();
        if (F.tid < 32) lcnt[F.tid] = 0;
        __syncthreads();
    }
}

__device__ __forceinline__ void moe_tables(Ctx& F, LAS int*& cn, LAS int*& tb) {
    const unsigned* ctl = (const unsigned*)(F.ws + WS_CTL);
    cn = (LAS int*)(F.lds + MISC_OFF); tb = cn + 32;
    __syncthreads();
    if (F.tid < 32) cn[F.tid] = (int)__hip_atomic_load(ctl + CW_CNT + 64 * F.tid, __ATOMIC_RELAXED, __HIP_MEMORY_SCOPE_AGENT);
    __syncthreads();
    if (F.tid == 0) { int s = 0; for (int e = 0; e < 32; ++e) { tb[e] = s; s += (cn[e] + 255) >> 8; } tb[32] = s; }
    __syncthreads();
}

__device__ __forceinline__ void ph_final(Ctx& F) {
    LAS int* cn; LAS int* tb; moe_tables(F, cn, tb);
    const float* mod = (const float*)(F.ws + WS_MOD); const bf16_t* YP = (const bf16_t*)(F.ws + WS_YP);
    const int* tok_e = (const int*)(F.ws + WS_TOKE); const int* tok_p = (const int*)(F.ws + WS_TOKP); const float* tok_g = (const float*)(F.ws + WS_TOKG);
    const int gw = F.bid * 8 + F.wave, NGW = F.G * 8;
    for (int r = gw; r < TL; r += NGW) {
        const int b = r >> 13; const float* g2 = mod + b * 6144 + 5 * 1024;
        f32x4 m[4];
#pragma unroll
        for (int q = 0; q < 4; ++q) m[q] = (f32x4){0.f, 0.f, 0.f, 0.f};
#pragma unroll
        for (int k = 0; k < 4; ++k) { const int e = tok_e[(size_t)r * 4 + k], pos = tok_p[(size_t)r * 4 + k]; const float gt = tok_g[(size_t)r * 4 + k];
            const bf16_t* yr = YP + ((size_t)tb[e] * 256 + pos) * DM;
#pragma unroll
            for (int q = 0; q < 4; ++q) { const u32x2 w = *(const u32x2*)(yr + 4 * (F.lane + 64 * q)); m[q] += (f32x4){bflo(w.x), bfhi(w.x), bflo(w.y), bfhi(w.y)} * gt; } }
        f32x4 v[4]; float ss = 0.f;
#pragma unroll
        for (int q = 0; q < 4; ++q) { const int idx = 4 * (F.lane + 64 * q); v[q] = ((const f32x4*)(F.out + (size_t)r * DM))[F.lane + 64 * q] + *(const f32x4*)(g2 + idx) * m[q];
            ss += (v[q].x * v[q].x + v[q].y * v[q].y) + (v[q].z * v[q].z + v[q].w * v[q].w); }
        const float rstd = rsqrtf(wave_sum(ss) * (1.f / DM) + EPS);
#pragma unroll
        for (int q = 0; q < 4; ++q) { const int idx = 4 * (F.lane + 64 * q); ((f32x4*)(F.out + (size_t)r * DM))[F.lane + 64 * q] = v[q] * rstd * *(const f32x4*)(F.in[IN_FNORM] + idx); }
    }
}

constexpr int NPHASE = 11;
__global__ void __launch_bounds__(512, 2) mega(Params p) {
    extern __shared__ __attribute__((aligned(16))) unsigned char lds_raw[];
    Ctx F;
    F.lds = (LAS unsigned char*)lds_raw; F.tid = threadIdx.x; F.lane = F.tid & 63; F.wave = __builtin_amdgcn_readfirstlane(F.tid >> 6); F.bid = blockIdx.x; F.G = gridDim.x;
#pragma unroll
    for (int i = 0; i < 26; ++i) F.in[i] = p.in[i];
    F.out = p.out; F.ws = p.ws;
    const int lo = p.ph_lo, hi = p.ph_hi;
#ifndef PH_MASK
#define PH_MASK 0x7ff
#endif
#define IN(k) (((PH_MASK >> (k)) & 1) && lo <= (k) && (k) < hi)
#if MK_FUSED
#define SEAM(k) do { if (IN(k) && IN((k) + 1)) { cg::this_grid().sync(); } } while (0)
#else
#define SEAM(k) do { } while (0)
#endif
    if (IN(0)) { ph_prologue(F); } SEAM(0);
    if (IN(1)) { ph_norm1(F); } SEAM(1);
    if (IN(2)) {
        pg8::DenseOrder S{TT / 256, NP / 256, F.G, F.bid, (const char*)(F.ws + WS_WIN)};
        pg8::EpiBf16 E{(bf16_t*)(F.ws + WS_P), NP, nullptr, 0};
        pg8::gemm_phase<pg8::EpiBf16, pg8::DenseOrder, true>(F.lds, (const bf16_t*)(F.ws + WS_H), S, E);
    } SEAM(2);
    if (IN(3)) { ph_conv_g(F); } SEAM(3);
    if (IN(4)) { ph_scan_naive(F); } SEAM(4);
    if (IN(5)) { ph_combine(F); } SEAM(5);
    if (IN(6)) {
        pg8::DenseOrder S{TL / 256, DM / 256, F.G, F.bid, (const char*)(F.ws + WS_WOUT)};
        pg8::EpiResGate E{F.in[IN_X], F.out, (const float*)(F.ws + WS_MOD)};
        pg8::gemm_phase<pg8::EpiResGate, pg8::DenseOrder, true>(F.lds, (const bf16_t*)(F.ws + WS_Y), S, E);
    } SEAM(6);
    if (IN(7)) { ph_router(F); } SEAM(7);
    if (IN(8)) {
        LAS int* cn; LAS int* tb; moe_tables(F, cn, tb);
        pg8::MoeOrder<true> S{__builtin_amdgcn_readfirstlane(tb[32]), 8, F.G, F.bid, (const char*)(F.ws + WS_WGU), 2048, tb, cn, (const int*)(F.ws + WS_ROWTOK)};
        pg8::EpiSwiglu E{(bf16_t*)(F.ws + WS_ACT), F.in[IN_BGU]};
        pg8::gemm_phase<pg8::EpiSwiglu, pg8::MoeOrder<true>, true>(F.lds, (const bf16_t*)(F.ws + WS_H), S, E);
    } SEAM(8);
    if (IN(9)) {
        LAS int* cn; LAS int* tb; moe_tables(F, cn, tb);
        pg8::MoeOrder<false> S{__builtin_amdgcn_readfirstlane(tb[32]), 4, F.G, F.bid, (const char*)(F.ws + WS_WD), 1024, tb, cn, nullptr};
        pg8::EpiBf16 E{(bf16_t*)(F.ws + WS_YP), DM, F.in[IN_BD], 1024};
        pg8::gemm_phase<pg8::EpiBf16, pg8::MoeOrder<false>, true>(F.lds, (const bf16_t*)(F.ws + WS_ACT), S, E);
    } SEAM(9);
    if (IN(10)) { ph_final(F); }
#undef IN
#undef SEAM
}

extern "C" void kernel_launch(void* const* d_in, const int* in_sizes, int n_in, void* d_out, int out_size, void* d_ws, size_t ws_size, hipStream_t stream) {
    static int grid = 0;
    if (grid == 0) {
        if (n_in != 26 || out_size != TL * DM || ws_size < WS_END) { fprintf(stderr, "kernel_launch: unexpected problem (n_in %d, out %d, ws %zu)\n", n_in, out_size, ws_size); grid = -1; return; }
        int dev = 0, cus = 0, per_cu = 0;
        if (hipGetDevice(&dev) != hipSuccess || hipDeviceGetAttribute(&cus, hipDeviceAttributeMultiprocessorCount, dev) != hipSuccess) { grid = -1; return; }
        if (hipFuncSetAttribute((const void*)mega, hipFuncAttributeMaxDynamicSharedMemorySize, LDS_BYTES) != hipSuccess) { fprintf(stderr, "kernel_launch: hipFuncSetAttribute failed\n"); grid = -1; return; }
        if (hipOccupancyMaxActiveBlocksPerMultiprocessor(&per_cu, (const void*)mega, 512, LDS_BYTES) != hipSuccess || per_cu < 1) { fprintf(stderr, "kernel_launch: occupancy query says %d\n", per_cu); per_cu = 1; }
        (void)hipGetLastError();
        grid = cus;
    }
    if (grid < 0) return;
    (void)hipMemsetAsync((char*)d_ws + WS_CTL, 0, CTL_BYTES, stream);
    Params a{};
    for (int i = 0; i < 26; ++i) a.in[i] = (const float*)d_in[i];
    a.out = (float*)d_out; a.ws = (unsigned char*)d_ws;
#if MK_FUSED
    a.ph_lo = 0; a.ph_hi = NPHASE;
    void* args[] = {&a};
    hipError_t e = hipLaunchCooperativeKernel((const void*)mega, dim3(grid), dim3(512), args, LDS_BYTES, stream);
    if (e != hipSuccess) fprintf(stderr, "cooperative launch failed: %s (grid %d)\n", hipGetErrorString(e), grid);
#else
    for (int ph = 0; ph < NPHASE; ++ph) {
        a.ph_lo = ph; a.ph_hi = ph + 1;
        hipLaunchKernelGGL(mega, dim3(grid), dim3(512), LDS_BYTES, stream, a);
    }
#endif
}
```

```cpp
#include <hip/hip_runtime.h>
#include <hip/hip_cooperative_groups.h>
#include <cstdio>
#include <cstdint>
namespace cg = cooperative_groups;

#ifndef MK_FUSED
#define MK_FUSED 1
#endif
#ifndef MK_NAIVE_SCAN
#define MK_NAIVE_SCAN 0
#endif

#define LAS __attribute__((address_space(3)))
#define GAS __attribute__((address_space(1)))
typedef unsigned short bf16_t;
typedef short bf16x8 __attribute__((ext_vector_type(8)));
typedef float f32x4 __attribute__((ext_vector_type(4)));
typedef float f32x2 __attribute__((ext_vector_type(2)));
typedef unsigned u32x4 __attribute__((ext_vector_type(4)));
typedef unsigned u32x2 __attribute__((ext_vector_type(2)));

constexpr int NB = 4, SEQ = 8192, CTXL = 256, DM = 1024;
constexpr int TL = NB * SEQ;
constexpr int TCX = NB * CTXL;
constexpr int TT = TL + TCX;
constexpr int NP = 3328;
constexpr int CQ = 0, CK = 256, CV = 512, CG = 1024, CZ = 1536, CX = 2048, CGK = 3072, CDT = 3088;
constexpr int NEXP = 32, DFF = 1024;
constexpr float EPS = 1e-6f;
constexpr int MAXTILES = 544;
constexpr int ZROW = TL;

constexpr size_t MiB = 1u << 20;
constexpr size_t WS_CTL = 0, CTL_BYTES = 1 * MiB;
constexpr size_t WS_MOD = 1 * MiB;
constexpr size_t WS_WIN = 2 * MiB;
constexpr size_t WS_WOUT = 9 * MiB;
constexpr size_t WS_WGU = 11 * MiB;
constexpr size_t WS_WD = 139 * MiB;
constexpr size_t WS_TOKE = 203 * MiB;
constexpr size_t WS_TOKP = WS_TOKE + 512 * 1024;
constexpr size_t WS_TOKG = WS_TOKP + 512 * 1024;
constexpr size_t WS_ROWTOK = 205 * MiB;
constexpr size_t WS_H = 209 * MiB;
constexpr size_t WS_P = 276 * MiB;
constexpr size_t WS_XBC = 491 * MiB;
constexpr size_t WS_G = 557 * MiB;
constexpr size_t WS_OG = 623 * MiB;
constexpr size_t WS_OS = 687 * MiB;
constexpr size_t WS_Y = 751 * MiB;
constexpr size_t WS_ACT = 276 * MiB;
constexpr size_t WS_YP = 548 * MiB;
constexpr size_t WS_USG = 820 * MiB;
constexpr size_t WS_SSG = 837 * MiB;
constexpr size_t WS_USS = 853 * MiB;
constexpr size_t WS_SSS = 887 * MiB;
constexpr size_t WS_ASG = 919 * MiB;
constexpr size_t WS_ASS = 920 * MiB;
constexpr size_t WS_X1 = WS_OS;
constexpr size_t WS_END = 921 * MiB;
static_assert(WS_YP + (size_t)MAXTILES * 256 * 1024 <= WS_X1, "x1 buffer clear of the fp8 Yp overlay");
static_assert(WS_P + (size_t)TT * NP * 2 <= WS_XBC && WS_XBC + (size_t)TT * 1024 * 2 <= WS_G && WS_G + (size_t)2 * TT * 256 * 4 <= WS_OG, "ws map");
static_assert(WS_ACT + (size_t)MAXTILES * 256 * 2048 <= WS_YP && WS_YP + (size_t)MAXTILES * 256 * 2048 <= WS_END, "ws map 2");
static_assert(WS_H + (size_t)(TT + 256) * 2048 <= WS_P, "ws map 3");
constexpr int CW_CNT = 1024;
constexpr int CW_BAR = 8192;
constexpr int CW_SB = 12288;
constexpr size_t CTL_ZERO = 65536;
static_assert((CW_BAR + 3456) <= CW_SB && (CW_SB + 4096) * 4 <= (int)CTL_ZERO && (CW_CNT + 64 * 32) * 4 <= (int)CTL_ZERO, "control words inside the per-call memset");

constexpr int RING_BYTES = 131072;
constexpr int MISC_OFF = 132096;
constexpr int LDS_BYTES = 147456;

struct Params { const float* in[26]; float* out; unsigned char* ws; int ph_lo, ph_hi; };

__device__ __forceinline__ unsigned f2bf(float f) { unsigned u = __builtin_bit_cast(unsigned, f); return (u + 0x7fffu + ((u >> 16) & 1u)) >> 16; }
typedef __bf16 bf16x2_t __attribute__((ext_vector_type(2)));
__device__ __forceinline__ unsigned pk2(float lo, float hi) { const f32x2 v = {lo, hi}; const bf16x2_t b = __builtin_convertvector(v, bf16x2_t); return __builtin_bit_cast(unsigned, b); }
__device__ __forceinline__ unsigned pk2(float lo, float hi);
__device__ __forceinline__ float bflo(unsigned w);
__device__ __forceinline__ float bfhi(unsigned w);
__device__ __forceinline__ f32x4 ld_bf4(const bf16_t* p) { const u32x2 w = *(const u32x2*)p; return (f32x4){bflo(w.x), bfhi(w.x), bflo(w.y), bfhi(w.y)}; }
__device__ __forceinline__ void st_bf4(bf16_t* p, f32x4 v) { u32x2 w; w.x = pk2(v.x, v.y); w.y = pk2(v.z, v.w); *(u32x2*)p = w; }
__device__ __forceinline__ float bf2f(unsigned short h) { return __builtin_bit_cast(float, (unsigned)h << 16); }
__device__ __forceinline__ float bflo(unsigned w) { return __builtin_bit_cast(float, w << 16); }
__device__ __forceinline__ float bfhi(unsigned w) { return __builtin_bit_cast(float, w & 0xffff0000u); }
__device__ __forceinline__ float wave_sum(float v) {
#pragma unroll
    for (int o = 1; o < 64; o <<= 1) v += __shfl_xor(v, o);
    return v;
}
__device__ __forceinline__ float silu_f(float v) { return v * __builtin_amdgcn_rcpf(1.f + __builtin_amdgcn_exp2f(-1.4426950408889634f * v)); }
__device__ __forceinline__ float sigmoid_f(float v) { return 1.f / (1.f + __expf(-v)); }
__device__ __forceinline__ float softplus_f(float v) { return fmaxf(v, 0.f) + log1pf(__expf(-fabsf(v))); }
__device__ __forceinline__ float logsigmoid_f(float v) { return fminf(v, 0.f) - log1pf(__expf(-fabsf(v))); }
#define LDS_WAIT() asm volatile("s_waitcnt lgkmcnt(0)" ::: "memory")
#define LBAR() asm volatile("s_waitcnt lgkmcnt(0)\n\ts_barrier" ::: "memory")

namespace pg8 {
constexpr int BM = 256, BK = 64, HALF = 128, HTB = HALF * BK * 2, STAGE_BYTES = 8 * HTB, NXCD = 8, WGM = 8;
constexpr int KD = 1024;
typedef int i32x4 __attribute__((ext_vector_type(4)));
typedef int i32x8 __attribute__((ext_vector_type(8)));
#ifndef PG8_XORSWZ
#define PG8_XORSWZ 1
#endif
#if PG8_XORSWZ
__host__ __device__ __forceinline__ int lds_byte(int r, int c) { return r * 128 + ((((c >> 3) ^ (r >> 1)) & 7) << 4) + (c & 7) * 2; }
__host__ __device__ __forceinline__ void stage_rc(int b, int& R, int& C) { R = b >> 7; C = ((((b >> 4) ^ (R >> 1)) & 7) << 3); }
#else
__host__ __device__ __forceinline__ int lds_byte(int r, int c) { const int st = (r >> 4) * 2 + (c >> 5), rr = r & 15, cc = c & 31, ob = rr * 64 + cc * 2; return st * 1024 + (ob ^ (((ob >> 9) & 1) << 5)); }
__host__ __device__ __forceinline__ void stage_rc(int b, int& R, int& C) { const int st = b / 1024, sb = b % 1024, swz = sb ^ (((sb >> 9) & 1) << 5); R = (st >> 1) * 16 + swz / 64; C = (st & 1) * 32 + (swz % 64) / 2; }
#endif
__host__ __device__ __forceinline__ int perm32(int rho) { const int n = rho >> 4, i = rho & 15; return 8 * (i >> 2) + 4 * n + (i & 3); }

struct Unit { int pm, pn, e, mt; };

__device__ __forceinline__ void tile_of(int L, int nM, int nN, int& pm, int& pn) {
    const int nwg = nM * nN; int wgid = L;
    { const int q = nwg / NXCD, r = nwg % NXCD, xcd = wgid % NXCD, off = wgid / NXCD; wgid = (xcd < r ? xcd * (q + 1) : r * (q + 1) + (xcd - r) * q) + off; }
    const int nig = WGM * nN, gid = wgid / nig, fm = gid * WGM, gsz = (nM - fm) < WGM ? (nM - fm) : WGM;
    pm = fm + ((wgid % nig) % gsz); pn = (wgid % nig) / gsz;
}
struct DenseOrder {
    static constexpr bool GATHER = false;
    int nM, nN, G, c; const char* Bt; unsigned rowb; int dup; int i0 = 0, i1 = 1 << 20;
    __device__ __forceinline__ bool next(int i, Unit& u) const { i += i0; const long L = (long)i * G + c; if (i >= i1 || L >= (long)nM * nN * dup) return false; tile_of((int)L, nM, nN * dup, u.pm, u.pn); u.pn %= nN; u.e = 0; u.mt = u.pm; return true; }
    __device__ __forceinline__ const char* bbase(const Unit& u) const { return Bt + (size_t)u.pn * BM * rowb; }
    __device__ __forceinline__ unsigned arow(const Unit& u, int rl) const { return 0u; }
};
template <bool GATHER_> struct MoeOrder {
    static constexpr bool GATHER = GATHER_;
    int nMt, nN, G, c; const char* Bt; int brows; const LAS int* tb; const LAS int* cn; const int* rowtok; unsigned rowb; int rot;
    __device__ __forceinline__ void chunk(int& nxc, int& rank, int& m0, int& nMx) const {
        const int NC = G < NXCD ? G : NXCD, x = c % NC; nxc = (G - x + NC - 1) / NC; rank = c / NC;
        const int qm = nMt / NC, rm = nMt % NC; nMx = qm + (x < rm ? 1 : 0); m0 = x * qm + (x < rm ? x : rm);
    }
    __device__ __forceinline__ int trips() const { int nxc, rank, m0, nMx; chunk(nxc, rank, m0, nMx); return (nMx * nN + nxc - 1) / nxc; }
    __device__ __forceinline__ bool next(int i, Unit& u) const {
        int nxc, rank, m0, nMx; chunk(nxc, rank, m0, nMx);
        rank = (rank + nxc - (nMx * rot) % nxc) % nxc;
        const int off = i * nxc + rank; if (off >= nMx * nN) return false;
        const int nig = WGM * nN, gid = off / nig, fm = gid * WGM, gsz = (nMx - fm) < WGM ? (nMx - fm) : WGM;
        u.pm = m0 + fm + ((off % nig) % gsz); u.pn = (off % nig) / gsz;
        int e = 0;
#pragma unroll
        for (int q = 1; q < NEXP; ++q) e += (tb[q] <= u.pm) ? 1 : 0;
        e = __builtin_amdgcn_readfirstlane(e); u.e = e; u.mt = u.pm - __builtin_amdgcn_readfirstlane(tb[e]); return true;
    }
    __device__ __forceinline__ int last_trip_of(int pm, int nNp) const {
        int nxc, rank, m0, nMx; chunk(nxc, rank, m0, nMx);
        const int loc = pm - m0, gid = loc / WGM, fm = gid * WGM, gsz = (nMx - fm) < WGM ? (nMx - fm) : WGM;
        return (gid * (WGM * nNp) + (nNp - 1) * gsz + (loc - fm)) / nxc;
    }
    __device__ __forceinline__ const char* bbase(const Unit& u) const { return Bt + (size_t)(u.e * brows + u.pn * BM) * rowb; }
    __device__ __forceinline__ unsigned arow(const Unit& u, int rl) const {
        const int pos = u.mt * BM + rl; const int lim = __builtin_amdgcn_readfirstlane(cn[u.e]); int tok = ZROW; if (pos < lim) tok = rowtok[u.e * TL + pos]; return (unsigned)tok;
    }
};
struct NoSync { static constexpr bool ARRIVE = false, WAIT = false; };

__device__ __forceinline__ unsigned cvt_pk_bf16(float lo, float hi) { unsigned r; asm volatile("v_cvt_pk_bf16_f32 %0, %1, %2" : "=v"(r) : "v"(lo), "v"(hi)); return r; }

struct EpiBf16 {
    static constexpr bool PERM = true, LDSBIAS = false;
    bf16_t* O; int ldc; const float* bias; int bstride; float scale;
    __device__ __forceinline__ void operator()(const f32x4 (&acc)[2][2][4][2], const Unit& u, int wr, int wc, int fr, int fq) const {
        const int row0 = u.pm * BM + wr * 64 + fr; const int col0 = u.pn * BM + wc * 32 + 8 * fq;
        f32x4 bv[2][2];
#pragma unroll
        for (int bj = 0; bj < 2; ++bj)
#pragma unroll
            for (int n = 0; n < 2; ++n) bv[bj][n] = bias ? *(const f32x4*)(bias + (size_t)u.e * bstride + col0 + bj * HALF + 4 * n) : (f32x4){0.f, 0.f, 0.f, 0.f};
#pragma unroll
        for (int ai = 0; ai < 2; ++ai)
#pragma unroll
            for (int m = 0; m < 4; ++m) { bf16_t* rowp = O + (size_t)(row0 + ai * HALF + m * 16) * ldc + col0;
#pragma unroll
                for (int bj = 0; bj < 2; ++bj) { const f32x4 v0 = acc[ai][bj][m][0] * scale + bv[bj][0], v1 = acc[ai][bj][m][1] * scale + bv[bj][1];
                    u32x4 w; w.x = cvt_pk_bf16(v0[0], v0[1]); w.y = cvt_pk_bf16(v0[2], v0[3]); w.z = cvt_pk_bf16(v1[0], v1[1]); w.w = cvt_pk_bf16(v1[2], v1[3]);
                    *(u32x4*)(rowp + bj * HALF) = w; } }
    }
};
__device__ __forceinline__ float clamp448(float v) { return __builtin_amdgcn_fmed3f(v, -448.f, 448.f); }
__device__ __forceinline__ unsigned pk4_fp8(float a, float b, float c, float d) {
    int w = 0; w = __builtin_amdgcn_cvt_pk_fp8_f32(clamp448(a), clamp448(b), w, false); w = __builtin_amdgcn_cvt_pk_fp8_f32(clamp448(c), clamp448(d), w, true); return (unsigned)w; }
__device__ __forceinline__ unsigned pk4_fp8_nc(float a, float b, float c, float d) {
    int w = 0; w = __builtin_amdgcn_cvt_pk_fp8_f32(a, b, w, false); w = __builtin_amdgcn_cvt_pk_fp8_f32(c, d, w, true); return (unsigned)w; }
struct EpiFp8 {
    static constexpr bool PERM = true;
    static constexpr bool LDSBIAS = true;
    unsigned char* O; int ldc; const float* bias; int bstride; float scale, oscale; LAS float* biasl;
    __device__ __forceinline__ const char* bias_src(const Unit& u, int lane) const { return (const char*)(bias + (size_t)u.e * bstride + u.pn * BM) + (unsigned)(16 * lane); }
    __device__ __forceinline__ void operator()(const f32x4 (&acc)[2][2][4][2], const Unit& u, int wr, int wc, int fr, int fq) const {
        const int row0 = u.pm * BM + wr * 64 + fr; const int col0 = u.pn * BM + wc * 32 + 8 * fq;
        f32x4 bv[2][2];
#pragma unroll
        for (int bj = 0; bj < 2; ++bj)
#pragma unroll
            for (int n = 0; n < 2; ++n) bv[bj][n] = *(const LAS f32x4*)(biasl + wc * 32 + 8 * fq + bj * HALF + 4 * n) * oscale;
        const float so = scale * oscale;
#pragma unroll
        for (int ai = 0; ai < 2; ++ai)
#pragma unroll
            for (int m = 0; m < 4; ++m) { unsigned char* rowp = O + (size_t)(row0 + ai * HALF + m * 16) * ldc + col0;
#pragma unroll
                for (int bj = 0; bj < 2; ++bj) { const f32x4 v0 = acc[ai][bj][m][0] * so + bv[bj][0], v1 = acc[ai][bj][m][1] * so + bv[bj][1];
                    u32x2 w; w.x = pk4_fp8(v0[0], v0[1], v0[2], v0[3]); w.y = pk4_fp8(v1[0], v1[1], v1[2], v1[3]);
                    *(u32x2*)(rowp + bj * HALF) = w; } }
    }
};
struct EpiSwiglu {
    static constexpr bool PERM = true;
    static constexpr bool LDSBIAS = true;
    unsigned char* O; const float* bias; float scale, oscale; LAS float* biasl;
    __device__ __forceinline__ const char* bias_src(const Unit& u, int lane) const { return (const char*)(bias + (size_t)u.e * 2048 + u.pn * HALF) + (unsigned)((lane >> 5) * 4096 + 16 * (lane & 31)); }
    __device__ __forceinline__ void operator()(const f32x4 (&acc)[2][2][4][2], const Unit& u, int wr, int wc, int fr, int fq) const {
        const int row0 = u.pm * BM + wr * 64 + fr; const int ff0 = u.pn * HALF + wc * 32 + 8 * fq;
        f32x4 bg[2], bu[2];
#pragma unroll
        for (int n = 0; n < 2; ++n) { bg[n] = *(const LAS f32x4*)(biasl + wc * 32 + 8 * fq + 4 * n); bu[n] = *(const LAS f32x4*)(biasl + HALF + wc * 32 + 8 * fq + 4 * n); }
        const f32x4 os4 = (f32x4){oscale, oscale, oscale, oscale};
#pragma unroll
        for (int ai = 0; ai < 2; ++ai)
#pragma unroll
            for (int m = 0; m < 4; ++m) { unsigned char* rowp = O + (size_t)(row0 + ai * HALF + m * 16) * DFF + ff0;
                float r[8];
#pragma unroll
                for (int n = 0; n < 2; ++n) {
                    f32x4 g = acc[ai][0][m][n] * scale + bg[n]; f32x4 up = acc[ai][1][m][n] * scale + bu[n];
                    g.x = fminf(g.x, 7.f); g.y = fminf(g.y, 7.f); g.z = fminf(g.z, 7.f); g.w = fminf(g.w, 7.f);
                    up.x = __builtin_amdgcn_fmed3f(up.x, -7.f, 7.f); up.y = __builtin_amdgcn_fmed3f(up.y, -7.f, 7.f); up.z = __builtin_amdgcn_fmed3f(up.z, -7.f, 7.f); up.w = __builtin_amdgcn_fmed3f(up.w, -7.f, 7.f);
                    const f32x4 tz = g * -2.4554669595930157f;
                    f32x4 d; d.x = __builtin_amdgcn_exp2f(tz.x); d.y = __builtin_amdgcn_exp2f(tz.y); d.z = __builtin_amdgcn_exp2f(tz.z); d.w = __builtin_amdgcn_exp2f(tz.w);
                    d = d + 1.0f;
                    f32x4 rc; rc.x = __builtin_amdgcn_rcpf(d.x); rc.y = __builtin_amdgcn_rcpf(d.y); rc.z = __builtin_amdgcn_rcpf(d.z); rc.w = __builtin_amdgcn_rcpf(d.w);
                    const f32x4 o = (up * os4 + os4) * (g * rc);
                    r[4 * n] = o.x; r[4 * n + 1] = o.y; r[4 * n + 2] = o.z; r[4 * n + 3] = o.w; }
                u32x2 w; w.x = pk4_fp8_nc(r[0], r[1], r[2], r[3]); w.y = pk4_fp8_nc(r[4], r[5], r[6], r[7]);
                *(u32x2*)rowp = w; }
    }
};
struct EpiResGate {
    static constexpr bool PERM = false, LDSBIAS = false;
    const float* x; bf16_t* out; const float* mod;
    __device__ __forceinline__ void operator()(const f32x4 (&acc)[2][2][4][2], const Unit& u, int wr, int wc, int fr, int fq) const {
        const int row0 = u.pm * BM + wr * 64 + fr, col0 = u.pn * BM + wc * 32 + 4 * fq;
        const float* g1 = mod + (size_t)((u.pm * BM) >> 13) * 6144 + 2048;
        f32x4 gv[2][2];
#pragma unroll
        for (int bj = 0; bj < 2; ++bj)
#pragma unroll
            for (int n = 0; n < 2; ++n) gv[bj][n] = *(const f32x4*)(g1 + col0 + bj * HALF + n * 16);
#pragma unroll
        for (int ai = 0; ai < 2; ++ai)
#pragma unroll
            for (int m = 0; m < 4; ++m) { const size_t off = (size_t)(row0 + ai * HALF + m * 16) * DM + col0;
#pragma unroll
                for (int bj = 0; bj < 2; ++bj)
#pragma unroll
                    for (int n = 0; n < 2; ++n) { const f32x4 xv = *(const f32x4*)(x + off + bj * HALF + n * 16);
                        const f32x4 o = xv + gv[bj][n] * acc[ai][bj][m][n]; u32x2 w; w.x = cvt_pk_bf16(o[0], o[1]); w.y = cvt_pk_bf16(o[2], o[3]);
                        *(u32x2*)(out + off + bj * HALF + n * 16) = w; } }
    }
};

template <class Epi, class Sched, bool ALIGN_EPI, bool FP8 = false, class Sync = NoSync>
__device__ __forceinline__ void gemm_phase(LAS unsigned char* lds, const bf16_t* Aglob, const Sched& S, const Epi& E, Sync* Y = nullptr) {
    const int tid = threadIdx.x, wid = __builtin_amdgcn_readfirstlane(tid >> 6), lane = tid & 63, wr = wid >> 2, wc = wid & 3, fr = lane & 15, fq = lane >> 4;
    constexpr int nt = FP8 ? KD / (2 * BK) : KD / BK;
    constexpr unsigned ROWB = FP8 ? KD : KD * 2; constexpr int RSH = FP8 ? 10 : 11;
    unsigned voffA[2], voffB[2];
#pragma unroll
    for (int i = 0; i < 2; ++i) { int R, C; stage_rc(tid * 16 + i * 8192, R, C); const int Rb = Epi::PERM ? ((R & ~31) + perm32(R & 31)) : R;
        voffA[i] = (unsigned)R * ROWB + (unsigned)C * 2u; voffB[i] = (unsigned)Rb * ROWB + (unsigned)C * 2u; }
    constexpr size_t kstep = (size_t)(BK * 2);
    constexpr size_t hstep = (size_t)HALF * ROWB;
    constexpr size_t tstep = 2 * hstep;
    const unsigned ldsw = (unsigned)wid * 1024u;
    const int aoff = lds_byte(wr * 64 + fr, fq * 8), boff = lds_byte(wc * 32 + fr, fq * 8);
    const int aoff1 = lds_byte(wr * 64 + fr, 32 + fq * 8), boff1 = lds_byte(wc * 32 + fr, 32 + fq * 8);
    const char* Ab = (const char*)Aglob;
#define PG8_SA(b, h) (((b) * 2 + (h)) * HTB)
#define PG8_SB(b, h) ((4 + (b) * 2 + (h)) * HTB)
#define PG8_STAGE_B(bufoff, gbase) do { _Pragma("unroll") for (int _i = 0; _i < 2; ++_i) \
        __builtin_amdgcn_global_load_lds((const unsigned*)((const char*)(gbase) + voffB[_i]), (LAS unsigned*)(lds + (bufoff) + ldsw + _i * 8192), 16, 0, 0); } while (0)
#define PG8_STAGE_A(bufoff, pa, tk, h, kb) do { _Pragma("unroll") for (int _i = 0; _i < 2; ++_i) { \
        const char* _src = Sched::GATHER ? (Ab + (kb) + (size_t)((((tk)[_i] >> (16 * (h))) & 0xffffu) * ROWB + (voffA[_i] & 127u))) : ((pa) + (size_t)(h) * hstep + (kb) + voffA[_i]); \
        __builtin_amdgcn_global_load_lds((const unsigned*)_src, (LAS unsigned*)(lds + (bufoff) + ldsw + _i * 8192), 16, 0, 0); } } while (0)
#define PG8_LD8(p0, p1) __builtin_shufflevector(*(const LAS i32x4*)(p0), *(const LAS i32x4*)(p1), 0, 1, 2, 3, 4, 5, 6, 7)
#define PG8_LDA(dst, b, h) do { _Pragma("unroll") for (int m = 0; m < 4; ++m) dst[m] = PG8_LD8(lds + PG8_SA(b, h) + aoff + m * 2048, lds + PG8_SA(b, h) + aoff1 + m * 2048); } while (0)
#define PG8_LDB(dst, b, h) do { _Pragma("unroll") for (int n = 0; n < 2; ++n) dst[n] = PG8_LD8(lds + PG8_SB(b, h) + boff + n * 2048, lds + PG8_SB(b, h) + boff1 + n * 2048); } while (0)
#define PG8_LO(x) __builtin_bit_cast(bf16x8, __builtin_shufflevector(x, x, 0, 1, 2, 3))
#define PG8_HI(x) __builtin_bit_cast(bf16x8, __builtin_shufflevector(x, x, 4, 5, 6, 7))
#define PG8_MMA(ai, bj, At, Bt) do { __builtin_amdgcn_s_setprio(1); _Pragma("unroll") for (int m = 0; m < 4; ++m) _Pragma("unroll") for (int n = 0; n < 2; ++n) { \
        if constexpr (FP8) asm volatile("v_mfma_scale_f32_16x16x128_f8f6f4 %0, %1, %2, %0, %3, %3 op_sel_hi:[0,0,0]" : "+v"(acc[ai][bj][m][n]) : "v"(Bt[n]), "v"(At[m]), "v"(sc127)); \
        else { acc[ai][bj][m][n] = __builtin_amdgcn_mfma_f32_16x16x32_bf16(PG8_LO(Bt[n]), PG8_LO(At[m]), acc[ai][bj][m][n], 0, 0, 0); \
               acc[ai][bj][m][n] = __builtin_amdgcn_mfma_f32_16x16x32_bf16(PG8_HI(Bt[n]), PG8_HI(At[m]), acc[ai][bj][m][n], 0, 0, 0); } } \
        __builtin_amdgcn_s_setprio(0); } while (0)
#define PG8_WAIT_V(n) asm volatile("s_waitcnt vmcnt(" #n ")" ::: "memory")
#define PG8_WAIT_L(n) asm volatile("s_waitcnt lgkmcnt(" #n ")" ::: "memory")
#define PG8_BAR __builtin_amdgcn_s_barrier()
#define PG8_SCHED __builtin_amdgcn_sched_barrier(0)
#define PG8_TOKS(dst, u) do { if constexpr (Sched::GATHER) { _Pragma("unroll") for (int _i = 0; _i < 2; ++_i) { const int _R = (int)(voffA[_i] >> RSH); \
        dst[_i] = S.arow(u, _R) | (S.arow(u, HALF + _R) << 16); } } } while (0)
    Unit cur, nxt; int ui = 0;
    if (!S.next(0, cur)) return;
    if constexpr (Sync::WAIT) { if (!Y->done && Y->need(cur)) { if (tid == 0) Y->wait(); __builtin_amdgcn_s_barrier(); Y->done = true; } }
    unsigned sc127 = 0u; if constexpr (FP8) asm volatile("v_mov_b32 %0, 0x7f7f7f7f" : "=v"(sc127));
    f32x4 acc[2][2][4][2];
#pragma unroll
    for (int a = 0; a < 2; ++a)
#pragma unroll
        for (int b = 0; b < 2; ++b)
#pragma unroll
            for (int m = 0; m < 4; ++m)
#pragma unroll
                for (int n = 0; n < 2; ++n) acc[a][b][m][n] = (f32x4){0.f, 0.f, 0.f, 0.f};
    i32x8 At[4], B0[2], B1[2];
    unsigned tokC[2] = {0u, 0u}, tokN[2] = {0u, 0u};
    PG8_TOKS(tokC, cur);
    const char* cA = Ab + (size_t)cur.pm * tstep;
    const char* cB = S.bbase(cur);
    PG8_STAGE_B(PG8_SB(0, 0), cB); PG8_STAGE_B(PG8_SB(0, 1), cB + hstep); PG8_STAGE_A(PG8_SA(0, 0), cA, tokC, 0, 0); PG8_STAGE_A(PG8_SA(0, 1), cA, tokC, 1, 0);
    if (wr == 1) PG8_BAR;
    PG8_WAIT_V(2); PG8_BAR;
    PG8_STAGE_B(PG8_SB(1, 0), cB + kstep); PG8_STAGE_A(PG8_SA(1, 0), cA, tokC, 0, kstep); PG8_STAGE_B(PG8_SB(1, 1), cB + hstep + kstep);
    PG8_WAIT_V(6); PG8_BAR;
    for (;;) {
        const bool has_next = S.next(ui + 1, nxt);
        if constexpr (Sync::WAIT) { if (has_next && !Y->done && Y->need(nxt)) { if (tid == 0) Y->wait(); PG8_BAR; Y->done = true; } }
        const char* nA = has_next ? Ab + (size_t)nxt.pm * tstep : cA; const char* nB = has_next ? S.bbase(nxt) : cB;
#pragma unroll 1
        for (int t = 0; t < nt; t += 2) {
            const bool last = (t == nt - 2);
            if constexpr (Epi::LDSBIAS) { if (last && wid == 0) __builtin_amdgcn_global_load_lds((const unsigned*)E.bias_src(cur, lane), (LAS unsigned*)E.biasl, 16, 0, 0); }
            if (last) { if (has_next) { PG8_TOKS(tokN, nxt); } else { tokN[0] = tokC[0]; tokN[1] = tokC[1]; } }
            const size_t k1 = (size_t)(t + 1) * kstep;
            const size_t k2 = last ? 0 : (size_t)(t + 2) * kstep, k3 = k2 + kstep;
            const char* a2 = last ? nA : cA;
            const char* b2 = last ? nB : cB + (size_t)(t + 2) * kstep; const char* b3 = b2 + kstep;
            PG8_LDB(B0, 0, 0); PG8_LDB(B1, 0, 1); PG8_SCHED; PG8_LDA(At, 0, 0); PG8_STAGE_A(PG8_SA(1, 1), cA, tokC, 1, k1);
            PG8_WAIT_V(8); PG8_WAIT_L(0); PG8_BAR; PG8_MMA(0, 0, At, B0); PG8_MMA(0, 1, At, B1); PG8_BAR; PG8_SCHED;
            if (last) { tokC[0] = tokN[0]; tokC[1] = tokN[1]; }
            PG8_LDA(At, 0, 1); PG8_STAGE_B(PG8_SB(0, 0), b2); PG8_STAGE_B(PG8_SB(0, 1), b2 + hstep); PG8_STAGE_A(PG8_SA(0, 0), a2, tokC, 0, k2);
            PG8_WAIT_V(8); PG8_WAIT_L(0); PG8_BAR; PG8_MMA(1, 0, At, B0); PG8_MMA(1, 1, At, B1); PG8_BAR; PG8_SCHED;
            PG8_LDB(B0, 1, 0); PG8_LDB(B1, 1, 1); PG8_SCHED; PG8_LDA(At, 1, 0); PG8_STAGE_A(PG8_SA(0, 1), a2, tokC, 1, k2);
            PG8_WAIT_V(8); PG8_WAIT_L(0); PG8_BAR; PG8_MMA(0, 0, At, B0); PG8_MMA(0, 1, At, B1); PG8_BAR; PG8_SCHED;
            PG8_LDA(At, 1, 1); PG8_STAGE_B(PG8_SB(1, 0), b3); PG8_STAGE_B(PG8_SB(1, 1), b3 + hstep); PG8_STAGE_A(PG8_SA(1, 0), a2, tokC, 0, k3);
            PG8_WAIT_V(8); PG8_WAIT_L(0); PG8_BAR; PG8_MMA(1, 0, At, B0); PG8_MMA(1, 1, At, B1); PG8_BAR; PG8_SCHED;
        }
        if constexpr (ALIGN_EPI) { if (wr == 0) PG8_BAR; }
        if constexpr (Sync::ARRIVE) { static_assert(ALIGN_EPI, "aligned epilogue"); if (ui == Y->a1) { PG8_WAIT_V(0); PG8_BAR; if (tid == 0) Y->arrive(); Y->done = true; } }
        if constexpr (FP8) asm volatile("s_nop 15\n\ts_nop 15" ::: "memory");
        E(acc, cur, wr, wc, fr, fq);
        if (!has_next) break;
#pragma unroll
        for (int a = 0; a < 2; ++a)
#pragma unroll
            for (int b = 0; b < 2; ++b)
#pragma unroll
                for (int m = 0; m < 4; ++m)
#pragma unroll
                    for (int n = 0; n < 2; ++n) acc[a][b][m][n] = (f32x4){0.f, 0.f, 0.f, 0.f};
        cur = nxt; cA = nA; cB = nB; ++ui;
        if constexpr (ALIGN_EPI) { if (wr == 1) PG8_BAR; }
    }
    PG8_WAIT_V(0);
    if constexpr (!ALIGN_EPI) { if (wr == 0) PG8_BAR; }
    PG8_BAR;
#undef PG8_SA
#undef PG8_SB
#undef PG8_STAGE_A
#undef PG8_STAGE_B
#undef PG8_LDA
#undef PG8_LDB
#undef PG8_MMA
#undef PG8_LD8
#undef PG8_LO
#undef PG8_HI
#undef PG8_WAIT_V
#undef PG8_WAIT_L
#undef PG8_BAR
#undef PG8_SCHED
#undef PG8_TOKS
}
}

#define XB_TMO      128
#define XB_XCNT(j)  (256  + 64 * (j))
#define XB_XSUB(j)  (1280 + 64 * (j))
#define XB_XGEN(j)  (2304 + 64 * (j))
#define XB_TOP      3328
#define XB_TOPGEN   3392
#define XCD_BAR_WORDS 3456
#define XB_SPIN_CAP (1u << 18)

__device__ __forceinline__ unsigned xb_ld(unsigned* p)              { return __hip_atomic_load(p, __ATOMIC_RELAXED, __HIP_MEMORY_SCOPE_AGENT); }
__device__ __forceinline__ unsigned xb_add(unsigned* p, unsigned v) { return __hip_atomic_fetch_add(p, v, __ATOMIC_RELAXED, __HIP_MEMORY_SCOPE_AGENT); }
__device__ __forceinline__ unsigned xb_xcc_id() { return (unsigned)__builtin_amdgcn_s_getreg((3 << 11) | 20) & 0xFu; }
#define XB_SPIN(cond, bar) do { unsigned _sp = 0; while (cond) { __builtin_amdgcn_s_sleep(1); \
    if ((++_sp & 255u) == 0u) { if (xb_ld(&(bar)[XB_TMO])) break; if (_sp > XB_SPIN_CAP) { atomicAdd(&(bar)[XB_TMO], 1u); break; } } } } while (0)

struct XcdBarrier {
    unsigned* bar; unsigned x;
    volatile LAS unsigned* st;
};

__device__ __forceinline__ XcdBarrier xcd_barrier_post(unsigned* bar, volatile LAS unsigned* st) {
    XcdBarrier b; b.bar = bar; b.x = xb_xcc_id(); b.st = st;
    if (threadIdx.x == 0) (void)xb_add(&bar[XB_XCNT(b.x)], 1u);
    return b;
}
__device__ __forceinline__ void xcd_barrier_complete(unsigned* bar, unsigned x, unsigned& nloc, unsigned& nx) {
    const unsigned G = gridDim.x * gridDim.y * gridDim.z;
    unsigned sum, cnt, mine, sp = 0u;
    for (;;) {
        sum = 0u; cnt = 0u; mine = 0u;
#pragma unroll
        for (unsigned j = 0; j < 16; ++j) { const unsigned c = xb_ld(&bar[XB_XCNT(j)]); sum += c; cnt += (c > 0u) ? 1u : 0u; mine = (j == x) ? c : mine; }
        if (sum == G) break;
        __builtin_amdgcn_s_sleep(1);
        if ((++sp & 255u) == 0u) { if (xb_ld(&bar[XB_TMO])) break; if (sp > XB_SPIN_CAP) { atomicAdd(&bar[XB_TMO], 1u); break; } }
    }
    nloc = mine > 0u ? mine : 1u; nx = cnt > 0u ? cnt : 1u;
}

__device__ __forceinline__ void xcd_barrier(const XcdBarrier& b) {
    asm volatile("s_waitcnt vmcnt(0)" ::: "memory");
    __syncthreads();
    if (threadIdx.x == 0) {
        unsigned* bar = b.bar;
        __builtin_amdgcn_s_waitcnt(0);
        unsigned nloc = b.st[0], nx = b.st[1];
        if (nloc == 0u) { xcd_barrier_complete(bar, b.x, nloc, nx); b.st[0] = nloc; b.st[1] = nx; }
        const unsigned old = xb_add(&bar[XB_XSUB(b.x)], 1u);
        const unsigned gen = old / nloc;
        if (old + 1u == (gen + 1u) * nloc) {
            __builtin_amdgcn_fence(__ATOMIC_RELEASE, "agent");
            asm volatile("s_waitcnt vmcnt(0)" ::: "memory");
            const unsigned og = xb_add(&bar[XB_TOP], 1u);
            const unsigned tg = og / nx;
            if (og + 1u == (tg + 1u) * nx) xb_add(&bar[XB_TOPGEN], 1u);
            else XB_SPIN(xb_ld(&bar[XB_TOPGEN]) == tg, bar);
            __builtin_amdgcn_fence(__ATOMIC_ACQUIRE, "agent");
            xb_add(&bar[XB_XGEN(b.x)], 1u);
            asm volatile("s_waitcnt vmcnt(0)" ::: "memory");
        } else {
            XB_SPIN(xb_ld(&bar[XB_XGEN(b.x)]) == gen, bar);
            __builtin_amdgcn_fence(__ATOMIC_ACQUIRE, "agent");
            asm volatile("s_waitcnt vmcnt(0)" ::: "memory");
        }
    }
    __syncthreads();
}

#define SB_XSUB(j)  (64 * (j))
#define SB_TOP      1024
#define SB_FLAG     1088
__device__ __forceinline__ void sb_arrive(const XcdBarrier& b, unsigned* sb) {
    const unsigned nloc = b.st[0], nx = b.st[1];
    const unsigned old = xb_add(&sb[SB_XSUB(b.x)], 1u);
    if (old + 1u == nloc) {
        __builtin_amdgcn_fence(__ATOMIC_RELEASE, "agent");
        asm volatile("s_waitcnt vmcnt(0)" ::: "memory");
        const unsigned og = xb_add(&sb[SB_TOP], 1u);
        if (og + 1u == nx) xb_add(&sb[SB_FLAG], 1u);
    }
}
__device__ __forceinline__ void sb_wait(const XcdBarrier& b, unsigned* sb) {
    XB_SPIN(xb_ld(&sb[SB_FLAG]) == 0u, b.bar);
    __builtin_amdgcn_fence(__ATOMIC_ACQUIRE, "agent");
    asm volatile("s_waitcnt vmcnt(0)" ::: "memory");
}
struct ArriveSync {
    static constexpr bool ARRIVE = true, WAIT = false;
    const XcdBarrier* b; unsigned* sb; int a1; bool done;
    __device__ __forceinline__ void arrive() const { sb_arrive(*b, sb); }
};
template <class Sched> struct WaitSync {
    static constexpr bool ARRIVE = false, WAIT = true;
    const XcdBarrier* b; unsigned* sb; int a1; bool done; const Sched* S; int nNp;
    __device__ __forceinline__ bool need(const pg8::Unit& u) const { return S->last_trip_of(u.pm, nNp) >= a1; }
    __device__ __forceinline__ void wait() const { sb_wait(*b, sb); }
};

struct Ctx {
    LAS unsigned char* lds; int tid, lane, wave, bid, G;
    const float* const* in; float* out; unsigned char* ws;
};
#define IN_X 0
#define IN_C 1
#define IN_CTX 2
#define IN_CCTX 3
#define IN_WMOD 4
#define IN_BMOD 5
#define IN_NORM1 6
#define IN_WIN 7
#define IN_GKUP 8
#define IN_GKB 9
#define IN_GLANORM 10
#define IN_CONVW 11
#define IN_CONVB 12
#define IN_DTBIAS 13
#define IN_ALOG 14
#define IN_SSDD 15
#define IN_SSDNORM 16
#define IN_WOUT 17
#define IN_NORM2 18
#define IN_WR 19
#define IN_BR 20
#define IN_WGU 21
#define IN_BGU 22
#define IN_WD 23
#define IN_BD 24
#define IN_FNORM 25

__device__ __forceinline__ int map_in(int n) {
    if (n < 1536) return n;
    if (n < 3072) return n + 16;
    if (n < 3088) return n - 1536;
    if (n < 3096) return n;
    return -1;
}
__device__ __forceinline__ void tr_item(const float* W, int N, int k0, int sc, bf16_t* WT, LAS float* scr, int lane) {
#pragma unroll 8
    for (int i = 0; i < 32; ++i) { const int kk = 2 * i + (lane >> 5); scr[kk * 33 + (lane & 31)] = (sc >= 0) ? W[(size_t)(k0 + kk) * N + sc] : 0.f; }
    LDS_WAIT(); asm volatile("" ::: "memory");
    const int c = lane & 7;
#pragma unroll
    for (int j = 0; j < 4; ++j) { const int n = (lane >> 3) + 8 * j; const LAS float* s = scr + (8 * c) * 33 + n;
        u32x4 o; o.x = pk2(s[0 * 33], s[1 * 33]); o.y = pk2(s[2 * 33], s[3 * 33]); o.z = pk2(s[4 * 33], s[5 * 33]); o.w = pk2(s[6 * 33], s[7 * 33]);
        *(u32x4*)(WT + (size_t)n * 1024 + k0 + 8 * c) = o; }
    LDS_WAIT(); asm volatile("" ::: "memory");
}

__device__ __forceinline__ void tr_item8(const float* W, int N, int k0, int sc, unsigned char* WT8, float wscale, LAS float* scr, int lane) {
#pragma unroll 16
    for (int i = 0; i < 64; ++i) { const int kk = 2 * i + (lane >> 5); scr[kk * 33 + (lane & 31)] = W[(size_t)(k0 + kk) * N + sc] * wscale; }
    LDS_WAIT(); asm volatile("" ::: "memory");
    const int c = lane & 7;
#pragma unroll
    for (int j = 0; j < 4; ++j) { const int n = (lane >> 3) + 8 * j; const LAS float* p = scr + (16 * c) * 33 + n;
        u32x4 o; o.x = pg8::pk4_fp8(p[0 * 33], p[1 * 33], p[2 * 33], p[3 * 33]); o.y = pg8::pk4_fp8(p[4 * 33], p[5 * 33], p[6 * 33], p[7 * 33]);
        o.z = pg8::pk4_fp8(p[8 * 33], p[9 * 33], p[10 * 33], p[11 * 33]); o.w = pg8::pk4_fp8(p[12 * 33], p[13 * 33], p[14 * 33], p[15 * 33]);
        *(u32x4*)(WT8 + (size_t)n * 1024 + k0 + 16 * c) = o; }
    LDS_WAIT(); asm volatile("" ::: "memory");
}
constexpr float WSCALE8 = 1024.f, HSCALE8 = 16.f, ASCALE8 = 4.f, PSCALE8 = 32.f;

__device__ __forceinline__ void tr8_load(f32x4 (&v)[16], const float* W, int N, int k0, int n0, int lane) {
    const float* p = W + (size_t)(k0 + (lane >> 3)) * N + n0 + 4 * (lane & 7);
#pragma unroll
    for (int i = 0; i < 16; ++i) v[i] = *(const f32x4*)(p + (size_t)(8 * i) * N);
}
__device__ __forceinline__ void tr8_store(const f32x4 (&v)[16], unsigned char* WT8, int k0, float wscale, LAS float* scr, int lane) {
    LAS float* s = scr + (lane >> 3) * 33 + 4 * (lane & 7);
#pragma unroll
    for (int i = 0; i < 16; ++i) { const f32x4 w = v[i] * wscale; s[(8 * i) * 33 + 0] = w.x; s[(8 * i) * 33 + 1] = w.y; s[(8 * i) * 33 + 2] = w.z; s[(8 * i) * 33 + 3] = w.w; }
    LDS_WAIT(); asm volatile("" ::: "memory");
    const int c = lane & 7;
#pragma unroll
    for (int j = 0; j < 4; ++j) { const int n = (lane >> 3) + 8 * j; const LAS float* p = scr + (16 * c) * 33 + n;
        u32x4 o; o.x = pg8::pk4_fp8(p[0 * 33], p[1 * 33], p[2 * 33], p[3 * 33]); o.y = pg8::pk4_fp8(p[4 * 33], p[5 * 33], p[6 * 33], p[7 * 33]);
        o.z = pg8::pk4_fp8(p[8 * 33], p[9 * 33], p[10 * 33], p[11 * 33]); o.w = pg8::pk4_fp8(p[12 * 33], p[13 * 33], p[14 * 33], p[15 * 33]);
        *(u32x4*)(WT8 + (size_t)n * 1024 + k0 + 16 * c) = o; }
    LDS_WAIT(); asm volatile("" ::: "memory");
}
struct Tr8Item { const float* W; int N, k0, n0; unsigned char* dst; };
__device__ __forceinline__ Tr8Item tr8_decode(const Ctx& F, int r) {
    constexpr int I_GU = NEXP * 8 * 64;
    Tr8Item t;
    if (r < I_GU) { const int e = r / (8 * 64), q = r % (8 * 64), nb = q % 64, kb = q / 64; const int n0 = nb * 32, tile = n0 >> 8, w = n0 & 255;
        t.W = F.in[IN_WGU] + (size_t)e * 1024 * 2048; t.N = 2048; t.k0 = kb * 128; t.n0 = (w < 128) ? tile * 128 + w : 1024 + tile * 128 + (w - 128);
        t.dst = (unsigned char*)(F.ws + WS_WGU) + ((size_t)e * 2048 + n0) * 1024; }
    else { r -= I_GU; const int e = r / (8 * 32), q = r % (8 * 32), nb = q % 32, kb = q / 32;
        t.W = F.in[IN_WD] + (size_t)e * 1024 * 1024; t.N = 1024; t.k0 = kb * 128; t.n0 = nb * 32;
        t.dst = (unsigned char*)(F.ws + WS_WD) + ((size_t)e * 1024 + nb * 32) * 1024; }
    return t;
}
__device__ __forceinline__ void expert_weight_copies(Ctx& F, int c_hi, int n_lo, int n_hi) {
    LAS float* scr = (LAS float*)(F.lds + F.wave * 16896);
    constexpr int NI = NEXP * 8 * 64 + NEXP * 8 * 32;
    const int s0 = F.bid < c_hi ? F.bid * n_lo : c_hi * n_lo + (F.bid - c_hi) * n_hi, ns = F.bid < c_hi ? n_lo : n_hi;
    int lane = F.lane; asm volatile("" : "+v"(lane));
    f32x4 va[16], vb[16];
    int it = s0 * 8 + F.wave; const int hi = (s0 + ns) * 8 < NI ? (s0 + ns) * 8 : NI;
    if (it < hi) { const Tr8Item t = tr8_decode(F, it); tr8_load(va, t.W, t.N, t.k0, t.n0, lane); }
    while (it < hi) {
        const int it2 = it + 8, it3 = it2 + 8;
        if (it2 < hi) { const Tr8Item t = tr8_decode(F, it2); tr8_load(vb, t.W, t.N, t.k0, t.n0, lane); }
        { const Tr8Item t = tr8_decode(F, it); tr8_store(va, t.dst, t.k0, WSCALE8, scr, lane); }
        if (it3 < hi) { const Tr8Item t = tr8_decode(F, it3); tr8_load(va, t.W, t.N, t.k0, t.n0, lane); }
        if (it2 < hi) { const Tr8Item t = tr8_decode(F, it2); tr8_store(vb, t.dst, t.k0, WSCALE8, scr, lane); }
        it = it3;
    }
}
__device__ __forceinline__ void prologue_items(Ctx& F, int part) {
    LAS float* scr = (LAS float*)(F.lds + F.wave * 16896);
    const int gw = F.bid * 8 + F.wave, NGW = F.G * 8;
    constexpr int I_IN = 16 * (NP / 32), I_OUT = 16 * 32, I_GU = NEXP * 8 * 64, I_D = NEXP * 8 * 32;
    bf16_t* WinT = (bf16_t*)(F.ws + WS_WIN); bf16_t* WoutT = (bf16_t*)(F.ws + WS_WOUT); unsigned char* WguT = (unsigned char*)(F.ws + WS_WGU); unsigned char* WdT = (unsigned char*)(F.ws + WS_WD);
    const int lo = part ? I_IN + I_OUT : 0, hi = part ? I_IN + I_OUT + I_GU + I_D : I_IN + I_OUT;
    for (int it = lo + gw; it < hi; it += NGW) {
        int r = it; const int l31 = F.lane & 31;
        if (r < I_IN) { const int nb = r % (NP / 32), kb = r / (NP / 32); tr_item(F.in[IN_WIN], 3096, kb * 64, map_in(nb * 32 + l31), WinT + (size_t)nb * 32 * 1024, scr, F.lane); continue; } r -= I_IN;
        if (r < I_OUT) { const int nb = r % 32, kb = r / 32; tr_item(F.in[IN_WOUT], 1024, kb * 64, nb * 32 + l31, WoutT + (size_t)nb * 32 * 1024, scr, F.lane); continue; } r -= I_OUT;
        if (r < I_GU) { const int e = r / (8 * 64), q = r % (8 * 64), nb = q % 64, kb = q / 64; const int n0 = nb * 32, tile = n0 >> 8, w = n0 & 255;
            const int sc0 = (w < 128) ? tile * 128 + w : 1024 + tile * 128 + (w - 128);
            tr_item8(F.in[IN_WGU] + (size_t)e * 1024 * 2048, 2048, kb * 128, sc0 + l31, WguT + ((size_t)e * 2048 + n0) * 1024, WSCALE8, scr, F.lane); continue; } r -= I_GU;
        { const int e = r / (8 * 32), q = r % (8 * 32), nb = q % 32, kb = q / 32;
            tr_item8(F.in[IN_WD] + (size_t)e * 1024 * 1024, 1024, kb * 128, nb * 32 + l31, WdT + ((size_t)e * 1024 + nb * 32) * 1024, WSCALE8, scr, F.lane); }
    }
}
__device__ __forceinline__ void ph_prologue(Ctx& F) {
    float* mod = (float*)(F.ws + WS_MOD);
    for (int item = F.bid; item < 192; item += F.G) {
        LAS float* sc = (LAS float*)F.lds;
        for (int i = F.tid; i < 5 * 1024; i += 512) { const int j = i >> 10, k = i & 1023; const float v = (j < 4) ? F.in[IN_C][j * 1024 + k] : F.in[IN_CCTX][k]; sc[i] = silu_f(v); }
        __syncthreads();
        const int nn = F.tid & 31, kq = F.tid >> 5, n = item * 32 + nn;
        float a0 = 0.f, a1 = 0.f, a2 = 0.f, a3 = 0.f, a4 = 0.f;
        const float* wm = F.in[IN_WMOD];
#pragma unroll 8
        for (int i = 0; i < 64; ++i) { const int k = kq + 16 * i; const float w = wm[(size_t)k * 6144 + n];
            a0 += sc[k] * w; a1 += sc[1024 + k] * w; a2 += sc[2048 + k] * w; a3 += sc[3072 + k] * w; a4 += sc[4096 + k] * w; }
        LAS float* red = (LAS float*)(F.lds + 20480);
        red[(kq * 5 + 0) * 32 + nn] = a0; red[(kq * 5 + 1) * 32 + nn] = a1; red[(kq * 5 + 2) * 32 + nn] = a2; red[(kq * 5 + 3) * 32 + nn] = a3; red[(kq * 5 + 4) * 32 + nn] = a4;
        __syncthreads();
        if (F.tid < 160) { const int j = F.tid >> 5; float s = F.in[IN_BMOD][n];
            for (int q = 0; q < 16; ++q) s += red[(q * 5 + j) * 32 + nn];
            mod[j * 6144 + n] = s; }
        __syncthreads();
    }
    prologue_items(F, 0);
}
__device__ __forceinline__ void ph_norm1(Ctx& F) {
    const float* mod = (const float*)(F.ws + WS_MOD); bf16_t* H = (bf16_t*)(F.ws + WS_H);
    const int gw = F.bid * 8 + F.wave, NGW = F.G * 8;
    f32x4 nw[4];
#pragma unroll
    for (int q = 0; q < 4; ++q) nw[q] = *(const f32x4*)(F.in[IN_NORM1] + 4 * (F.lane + 64 * q));
    constexpr int U = 2;
    for (int r0 = gw * U; r0 < TT; r0 += NGW * U) {
        f32x4 v[U][4];
#pragma unroll
        for (int u = 0; u < U; ++u) { const int r = r0 + u;
            const float* src = (r < TL) ? F.in[IN_X] + (size_t)r * DM : F.in[IN_CTX] + (size_t)(r - TL) * DM;
#pragma unroll
            for (int q = 0; q < 4; ++q) v[u][q] = ((const f32x4*)src)[F.lane + 64 * q]; }
#pragma unroll
        for (int u = 0; u < U; ++u) { const int r = r0 + u; const int j = (r < TL) ? (r >> 13) : 4;
            const float* sh = mod + j * 6144; const float* scl = sh + 1024;
            float ss = 0.f;
#pragma unroll
            for (int q = 0; q < 4; ++q) ss += (v[u][q].x * v[u][q].x + v[u][q].y * v[u][q].y) + (v[u][q].z * v[u][q].z + v[u][q].w * v[u][q].w);
            const float rstd = rsqrtf(wave_sum(ss) * (1.f / DM) + EPS);
#pragma unroll
            for (int q = 0; q < 4; ++q) { const int idx = 4 * (F.lane + 64 * q);
                const f32x4 s1 = *(const f32x4*)(scl + idx), h1 = *(const f32x4*)(sh + idx);
                const f32x4 o = (v[u][q] * rstd * nw[q]) * (s1 + 1.0f) + h1;
                u32x2 pk; pk.x = pk2(o.x, o.y); pk.y = pk2(o.z, o.w);
                *(u32x2*)(H + (size_t)r * DM + idx) = pk; } }
    }
}

__device__ __forceinline__ void ph_conv_g(Ctx& F) {
    const char* P = (const char*)(F.ws + WS_P); bf16_t* XBC = (bf16_t*)(F.ws + WS_XBC);
    const int ch = (F.tid & 127) * 8, qd = F.tid >> 7;
    f32x2 wgt[9][4];
#pragma unroll
    for (int t = 0; t < 9; ++t) { const f32x4 a = *(const f32x4*)(F.in[IN_CONVW] + t * 1024 + ch), b4 = *(const f32x4*)(F.in[IN_CONVW] + t * 1024 + ch + 4);
        wgt[t][0] = (f32x2){a.x, a.y}; wgt[t][1] = (f32x2){a.z, a.w}; wgt[t][2] = (f32x2){b4.x, b4.y}; wgt[t][3] = (f32x2){b4.z, b4.w}; }
    f32x2 cb[4]; { const f32x4 a = *(const f32x4*)(F.in[IN_CONVB] + ch), b4 = *(const f32x4*)(F.in[IN_CONVB] + ch + 4); cb[0] = (f32x2){a.x, a.y}; cb[1] = (f32x2){a.z, a.w}; cb[2] = (f32x2){b4.x, b4.y}; cb[3] = (f32x2){b4.z, b4.w}; }
    for (int item = F.bid; item < 2048 + 64; item += F.G) {
        const bool lat = item < 2048;
        int rowbase, x0, W, y = 0, H = 1;
        if (lat) { const int b = item >> 9, yy = (item >> 2) & 127, qg = item & 3; y = yy; H = 128; W = 64; rowbase = b * SEQ + yy * 64; x0 = (qg * 4 + qd) * 4; }
        else { const int q = item - 2048, b = q >> 4, qg = q & 15; W = CTXL; rowbase = TL + b * CTXL; x0 = (qg * 4 + qd) * 4; }
        f32x2 acc[4][4];
#pragma unroll
        for (int p = 0; p < 4; ++p)
#pragma unroll
            for (int i = 0; i < 4; ++i) acc[p][i] = cb[i];
        u32x4 v[3][6];
#pragma unroll
        for (int dy = 0; dy < 3; ++dy) { const int yy = y + dy - 1; const bool rowok = lat ? (yy >= 0 && yy < H) : (dy == 1);
#pragma unroll
            for (int dx = 0; dx < 6; ++dx) { const int xx = x0 + dx - 1; v[dy][dx] = (u32x4){0u, 0u, 0u, 0u};
                if (rowok && xx >= 0 && xx < W) v[dy][dx] = *(const u32x4*)(P + (unsigned)((rowbase + (dy - 1) * 64 + xx) * NP + CX + ch) * 2u); } }
#pragma unroll
        for (int dy = 0; dy < 3; ++dy)
#pragma unroll
            for (int dx = 0; dx < 6; ++dx) { const u32x4 u = v[dy][dx]; f32x2 f[4];
                f[0] = (f32x2){bflo(u.x), bfhi(u.x)}; f[1] = (f32x2){bflo(u.y), bfhi(u.y)}; f[2] = (f32x2){bflo(u.z), bfhi(u.z)}; f[3] = (f32x2){bflo(u.w), bfhi(u.w)};
#pragma unroll
                for (int p = 0; p < 4; ++p) { const int kx = dx - p;
                    if (kx >= 0 && kx < 3) {
#pragma unroll
                        for (int i = 0; i < 4; ++i) acc[p][i] = __builtin_elementwise_fma(f[i], wgt[dy * 3 + kx][i], acc[p][i]); } } }
#pragma unroll
        for (int p = 0; p < 4; ++p) { u32x4 o; o.x = pk2(silu_f(acc[p][0].x), silu_f(acc[p][0].y)); o.y = pk2(silu_f(acc[p][1].x), silu_f(acc[p][1].y)); o.z = pk2(silu_f(acc[p][2].x), silu_f(acc[p][2].y)); o.w = pk2(silu_f(acc[p][3].x), silu_f(acc[p][3].y));
            *(u32x4*)(XBC + (size_t)(rowbase + x0 + p) * 1024 + ch) = o; }
    }
}

__device__ __forceinline__ int scan_row(int b, int dir, int s) {
    if (s < CTXL) { const int t = dir ? (CTXL - 1 - s) : s; return TL + b * CTXL + t; }
    const int s2 = s - CTXL; const int t = dir ? (SEQ - 1 - s2) : s2; return b * SEQ + t;
}

__device__ __forceinline__ void ph_scan_naive(Ctx& F) {
    const bf16_t* P = (const bf16_t*)(F.ws + WS_P); const bf16_t* XBC = (const bf16_t*)(F.ws + WS_XBC); const float* Gb = (const float*)(F.ws + WS_G);
    bf16_t* OG = (bf16_t*)(F.ws + WS_OG); bf16_t* OS = (bf16_t*)(F.ws + WS_OS);
    constexpr int NSTEP = CTXL + SEQ, BT = 16;
    for (int item = F.bid; item < 96; item += F.G) {
        if (item < 32) {
            const int b = item >> 3, h = (item >> 1) & 3, dir = item & 1;
            LAS float* qs = (LAS float*)F.lds; LAS float* ks = qs + BT * 64; LAS float* as = ks + BT * 64; LAS float* vs = as + BT * 64;
            const int v = F.tid >> 2, d0 = (F.tid & 3) * 16;
            float S[16];
#pragma unroll
            for (int d = 0; d < 16; ++d) S[d] = 0.f;
#pragma unroll 1
            for (int s0 = 0; s0 < NSTEP; s0 += BT) {
                __syncthreads();
#pragma unroll 1
                for (int i = F.tid; i < BT * 64; i += 512) { const int tk = i >> 6, d = i & 63; const int row = scan_row(b, dir, s0 + tk);
                    qs[i] = bf2f(P[(size_t)row * NP + CQ + h * 64 + d]) * 0.125f; ks[i] = bf2f(P[(size_t)row * NP + CK + h * 64 + d]);
                    as[i] = __expf(Gb[((size_t)dir * TT + row) * 256 + h * 64 + d]); }
#pragma unroll 1
                for (int i = F.tid; i < BT * 128; i += 512) { const int tk = i >> 7, vv = i & 127; const int row = scan_row(b, dir, s0 + tk); vs[i] = bf2f(P[(size_t)row * NP + CV + h * 128 + vv]); }
                __syncthreads();
#pragma unroll 1
                for (int tk = 0; tk < BT; ++tk) { const float vt = vs[tk * 128 + v]; float o = 0.f;
#pragma unroll
                    for (int d = 0; d < 16; ++d) { S[d] = as[tk * 64 + d0 + d] * S[d] + ks[tk * 64 + d0 + d] * vt; o += qs[tk * 64 + d0 + d] * S[d]; }
                    o += __shfl_xor(o, 1); o += __shfl_xor(o, 2);
                    const int row = scan_row(b, dir, s0 + tk);
                    if (row < TL && (F.tid & 3) == 0) OG[((size_t)dir * TL + row) * 512 + h * 128 + v] = (bf16_t)f2bf(o); }
            }
        } else {
            const int it = item - 32, b = it >> 4, hh = (it >> 1) & 7, dir = it & 1, g = hh >> 2;
            LAS float* Bs = (LAS float*)F.lds; LAS float* Cs = Bs + BT * 128; LAS float* xs = Cs + BT * 128; LAS float* dts = xs + BT * 64; LAS float* das = dts + BT;
            const int pp = F.tid >> 3, sb = (F.tid & 7) * 16;
            const float Ah = -__expf(F.in[IN_ALOG][dir * 8 + hh]), dtb = F.in[IN_DTBIAS][dir * 8 + hh];
            float S[16];
#pragma unroll
            for (int s = 0; s < 16; ++s) S[s] = 0.f;
#pragma unroll 1
            for (int s0 = 0; s0 < NSTEP; s0 += BT) {
                __syncthreads();
#pragma unroll 1
                for (int i = F.tid; i < BT * 128; i += 512) { const int tk = i >> 7, ss = i & 127; const int row = scan_row(b, dir, s0 + tk);
                    Bs[i] = bf2f(XBC[(size_t)row * 1024 + 512 + g * 128 + ss]); Cs[i] = bf2f(XBC[(size_t)row * 1024 + 768 + g * 128 + ss]); }
#pragma unroll 1
                for (int i = F.tid; i < BT * 64; i += 512) { const int tk = i >> 6, c = i & 63; const int row = scan_row(b, dir, s0 + tk); xs[i] = bf2f(XBC[(size_t)row * 1024 + hh * 64 + c]); }
                if (F.tid < BT) { const int row = scan_row(b, dir, s0 + F.tid);
                    const float dt = softplus_f(bf2f(P[(size_t)row * NP + CDT + hh]) + dtb);
                    dts[F.tid] = dt; das[F.tid] = __expf(dt * Ah); }
                __syncthreads();
#pragma unroll 1
                for (int tk = 0; tk < BT; ++tk) { const float dt = dts[tk], dA = das[tk]; const float xdt = xs[tk * 64 + pp] * dt; float y = 0.f;
#pragma unroll
                    for (int s = 0; s < 16; ++s) { S[s] = dA * S[s] + xdt * Bs[tk * 128 + sb + s]; y += Cs[tk * 128 + sb + s] * S[s]; }
                    y += __shfl_xor(y, 1); y += __shfl_xor(y, 2); y += __shfl_xor(y, 4);
                    const int row = scan_row(b, dir, s0 + tk);
                    if (row < TL && (F.tid & 7) == 0) OS[((size_t)dir * TL + row) * 512 + hh * 64 + pp] = (bf16_t)f2bf(y); }
            }
        }
        __syncthreads();
    }
}


typedef short s16x4 __attribute__((ext_vector_type(4)));
__device__ __forceinline__ f32x4 mfma16(bf16x8 a, bf16x8 b, f32x4 c) { return __builtin_amdgcn_mfma_f32_16x16x32_bf16(a, b, c, 0, 0, 0); }
__device__ __forceinline__ bf16x8 ldfrag(const LAS bf16_t* p) { return *(const LAS bf16x8*)p; }
__device__ __forceinline__ bf16x8 ldfrag_perm(const LAS bf16_t* p) { const s16x4 lo = *(const LAS s16x4*)p, hi = *(const LAS s16x4*)(p + 16); return (bf16x8){lo[0], lo[1], lo[2], lo[3], hi[0], hi[1], hi[2], hi[3]}; }
__device__ __forceinline__ bf16x8 ldfrag_tr(const LAS bf16_t* p, int pitch) {
    const s16x4 lo = __builtin_bit_cast(s16x4, __builtin_amdgcn_ds_read_tr16_b64_v4i16((LAS s16x4*)p));
    const s16x4 hi = __builtin_bit_cast(s16x4, __builtin_amdgcn_ds_read_tr16_b64_v4i16((LAS s16x4*)(p + 4 * pitch)));
    return (bf16x8){lo[0], lo[1], lo[2], lo[3], hi[0], hi[1], hi[2], hi[3]};
}
__device__ __forceinline__ bf16x8 acc2frag(f32x4 t0, f32x4 t1) {
    u32x4 w; w.x = pk2(t0[0], t0[1]); w.y = pk2(t0[2], t0[3]); w.z = pk2(t1[0], t1[1]); w.w = pk2(t1[2], t1[3]);
    return __builtin_bit_cast(bf16x8, w);
}
__device__ __forceinline__ int chunk_rlo(int b, int dir, int seg, int c) {
    if (seg == 0) { const int s0 = 64 * c; return TL + b * CTXL + (dir ? (CTXL - 64 - s0) : s0); }
    const int s2 = 512 * (seg - 1) + 64 * c; return b * SEQ + (dir ? (SEQ - 64 - s2) : s2);
}
constexpr int GP = 72, VP = 136, XP = 264;
constexpr int GL_QT = 0, GL_KT = 9216, GL_KHT = 18432, GL_VN = 27648, GL_PM = 45056, GL_TT = 54272, GL_AD = 56320, GL_GL = 56576, GL_OT = 91392;
constexpr int GLP = 68;
constexpr int SL_CM = 0, SL_BM = 17408, SL_XM = 34816, SL_MM = 68608, SL_AC = 105472, SL_DT = 106496, SL_W = 107520, SL_E = 108544, SL_DA = 109568, SL_YT = 109584;

struct GlaRegs { unsigned q[8], k[8]; u32x4 v[2]; };
__device__ __forceinline__ float logsigmoid2_16(float v) {
    const float t = v * 1.4426950408889634f; return (fminf(t, 0.f) - __builtin_amdgcn_logf(1.f + __builtin_amdgcn_exp2f(-fabsf(t)))) * (1.f / 16.f); }
template <bool OUT> __device__ __forceinline__ void gla_load(GlaRegs& R, const Ctx& F, int rlo, int dir, int h) {
    const char* P = (const char*)(F.ws + WS_P);
#pragma unroll
    for (int u = 0; u < 2; ++u) { const int idx = F.tid + 512 * u, j = idx >> 4, ch = idx & 15, row = dir ? rlo + 63 - j : rlo + j;
        R.v[u] = *(const u32x4*)(P + (unsigned)(row * NP + CV + h * 128 + ch * 8) * 2u); }
#pragma unroll
    for (int k = 0; k < 8; ++k) { const int j = 8 * F.wave + k, row = dir ? rlo + 63 - j : rlo + j;
        if (OUT) R.q[k] = *(const unsigned short*)(P + (unsigned)(row * NP + CQ + h * 64 + F.lane) * 2u);
        R.k[k] = *(const unsigned short*)(P + (unsigned)(row * NP + CK + h * 64 + F.lane) * 2u); }
}
__device__ __forceinline__ u32x4 gla_load_gk(const Ctx& F, int rlo, int dir) {
    const int j = F.tid >> 1, row = dir ? rlo + 63 - j : rlo + j;
    return *(const u32x4*)((const char*)(F.ws + WS_P) + (unsigned)(row * NP + CGK + (F.tid & 1) * 8) * 2u);
}
__device__ __forceinline__ void gla_store_gk(LAS float* GK, const Ctx& F, u32x4 v) {
    LAS float* o = GK + (F.tid >> 1) * 16 + (F.tid & 1) * 8;
    *(LAS f32x4*)o = (f32x4){bflo(v.x), bfhi(v.x), bflo(v.y), bfhi(v.y)}; *(LAS f32x4*)(o + 4) = (f32x4){bflo(v.z), bfhi(v.z), bflo(v.w), bfhi(v.w)};
}
template <bool OUT> __device__ __forceinline__ void gla_item(const Ctx& F, int seq, int seg) {
    const int b = seq >> 3, h = (seq >> 1) & 3, dir = seq & 1;
    const int l = F.lane, g4 = l >> 4, l15 = l & 15, w = F.wave;
    LAS bf16_t* QT = (LAS bf16_t*)(F.lds + GL_QT); LAS bf16_t* KT = (LAS bf16_t*)(F.lds + GL_KT); LAS bf16_t* KHT = (LAS bf16_t*)(F.lds + GL_KHT);
    LAS bf16_t* VN = (LAS bf16_t*)(F.lds + GL_VN); LAS bf16_t* PM = (LAS bf16_t*)(F.lds + GL_PM); LAS float* TTl = (LAS float*)(F.lds + GL_TT); LAS float* AD = (LAS float*)(F.lds + GL_AD);
    bf16_t* OG = (bf16_t*)(F.ws + WS_OG); LAS bf16_t* OT = (LAS bf16_t*)(F.lds + GL_OT);
#define GLA_FLUSH(rl) do { _Pragma("unroll") for (int u = 0; u < 2; ++u) { const int idx = F.tid + 512 * u, i = idx >> 4, ch = idx & 15, row = dir ? (rl) + 63 - i : (rl) + i; \
        *(u32x4*)((char*)OG + (unsigned)((dir * TL + row) * 512 + h * 128 + ch * 8) * 2u) = *(const LAS u32x4*)(OT + i * VP + ch * 8); } } while (0)
    f32x4 S[4];
    if (OUT) { const bf16_t* src = (const bf16_t*)(F.ws + WS_SSG) + ((size_t)seq * 16 + (seg - 1)) * 8192 + w * 1024 + l * 16;
#pragma unroll
        for (int dt = 0; dt < 4; ++dt) S[dt] = ld_bf4(src + dt * 4); }
    else {
#pragma unroll
        for (int dt = 0; dt < 4; ++dt) S[dt] = (f32x4){0.f, 0.f, 0.f, 0.f}; }
    float segsum = 0.f;
    const int nch = (seg == 0) ? 4 : 8;
    LAS float* GLb = (LAS float*)(F.lds + GL_GL);
    bf16x8 Aw; f32x4 gb4;
    { const int dcol = h * 64 + 16 * (w & 3) + l15, kb = 8 * (g4 & 1); float wv[8];
#pragma unroll
      for (int t = 0; t < 8; ++t) { const float x = F.in[IN_GKUP][(dir * 16 + kb + t) * 256 + dcol]; const float hi = __builtin_bit_cast(float, pk2(x, 0.f) << 16); wv[t] = (g4 >= 2) ? (x - hi) : x; }
      u32x4 pw; pw.x = pk2(wv[0], wv[1]); pw.y = pk2(wv[2], wv[3]); pw.z = pk2(wv[4], wv[5]); pw.w = pk2(wv[6], wv[7]); Aw = __builtin_bit_cast(bf16x8, pw);
      gb4 = *(const f32x4*)(F.in[IN_GKB] + dir * 256 + h * 64 + 16 * (w & 3) + 4 * g4); }
#define GLA_GKLOAD(dst, cc) do { const int _rl = chunk_rlo(b, dir, seg, (cc)); _Pragma("unroll") for (int jj = 0; jj < 2; ++jj) { const int j = 16 * (2 * (w >> 2) + jj) + l15, row = dir ? _rl + 63 - j : _rl + j; \
        dst[jj] = *(const u32x4*)((const char*)(F.ws + WS_P) + (unsigned)(row * NP + CGK + 8 * (g4 & 1)) * 2u); } } while (0)
#define GLA_GCOMP(src, cc) do { _Pragma("unroll") for (int jj = 0; jj < 2; ++jj) { const f32x4 ga = mfma16(Aw, __builtin_bit_cast(bf16x8, src[jj]), (f32x4){0.f, 0.f, 0.f, 0.f}); \
        f32x4 gv; gv.x = logsigmoid2_16(ga.x + gb4.x); gv.y = logsigmoid2_16(ga.y + gb4.y); gv.z = logsigmoid2_16(ga.z + gb4.z); gv.w = logsigmoid2_16(ga.w + gb4.w); \
        *(LAS f32x4*)(GLb + ((cc) & 1) * (64 * GLP) + (16 * (2 * (w >> 2) + jj) + l15) * GLP + 16 * (w & 3) + 4 * g4) = gv; } } while (0)
    u32x4 gkf[2];
    GLA_GKLOAD(gkf, 0); GLA_GCOMP(gkf, 0); GLA_GKLOAD(gkf, 1);
    GlaRegs R; gla_load<OUT>(R, F, chunk_rlo(b, dir, seg, 0), dir, h);
    LBAR();
#pragma unroll 1
    for (int c = 0; c < nch; ++c) {
        const int rlo = chunk_rlo(b, dir, seg, c);
        if (OUT && c > 0) GLA_FLUSH(chunk_rlo(b, dir, seg, c - 1));
        float cs[8]; { float run = 0.f; const LAS float* gl = GLb + (c & 1) * (64 * GLP) + (8 * w) * GLP + l;
#pragma unroll
            for (int k = 0; k < 8; ++k) { run += gl[k * GLP]; cs[k] = run; }
            TTl[w * 64 + l] = run; }
        LBAR();
        float base = 0.f, tot = 0.f;
#pragma unroll
        for (int q = 0; q < 8; ++q) { const float t = TTl[q * 64 + l]; tot += t; base += (q < w) ? t : 0.f; }
        const float etot = __builtin_amdgcn_exp2f(tot);
        { float kh[8];
#pragma unroll
          for (int k2 = 0; k2 < 8; k2 += 2) { float qv[2], kv[2];
#pragma unroll
              for (int u = 0; u < 2; ++u) { const int k = k2 + u; const float bj = base + cs[k]; const float kf = __builtin_bit_cast(float, R.k[k] << 16);
                  const float ek = __builtin_amdgcn_exp2f(-bj);
                  if (OUT) { qv[u] = __builtin_bit_cast(float, R.q[k] << 16) * 0.125f * __builtin_amdgcn_exp2f(bj); kv[u] = kf * ek; }
                  kh[k] = kf * (etot * ek); }
              if (OUT) { const int j = 8 * w + k2; const unsigned qw = pk2(qv[0], qv[1]), kw = pk2(kv[0], kv[1]);
                  QT[j * GP + l] = (bf16_t)(qw & 0xffffu); QT[(j + 1) * GP + l] = (bf16_t)(qw >> 16); KT[j * GP + l] = (bf16_t)(kw & 0xffffu); KT[(j + 1) * GP + l] = (bf16_t)(kw >> 16); } }
          u32x4 pk; pk.x = pk2(kh[0], kh[1]); pk.y = pk2(kh[2], kh[3]); pk.z = pk2(kh[4], kh[5]); pk.w = pk2(kh[6], kh[7]);
          *(LAS u32x4*)(KHT + l * GP + 8 * w) = pk; }
        if (w == 0) { AD[l] = etot; segsum += tot; }
#pragma unroll
        for (int u = 0; u < 2; ++u) { const int idx = F.tid + 512 * u, j = idx >> 4, ch = idx & 15; *(LAS u32x4*)(VN + j * VP + ch * 8) = R.v[u]; }
        LBAR();
        if (c + 1 < nch) gla_load<OUT>(R, F, chunk_rlo(b, dir, seg, c + 1), dir, h);
        if (c + 1 < nch) { GLA_GCOMP(gkf, c + 1); if (c + 2 < nch) GLA_GKLOAD(gkf, c + 2); }
        if (OUT) {
            const int jt = w & 3;
#pragma unroll
            for (int ii = 0; ii < 2; ++ii) { const int it = 2 * (w >> 2) + ii; f32x4 acc = (f32x4){0.f, 0.f, 0.f, 0.f};
                if (jt <= it) {
#pragma unroll
                    for (int ks = 0; ks < 2; ++ks) acc = mfma16(ldfrag(KT + (16 * jt + l15) * GP + 32 * ks + 8 * g4), ldfrag(QT + (16 * it + l15) * GP + 32 * ks + 8 * g4), acc); }
                const int i = 16 * it + l15, j0 = 16 * jt + 4 * g4;
                float p0 = (j0 + 0 <= i) ? acc[0] : 0.f, p1 = (j0 + 1 <= i) ? acc[1] : 0.f, p2 = (j0 + 2 <= i) ? acc[2] : 0.f, p3 = (j0 + 3 <= i) ? acc[3] : 0.f;
                u32x2 pk; pk.x = pk2(p0, p1); pk.y = pk2(p2, p3);
                *(LAS u32x2*)(PM + i * GP + j0) = pk; }
            LBAR();
        }
        bf16x8 Bv[2];
#pragma unroll
        for (int ks = 0; ks < 2; ++ks) Bv[ks] = ldfrag_tr(VN + (32 * ks + 8 * g4 + (l15 >> 2)) * VP + 16 * w + 4 * (l & 3), VP);
        if (OUT) {
            bf16x8 Bs[2];
#pragma unroll
            for (int ks = 0; ks < 2; ++ks) Bs[ks] = acc2frag(S[2 * ks], S[2 * ks + 1]);
#pragma unroll
            for (int it = 0; it < 4; ++it) { f32x4 acc = (f32x4){0.f, 0.f, 0.f, 0.f};
#pragma unroll
                for (int ks = 0; ks < 2; ++ks) acc = mfma16(ldfrag(PM + (16 * it + l15) * GP + 32 * ks + 8 * g4), Bv[ks], acc);
#pragma unroll
                for (int ks = 0; ks < 2; ++ks) acc = mfma16(ldfrag_perm(QT + (16 * it + l15) * GP + 32 * ks + 4 * g4), Bs[ks], acc);
                { const unsigned w01 = pk2(acc[0], acc[1]), w23 = pk2(acc[2], acc[3]); LAS bf16_t* op = OT + (16 * it + 4 * g4) * VP + 16 * w + l15;
                  op[0] = (bf16_t)(w01 & 0xffffu); op[VP] = (bf16_t)(w01 >> 16); op[2 * VP] = (bf16_t)(w23 & 0xffffu); op[3 * VP] = (bf16_t)(w23 >> 16); } }
        }
#pragma unroll
        for (int dt = 0; dt < 4; ++dt) { const f32x4 av = *(const LAS f32x4*)(AD + 16 * dt + 4 * g4); S[dt] = S[dt] * av;
#pragma unroll
            for (int ks = 0; ks < 2; ++ks) S[dt] = mfma16(ldfrag(KHT + (16 * dt + l15) * GP + 32 * ks + 8 * g4), Bv[ks], S[dt]); }
        LBAR();
    }
    if (OUT) { GLA_FLUSH(chunk_rlo(b, dir, seg, nch - 1)); LBAR(); }
#undef GLA_FLUSH
#undef GLA_GKLOAD
#undef GLA_GCOMP
    if (!OUT) { bf16_t* dst = (bf16_t*)(F.ws + WS_USG) + ((size_t)seq * 17 + seg) * 8192 + w * 1024 + l * 16;
#pragma unroll
        for (int dt = 0; dt < 4; ++dt) st_bf4(dst + dt * 4, S[dt]);
        if (w == 0) ((float*)(F.ws + WS_ASG))[((size_t)seq * 17 + seg) * 64 + l] = segsum; }
}

struct SsdRegs { u32x4 c[2], bm[2], x[4]; unsigned dtraw; };
template <bool OUT> __device__ __forceinline__ void ssd_load1(SsdRegs& R, const Ctx& F, int rlo, int dir, int g) {
    const char* P = (const char*)(F.ws + WS_P); const char* XBC = (const char*)(F.ws + WS_XBC);
#pragma unroll
    for (int u = 0; u < 2; ++u) { const int idx = F.tid + 512 * u, j = idx >> 4, ch = idx & 15, row = dir ? rlo + 63 - j : rlo + j;
        R.bm[u] = *(const u32x4*)(XBC + (unsigned)(row * 1024 + 512 + g * 128 + ch * 8) * 2u); }
    R.dtraw = 0u;
    if (F.wave < 4) { const int row = dir ? rlo + 63 - F.lane : rlo + F.lane; R.dtraw = *(const unsigned short*)(P + (unsigned)(row * NP + CDT + g * 4 + F.wave) * 2u); }
}
template <bool OUT> __device__ __forceinline__ void ssd_load2(SsdRegs& R, const Ctx& F, int rlo, int dir, int g) {
    const char* XBC = (const char*)(F.ws + WS_XBC);
    if (OUT) {
#pragma unroll
        for (int u = 0; u < 2; ++u) { const int idx = F.tid + 512 * u, j = idx >> 4, ch = idx & 15, row = dir ? rlo + 63 - j : rlo + j;
            R.c[u] = *(const u32x4*)(XBC + (unsigned)(row * 1024 + 768 + g * 128 + ch * 8) * 2u); } }
#pragma unroll
    for (int u = 0; u < 4; ++u) { const int idx = F.tid + 512 * u, j = idx >> 5, ch = idx & 31, row = dir ? rlo + 63 - j : rlo + j;
        R.x[u] = *(const u32x4*)(XBC + (unsigned)(row * 1024 + g * 256 + ch * 8) * 2u); }
}
template <bool OUT> __device__ __forceinline__ void ssd_item(const Ctx& F, int sg, int seg) {
    const int b = sg >> 2, g = (sg >> 1) & 1, dir = sg & 1;
    const int l = F.lane, g4 = l >> 4, l15 = l & 15, w = F.wave, r = w >> 1, ph = w & 1;
    LAS bf16_t* CM = (LAS bf16_t*)(F.lds + SL_CM); LAS bf16_t* BM = (LAS bf16_t*)(F.lds + SL_BM); LAS bf16_t* XM = (LAS bf16_t*)(F.lds + SL_XM); LAS bf16_t* MM = (LAS bf16_t*)(F.lds + SL_MM);
    LAS float* AC = (LAS float*)(F.lds + SL_AC); LAS float* DTl = (LAS float*)(F.lds + SL_DT); LAS float* Wl = (LAS float*)(F.lds + SL_W); LAS float* El = (LAS float*)(F.lds + SL_E); LAS float* DAl = (LAS float*)(F.lds + SL_DA);
    bf16_t* OS = (bf16_t*)(F.ws + WS_OS); LAS bf16_t* YT = (LAS bf16_t*)(F.lds + SL_YT);
#define SSD_FLUSH(rl) do { _Pragma("unroll") for (int u = 0; u < 4; ++u) { const int idx = F.tid + 512 * u, i = idx >> 5, ch = idx & 31, row = dir ? (rl) + 63 - i : (rl) + i; \
        *(u32x4*)((char*)OS + (unsigned)((dir * TL + row) * 512 + g * 256 + ch * 8) * 2u) = *(const LAS u32x4*)(YT + i * XP + ch * 8); } } while (0)
    f32x4 ST[8][2];
    if (OUT) { const bf16_t* src = (const bf16_t*)(F.ws + WS_SSS) + ((size_t)sg * 16 + (seg - 1)) * 32768 + w * 4096 + l * 64;
#pragma unroll
        for (int st = 0; st < 8; ++st)
#pragma unroll
            for (int nt = 0; nt < 2; ++nt) ST[st][nt] = ld_bf4(src + (st * 2 + nt) * 4); }
    else {
#pragma unroll
        for (int st = 0; st < 8; ++st)
#pragma unroll
            for (int nt = 0; nt < 2; ++nt) ST[st][nt] = (f32x4){0.f, 0.f, 0.f, 0.f}; }
    const int hh4 = (w < 4) ? (g * 4 + w) : 0;
    const float Ah = -__expf(F.in[IN_ALOG][dir * 8 + hh4]) * 1.4426950408889634f, dtb = F.in[IN_DTBIAS][dir * 8 + hh4];
    float segsum = 0.f;
    const int nch = (seg == 0) ? 4 : 8;
    SsdRegs R; ssd_load1<OUT>(R, F, chunk_rlo(b, dir, seg, 0), dir, g); ssd_load2<OUT>(R, F, chunk_rlo(b, dir, seg, 0), dir, g);
#pragma unroll 1
    for (int c = 0; c < nch; ++c) {
        const int rlo = chunk_rlo(b, dir, seg, c);
        if (OUT && c > 0) SSD_FLUSH(chunk_rlo(b, dir, seg, c - 1));
#pragma unroll
        for (int u = 0; u < 2; ++u) { const int idx = F.tid + 512 * u, j = idx >> 4, ch = idx & 15;
            if (OUT) *(LAS u32x4*)(CM + j * VP + ch * 8) = R.c[u];
            *(LAS u32x4*)(BM + j * VP + ch * 8) = R.bm[u]; }
#pragma unroll
        for (int u = 0; u < 4; ++u) { const int idx = F.tid + 512 * u, j = idx >> 5, ch = idx & 31; *(LAS u32x4*)(XM + j * XP + ch * 8) = R.x[u]; }
        if (w < 4) { const float dtx = __builtin_bit_cast(float, R.dtraw << 16) + dtb;
            const float dt = fmaxf(dtx, 0.f) + 0.6931471805599453f * __builtin_amdgcn_logf(1.f + __builtin_amdgcn_exp2f(-fabsf(dtx) * 1.4426950408889634f)); float a = dt * Ah;
#pragma unroll
            for (int off = 1; off < 64; off <<= 1) { const float t = __shfl_up(a, off); if (l >= off) a += t; }
            const float alast = __shfl(a, 63);
            AC[w * 64 + l] = a; DTl[w * 64 + l] = dt; Wl[w * 64 + l] = __builtin_amdgcn_exp2f(alast - a) * dt; El[w * 64 + l] = __builtin_amdgcn_exp2f(a);
            if (l == 0) DAl[w] = __builtin_amdgcn_exp2f(alast);
            segsum += alast; }
        LBAR();
        if (c + 1 < nch) ssd_load1<OUT>(R, F, chunk_rlo(b, dir, seg, c + 1), dir, g);
        if (OUT) {
            const int jt = w & 3;
#pragma unroll
            for (int ii = 0; ii < 2; ++ii) { const int it = 2 * (w >> 2) + ii; f32x4 acc = (f32x4){0.f, 0.f, 0.f, 0.f};
                if (jt <= it) {
#pragma unroll
                    for (int ks = 0; ks < 4; ++ks) acc = mfma16(ldfrag(BM + (16 * jt + l15) * VP + 32 * ks + 8 * g4), ldfrag(CM + (16 * it + l15) * VP + 32 * ks + 8 * g4), acc); }
                const int i = 16 * it + l15, j0 = 16 * jt + 4 * g4;
#pragma unroll
                for (int rr = 0; rr < 4; ++rr) { const float ai = AC[rr * 64 + i]; const f32x4 aj = *(const LAS f32x4*)(AC + rr * 64 + j0), dj = *(const LAS f32x4*)(DTl + rr * 64 + j0);
                    float m[4];
#pragma unroll
                    for (int q = 0; q < 4; ++q) m[q] = (j0 + q <= i) ? acc[q] * __builtin_amdgcn_exp2f(fminf(ai - aj[q], 0.f)) * dj[q] : 0.f;
                    u32x2 pk; pk.x = pk2(m[0], m[1]); pk.y = pk2(m[2], m[3]);
                    *(LAS u32x2*)(MM + (rr * 64 + i) * GP + j0) = pk; } }
            LBAR();
        }
        const int p0 = 64 * r + 32 * ph;
        if (OUT) {
#pragma unroll
            for (int nt = 0; nt < 2; ++nt) {
                f32x4 ay[4];
#pragma unroll
                for (int it = 0; it < 4; ++it) ay[it] = (f32x4){0.f, 0.f, 0.f, 0.f};
                bf16x8 Ac[4], An[4];
#pragma unroll
                for (int it = 0; it < 4; ++it) Ac[it] = ldfrag_perm(CM + (16 * it + l15) * VP + 4 * g4);
#pragma unroll
                for (int ks = 0; ks < 4; ++ks) {
                    if (ks < 3) {
#pragma unroll
                        for (int it = 0; it < 4; ++it) An[it] = ldfrag_perm(CM + (16 * it + l15) * VP + 32 * (ks + 1) + 4 * g4); }
                    else {
#pragma unroll
                        for (int it = 0; it < 4; ++it) An[it] = ldfrag(MM + (r * 64 + 16 * it + l15) * GP + 8 * g4); }
                    const bf16x8 Bst = acc2frag(ST[2 * ks][nt], ST[2 * ks + 1][nt]);
#pragma unroll
                    for (int it = 0; it < 4; ++it) ay[it] = mfma16(Ac[it], Bst, ay[it]);
                    __builtin_amdgcn_sched_barrier(0);
#pragma unroll
                    for (int it = 0; it < 4; ++it) Ac[it] = An[it]; }
                bf16x8 Bx0 = ldfrag_tr(XM + (8 * g4 + (l15 >> 2)) * XP + p0 + 16 * nt + 4 * (l & 3), XP);
                const bf16x8 Bx1 = ldfrag_tr(XM + (32 + 8 * g4 + (l15 >> 2)) * XP + p0 + 16 * nt + 4 * (l & 3), XP);
#pragma unroll
                for (int it = 0; it < 4; ++it) { const f32x4 ev = *(const LAS f32x4*)(El + r * 64 + 16 * it + 4 * g4); ay[it] = ay[it] * ev; }
#pragma unroll
                for (int it = 0; it < 4; ++it) An[it] = ldfrag(MM + (r * 64 + 16 * it + l15) * GP + 32 + 8 * g4);
#pragma unroll
                for (int it = 0; it < 4; ++it) ay[it] = mfma16(Ac[it], Bx0, ay[it]);
                __builtin_amdgcn_sched_barrier(0);
#pragma unroll
                for (int it = 0; it < 4; ++it) ay[it] = mfma16(An[it], Bx1, ay[it]);
#pragma unroll
                for (int it = 0; it < 4; ++it) { const unsigned w01 = pk2(ay[it][0], ay[it][1]), w23 = pk2(ay[it][2], ay[it][3]); LAS bf16_t* yp = YT + (16 * it + 4 * g4) * XP + p0 + 16 * nt + l15;
                    yp[0] = (bf16_t)(w01 & 0xffffu); yp[XP] = (bf16_t)(w01 >> 16); yp[2 * XP] = (bf16_t)(w23 & 0xffffu); yp[3 * XP] = (bf16_t)(w23 >> 16); }
                __builtin_amdgcn_sched_barrier(0);
            }
        }
        if (c + 1 < nch) ssd_load2<OUT>(R, F, chunk_rlo(b, dir, seg, c + 1), dir, g);
        { const float dA = DAl[r];
          bf16x8 Bx[2][2];
#pragma unroll
          for (int ks = 0; ks < 2; ++ks)
#pragma unroll
              for (int nt = 0; nt < 2; ++nt) Bx[ks][nt] = ldfrag_tr(XM + (32 * ks + 8 * g4 + (l15 >> 2)) * XP + p0 + 16 * nt + 4 * (l & 3), XP);
          bf16x8 Af[2]; Af[0] = ldfrag_tr(BM + (8 * g4 + (l15 >> 2)) * VP + 4 * (l & 3), VP); Af[1] = ldfrag_tr(BM + (32 + 8 * g4 + (l15 >> 2)) * VP + 4 * (l & 3), VP);
          bf16x8 Bw[2][2];
#pragma unroll
          for (int ks = 0; ks < 2; ++ks) { const f32x4 w0 = *(const LAS f32x4*)(Wl + r * 64 + 32 * ks + 8 * g4), w1 = *(const LAS f32x4*)(Wl + r * 64 + 32 * ks + 8 * g4 + 4);
#pragma unroll
              for (int nt = 0; nt < 2; ++nt) { const u32x4 xv = __builtin_bit_cast(u32x4, Bx[ks][nt]); u32x4 o;
                  o.x = pk2(bflo(xv.x) * w0[0], bfhi(xv.x) * w0[1]); o.y = pk2(bflo(xv.y) * w0[2], bfhi(xv.y) * w0[3]);
                  o.z = pk2(bflo(xv.z) * w1[0], bfhi(xv.z) * w1[1]); o.w = pk2(bflo(xv.w) * w1[2], bfhi(xv.w) * w1[3]);
                  Bw[ks][nt] = __builtin_bit_cast(bf16x8, o); } }
#pragma unroll
          for (int st = 0; st < 8; ++st) { ST[st][0] = ST[st][0] * dA; ST[st][1] = ST[st][1] * dA;
              bf16x8 Ag[2]; if (st < 7) { Ag[0] = ldfrag_tr(BM + (8 * g4 + (l15 >> 2)) * VP + 16 * (st + 1) + 4 * (l & 3), VP); Ag[1] = ldfrag_tr(BM + (32 + 8 * g4 + (l15 >> 2)) * VP + 16 * (st + 1) + 4 * (l & 3), VP); }
              else { Ag[0] = Af[0]; Ag[1] = Af[1]; }
#pragma unroll
              for (int ks = 0; ks < 2; ++ks) { ST[st][0] = mfma16(Af[ks], Bw[ks][0], ST[st][0]); ST[st][1] = mfma16(Af[ks], Bw[ks][1], ST[st][1]); }
              __builtin_amdgcn_sched_barrier(0);
              Af[0] = Ag[0]; Af[1] = Ag[1]; } }
        LBAR();
    }
    if (OUT) { SSD_FLUSH(chunk_rlo(b, dir, seg, nch - 1)); LBAR(); }
#undef SSD_FLUSH
    if (!OUT) { bf16_t* dst = (bf16_t*)(F.ws + WS_USS) + ((size_t)sg * 17 + seg) * 32768 + w * 4096 + l * 64;
#pragma unroll
        for (int st = 0; st < 8; ++st)
#pragma unroll
            for (int nt = 0; nt < 2; ++nt) st_bf4(dst + (st * 2 + nt) * 4, ST[st][nt]);
        if (w < 4 && l == 0) ((float*)(F.ws + WS_ASS))[((size_t)sg * 17 + seg) * 4 + w] = segsum; }
}

__device__ __forceinline__ void ph_scan_a(Ctx& F) {
    for (int item = F.bid; item < 240 + 480 + 16 + 32; item += F.G) {
        if (item < 240) ssd_item<false>(F, item / 15, 1 + item % 15);
        else if (item < 720) { const int q = item - 240; gla_item<false>(F, q / 15, 1 + q % 15); }
        else if (item < 736) ssd_item<false>(F, item - 720, 0);
        else gla_item<false>(F, item - 736, 0);
    }
}
__device__ __forceinline__ void ph_scan_b(Ctx& F) {
    const int gt = F.bid * 512 + F.tid, NT = F.G * 512;
    for (int it = gt; it < 32 * 2048 + 16 * 8192; it += NT) {
        if (it < 32 * 2048) {
            const int seq = it >> 11, e4 = it & 2047, e = e4 * 4, lane = (e >> 4) & 63, dt = (e >> 2) & 3, d0 = 16 * dt + 4 * (lane >> 4);
            const bf16_t* U = (const bf16_t*)(F.ws + WS_USG) + (size_t)seq * 17 * 8192 + e; const float* A = (const float*)(F.ws + WS_ASG) + (size_t)seq * 17 * 64 + d0;
            bf16_t* O = (bf16_t*)(F.ws + WS_SSG) + (size_t)seq * 16 * 8192 + e;
            f32x4 S = ld_bf4(U); st_bf4(O, S);
#pragma unroll 1
            for (int m = 1; m < 16; ++m) { const f32x4 u = ld_bf4(U + (size_t)m * 8192); const f32x4 a = *(const f32x4*)(A + m * 64);
                S.x = __builtin_amdgcn_exp2f(a.x) * S.x + u.x; S.y = __builtin_amdgcn_exp2f(a.y) * S.y + u.y; S.z = __builtin_amdgcn_exp2f(a.z) * S.z + u.z; S.w = __builtin_amdgcn_exp2f(a.w) * S.w + u.w;
                st_bf4(O + (size_t)m * 8192, S); }
        } else {
            const int q = it - 32 * 2048, sg = q >> 13, e4 = q & 8191, e = e4 * 4, r = (e >> 12) >> 1;
            const bf16_t* U = (const bf16_t*)(F.ws + WS_USS) + (size_t)sg * 17 * 32768 + e; const float* A = (const float*)(F.ws + WS_ASS) + (size_t)sg * 17 * 4 + r;
            bf16_t* O = (bf16_t*)(F.ws + WS_SSS) + (size_t)sg * 16 * 32768 + e;
            f32x4 S = ld_bf4(U); st_bf4(O, S);
#pragma unroll 1
            for (int m = 1; m < 16; ++m) { const f32x4 u = ld_bf4(U + (size_t)m * 32768); const float a = __builtin_amdgcn_exp2f(A[m * 4]);
                S = S * a + u; st_bf4(O + (size_t)m * 32768, S); }
        }
    }
}
__device__ __forceinline__ void combine_gla_block(const Ctx& F, int b, int h, int seg) {
    const char* OG = (const char*)(F.ws + WS_OG); const char* P = (const char*)(F.ws + WS_P); char* Y = (char*)(F.ws + WS_Y);
    int l = F.lane; asm volatile("" : "+v"(l));
    const int sub = l >> 4, c8 = (l & 15) * 8, row0 = b * SEQ + 512 * (seg - 1);
    float nw[8]; { const f32x4 n0 = *(const f32x4*)(F.in[IN_GLANORM] + c8), n1 = *(const f32x4*)(F.in[IN_GLANORM] + c8 + 4); nw[0] = n0.x; nw[1] = n0.y; nw[2] = n0.z; nw[3] = n0.w; nw[4] = n1.x; nw[5] = n1.y; nw[6] = n1.z; nw[7] = n1.w; }
    constexpr int U = 4;
    for (int t0 = F.wave * 4 * U; t0 < 512; t0 += 8 * 4 * U) {
        u32x4 a[U], c[U], g[U];
#pragma unroll
        for (int u = 0; u < U; ++u) { const int row = row0 + t0 + 4 * u + sub;
            a[u] = *(const u32x4*)(OG + (unsigned)(row * 512 + h * 128 + c8) * 2u); c[u] = *(const u32x4*)(OG + (unsigned)((TL + row) * 512 + h * 128 + c8) * 2u);
            g[u] = *(const u32x4*)(P + (unsigned)(row * NP + CG + h * 128 + c8) * 2u); }
#pragma unroll
        for (int u = 0; u < U; ++u) { const int row = row0 + t0 + 4 * u + sub;
            float o[8], gt[8];
            o[0] = bflo(a[u].x) + bflo(c[u].x); o[1] = bfhi(a[u].x) + bfhi(c[u].x); o[2] = bflo(a[u].y) + bflo(c[u].y); o[3] = bfhi(a[u].y) + bfhi(c[u].y);
            o[4] = bflo(a[u].z) + bflo(c[u].z); o[5] = bfhi(a[u].z) + bfhi(c[u].z); o[6] = bflo(a[u].w) + bflo(c[u].w); o[7] = bfhi(a[u].w) + bfhi(c[u].w);
            gt[0] = bflo(g[u].x); gt[1] = bfhi(g[u].x); gt[2] = bflo(g[u].y); gt[3] = bfhi(g[u].y); gt[4] = bflo(g[u].z); gt[5] = bfhi(g[u].z); gt[6] = bflo(g[u].w); gt[7] = bfhi(g[u].w);
            float ss = 0.f;
#pragma unroll
            for (int i = 0; i < 8; ++i) ss += o[i] * o[i];
            ss += __shfl_xor(ss, 1); ss += __shfl_xor(ss, 2); ss += __shfl_xor(ss, 4); ss += __shfl_xor(ss, 8);
            const float rstd = rsqrtf(ss * (1.f / 128.f) + EPS);
#pragma unroll
            for (int i = 0; i < 8; ++i) o[i] = o[i] * rstd * nw[i] * silu_f(gt[i]);
            u32x4 w; w.x = pk2(o[0], o[1]); w.y = pk2(o[2], o[3]); w.z = pk2(o[4], o[5]); w.w = pk2(o[6], o[7]);
            *(u32x4*)(Y + (unsigned)(row * 1024 + h * 128 + c8) * 2u) = w; }
    }
}
__device__ __forceinline__ void combine_ssd_block(const Ctx& F, int b, int g, int seg) {
    const char* OS = (const char*)(F.ws + WS_OS); const char* P = (const char*)(F.ws + WS_P); const char* XBC = (const char*)(F.ws + WS_XBC); char* Y = (char*)(F.ws + WS_Y);
    int l = F.lane; asm volatile("" : "+v"(l));
    const int sub = l >> 5, c0 = g * 256 + (l & 31) * 8, row0 = b * SEQ + 512 * (seg - 1);
    float nw[8]; { const f32x4 n0 = *(const f32x4*)(F.in[IN_SSDNORM] + c0), n1 = *(const f32x4*)(F.in[IN_SSDNORM] + c0 + 4); nw[0] = n0.x; nw[1] = n0.y; nw[2] = n0.z; nw[3] = n0.w; nw[4] = n1.x; nw[5] = n1.y; nw[6] = n1.z; nw[7] = n1.w; }
    const float Dh = F.in[IN_SSDD][c0 >> 6];
    constexpr int U = 4;
    for (int t0 = F.wave * 2 * U; t0 < 512; t0 += 8 * 2 * U) {
        u32x4 a[U], c[U], z[U], x[U];
#pragma unroll
        for (int u = 0; u < U; ++u) { const int row = row0 + t0 + 2 * u + sub;
            a[u] = *(const u32x4*)(OS + (unsigned)(row * 512 + c0) * 2u); c[u] = *(const u32x4*)(OS + (unsigned)((TL + row) * 512 + c0) * 2u);
            z[u] = *(const u32x4*)(P + (unsigned)(row * NP + CZ + c0) * 2u); x[u] = *(const u32x4*)(XBC + (unsigned)(row * 1024 + c0) * 2u); }
#pragma unroll
        for (int u = 0; u < U; ++u) { const int row = row0 + t0 + 2 * u + sub;
            float v[8];
#define SSDV(i, A, C, X, Z) v[i] = (A + C + Dh * X) * silu_f(Z)
            SSDV(0, bflo(a[u].x), bflo(c[u].x), bflo(x[u].x), bflo(z[u].x)); SSDV(1, bfhi(a[u].x), bfhi(c[u].x), bfhi(x[u].x), bfhi(z[u].x));
            SSDV(2, bflo(a[u].y), bflo(c[u].y), bflo(x[u].y), bflo(z[u].y)); SSDV(3, bfhi(a[u].y), bfhi(c[u].y), bfhi(x[u].y), bfhi(z[u].y));
            SSDV(4, bflo(a[u].z), bflo(c[u].z), bflo(x[u].z), bflo(z[u].z)); SSDV(5, bfhi(a[u].z), bfhi(c[u].z), bfhi(x[u].z), bfhi(z[u].z));
            SSDV(6, bflo(a[u].w), bflo(c[u].w), bflo(x[u].w), bflo(z[u].w)); SSDV(7, bfhi(a[u].w), bfhi(c[u].w), bfhi(x[u].w), bfhi(z[u].w));
#undef SSDV
            float ss = 0.f;
#pragma unroll
            for (int i = 0; i < 8; ++i) ss += v[i] * v[i];
            ss += __shfl_xor(ss, 1); ss += __shfl_xor(ss, 2); ss += __shfl_xor(ss, 4); ss += __shfl_xor(ss, 8); ss += __shfl_xor(ss, 16);
            const float rstd = rsqrtf(ss * (1.f / 256.f) + EPS);
            u32x4 w; w.x = pk2(v[0] * rstd * nw[0], v[1] * rstd * nw[1]); w.y = pk2(v[2] * rstd * nw[2], v[3] * rstd * nw[3]); w.z = pk2(v[4] * rstd * nw[4], v[5] * rstd * nw[5]); w.w = pk2(v[6] * rstd * nw[6], v[7] * rstd * nw[7]);
            *(u32x4*)(Y + (unsigned)(row * 1024 + 512 + c0) * 2u) = w; }
    }
}
__device__ __forceinline__ void ph_scan_c(Ctx& F) {
    const bool deal = (F.G == 256);
    const int first = deal ? (F.bid < 128 ? F.bid : 128 + 2 * (F.bid - 128)) : F.bid;
    const int count = deal ? (F.bid < 128 ? 1 : 2) : (384 - F.bid + F.G - 1) / F.G;
    const int step = deal ? 1 : F.G;
#pragma unroll 1
    for (int k2 = 0; k2 < 2 * count; ++k2) {
        const int pit = first + (k2 >> 1) * step, d = k2 & 1;
        asm volatile("" : "+s"(F.ws));
        if (pit < 128) { const int seg = 1 + (pit & 15); ssd_item<true>(F, (pit >> 4) * 2 + d, d ? 17 - seg : seg); }
        else { const int seg = 1 + ((pit - 128) & 15); gla_item<true>(F, ((pit - 128) >> 4) * 2 + d, d ? 17 - seg : seg); }
        if (d) {
            asm volatile("s_waitcnt vmcnt(0)" ::: "memory"); __syncthreads();
            if (pit < 128) combine_ssd_block(F, pit >> 5, (pit >> 4) & 1, 1 + (pit & 15));
            else combine_gla_block(F, (pit - 128) >> 6, ((pit - 128) >> 4) & 3, 1 + ((pit - 128) & 15));
        }
    }
}

#define UNP(dst, w0, w1) dst[0] = bflo(w0.x); dst[1] = bfhi(w0.x); dst[2] = bflo(w0.y); dst[3] = bfhi(w0.y); dst[4] = bflo(w0.z); dst[5] = bfhi(w0.z); dst[6] = bflo(w0.w); dst[7] = bfhi(w0.w); \
        dst[8] = bflo(w1.x); dst[9] = bfhi(w1.x); dst[10] = bflo(w1.y); dst[11] = bfhi(w1.y); dst[12] = bflo(w1.z); dst[13] = bfhi(w1.z); dst[14] = bflo(w1.w); dst[15] = bfhi(w1.w)
__device__ __forceinline__ void ph_combine(Ctx& F) {
    const bf16_t* P = (const bf16_t*)(F.ws + WS_P); const bf16_t* XBC = (const bf16_t*)(F.ws + WS_XBC);
    const bf16_t* OG = (const bf16_t*)(F.ws + WS_OG); const bf16_t* OS = (const bf16_t*)(F.ws + WS_OS); bf16_t* Y = (bf16_t*)(F.ws + WS_Y);
    const int gw = F.bid * 8 + F.wave, NGW = F.G * 8, l = F.lane;
    const bool gla = l < 32; const int c0 = gla ? 16 * l : 16 * (l - 32);
    float nwv[16]; { const float* nw = gla ? F.in[IN_GLANORM] + (c0 & 127) : F.in[IN_SSDNORM] + c0;
#pragma unroll
        for (int i = 0; i < 16; ++i) nwv[i] = nw[i]; }
    const float Dh = F.in[IN_SSDD][c0 >> 6];
    constexpr int U = 4;
    for (int r0 = gw * U; r0 < TL; r0 += NGW * U) {
        u32x4 a0[U], a1[U], b0[U], b1[U], g0[U], g1[U], x0[U], x1[U];
#pragma unroll
        for (int u = 0; u < U; ++u) { const int r = r0 + u;
            const bf16_t* o0 = (gla ? OG : OS) + (size_t)r * 512 + c0; const bf16_t* o1 = o0 + (size_t)TL * 512;
            const bf16_t* gz = P + (size_t)r * NP + (gla ? CG : CZ) + c0; const bf16_t* xp = XBC + (size_t)r * 1024 + c0;
            a0[u] = *(const u32x4*)o0; a1[u] = *(const u32x4*)(o0 + 8); b0[u] = *(const u32x4*)o1; b1[u] = *(const u32x4*)(o1 + 8); g0[u] = *(const u32x4*)gz; g1[u] = *(const u32x4*)(gz + 8);
            x0[u] = (u32x4){0u, 0u, 0u, 0u}; x1[u] = x0[u];
            if (!gla) { x0[u] = *(const u32x4*)xp; x1[u] = *(const u32x4*)(xp + 8); } }
#pragma unroll
        for (int u = 0; u < U; ++u) { const int r = r0 + u;
            float v[16], gt[16], t0[16], t1[16], xv[16]; UNP(t0, a0[u], a1[u]); UNP(t1, b0[u], b1[u]); UNP(gt, g0[u], g1[u]); UNP(xv, x0[u], x1[u]);
#pragma unroll
            for (int i = 0; i < 16; ++i) { const float sg = silu_f(gt[i]); v[i] = gla ? (t0[i] + t1[i]) : (t0[i] + t1[i] + Dh * xv[i]) * sg; gt[i] = sg; }
            float ss = 0.f;
#pragma unroll
            for (int i = 0; i < 16; ++i) ss += v[i] * v[i];
            ss += __shfl_xor(ss, 1); ss += __shfl_xor(ss, 2); ss += __shfl_xor(ss, 4);
            const float s8 = __shfl_xor(ss, 8); if (!gla) ss += s8;
            const float rstd = rsqrtf(ss * (gla ? (1.f / 128.f) : (1.f / 256.f)) + EPS);
            float o[16];
#pragma unroll
            for (int i = 0; i < 16; ++i) { float y = v[i] * rstd * nwv[i]; if (gla) y *= gt[i]; o[i] = y; }
            u32x4 w0, w1; w0.x = pk2(o[0], o[1]); w0.y = pk2(o[2], o[3]); w0.z = pk2(o[4], o[5]); w0.w = pk2(o[6], o[7]); w1.x = pk2(o[8], o[9]); w1.y = pk2(o[10], o[11]); w1.z = pk2(o[12], o[13]); w1.w = pk2(o[14], o[15]);
            bf16_t* yp = Y + (size_t)r * 1024 + (gla ? 0 : 512) + c0;
            *(u32x4*)yp = w0; *(u32x4*)(yp + 8) = w1; }
    }
}

constexpr int WRS = 1028;
__device__ __forceinline__ void ph_router(Ctx& F) {
    const float* mod = (const float*)(F.ws + WS_MOD); unsigned char* H2 = (unsigned char*)(F.ws + WS_H);
    unsigned* ctl = (unsigned*)(F.ws + WS_CTL);
    int* tok_e = (int*)(F.ws + WS_TOKE); int* tok_p = (int*)(F.ws + WS_TOKP); float* tok_g = (float*)(F.ws + WS_TOKG); int* rowtok = (int*)(F.ws + WS_ROWTOK);
    LAS float* WT = (LAS float*)F.lds;
    LAS int* lcnt = (LAS int*)(F.lds + MISC_OFF);
    LAS int* gbase = lcnt + 32;
    LAS int* rec_e = gbase + 32;
    LAS int* rec_p = rec_e + 512;
    LAS float* biasl = (LAS float*)(rec_p + 512);
    LAS float* rsl = biasl + 32;
    LAS float* wpl = rsl + 128;
    LAS float* shl = wpl + 1024;
    const int l = F.lane, i16 = l & 15, kk = l >> 4, w = F.wave;
    if (F.bid == 0) { for (int i = F.tid; i < 256; i += 512) ((unsigned*)(H2 + (size_t)ZROW * DM))[i] = 0u; }
    int cur_b = -1;
    for (int tile = F.bid; tile < TL / 128; tile += F.G) {
        const int b = (tile * 128) >> 13;
        if (b != cur_b) {
            cur_b = b;
            __syncthreads();
            const float* sh = mod + b * 6144 + 3 * 1024; const float* scl = sh + 1024;
            for (int k = F.tid; k < 1024; k += 512) { wpl[k] = F.in[IN_NORM2][k] * (1.f + scl[k]); shl[k] = sh[k]; }
            if (F.tid < 32) lcnt[F.tid] = 0;
            __syncthreads();
            { float ba = 0.f;
#pragma unroll 16
              for (int j = 0; j < 64; ++j) { const int i = F.tid + 512 * j, k = i >> 5, e = i & 31; const float wr = F.in[IN_WR][i]; WT[e * WRS + k] = wr * wpl[k]; ba += shl[k] * wr; }
              LAS float* red = (LAS float*)(rec_e);
              red[(F.tid >> 5) * 32 + (F.tid & 31)] = ba; }
            __syncthreads();
            if (F.tid < 32) { float a = F.in[IN_BR][F.tid];
#pragma unroll
                for (int q = 0; q < 16; ++q) a += ((LAS float*)rec_e)[q * 32 + F.tid];
                biasl[F.tid] = a; }
            __syncthreads();
        }
        const int row = tile * 128 + w * 16 + i16;
        const bf16_t* X1 = (const bf16_t*)(F.ws + WS_X1);
        const bf16_t* xr = X1 + (size_t)row * DM + 256 * kk;
        const LAS float* w0p = WT + i16 * WRS + 256 * kk; const LAS float* w1p = w0p + 16 * WRS;
        f32x4 a0 = (f32x4){0.f, 0.f, 0.f, 0.f}, a1 = a0; float ss = 0.f;
#pragma unroll 4
        for (int q = 0; q < 32; ++q) { const u32x4 xb = *(const u32x4*)(xr + 8 * q); float xv[8];
            xv[0] = bflo(xb.x); xv[1] = bfhi(xb.x); xv[2] = bflo(xb.y); xv[3] = bfhi(xb.y); xv[4] = bflo(xb.z); xv[5] = bfhi(xb.z); xv[6] = bflo(xb.w); xv[7] = bfhi(xb.w);
            const f32x4 w0a = *(const LAS f32x4*)(w0p + 8 * q), w0b = *(const LAS f32x4*)(w0p + 8 * q + 4), w1a = *(const LAS f32x4*)(w1p + 8 * q), w1b = *(const LAS f32x4*)(w1p + 8 * q + 4);
#pragma unroll
            for (int c = 0; c < 8; ++c) ss += xv[c] * xv[c];
#pragma unroll
            for (int c = 0; c < 4; ++c) { a0 = __builtin_amdgcn_mfma_f32_16x16x4f32(xv[c], w0a[c], a0, 0, 0, 0); a1 = __builtin_amdgcn_mfma_f32_16x16x4f32(xv[c], w1a[c], a1, 0, 0, 0); }
#pragma unroll
            for (int c = 0; c < 4; ++c) { a0 = __builtin_amdgcn_mfma_f32_16x16x4f32(xv[4 + c], w0b[c], a0, 0, 0, 0); a1 = __builtin_amdgcn_mfma_f32_16x16x4f32(xv[4 + c], w1b[c], a1, 0, 0, 0); } }
        ss += __shfl_xor(ss, 16); ss += __shfl_xor(ss, 32);
        const float rstd_i = rsqrtf(ss * (1.f / DM) + EPS);
        if (kk == 0) rsl[w * 16 + i16] = rstd_i;
        LDS_WAIT(); asm volatile("" ::: "memory");
        const f32x4 rs4 = *(const LAS f32x4*)(rsl + w * 16 + 4 * kk);
        const float bz0 = biasl[i16], bz1 = biasl[16 + i16];
        float v0[4], v1[4];
#pragma unroll
        for (int r = 0; r < 4; ++r) { v0[r] = a0[r] * rs4[r] + bz0; v1[r] = a1[r] * rs4[r] + bz1; }
        int ei[4][4]; float ev[4][4];
#pragma unroll
        for (int k = 0; k < 4; ++k)
#pragma unroll
            for (int r = 0; r < 4; ++r) { float bv = v0[r]; int bi = i16; if (v1[r] > bv) { bv = v1[r]; bi = 16 + i16; }
#pragma unroll
                for (int o = 1; o < 16; o <<= 1) { const float ov = __shfl_xor(bv, o); const int oi = __shfl_xor(bi, o); if (ov > bv || (ov == bv && oi < bi)) { bv = ov; bi = oi; } }
                ei[k][r] = bi; ev[k][r] = bv; if (bi == i16) v0[r] = -3.3e38f; if (bi == 16 + i16) v1[r] = -3.3e38f; }
        if (i16 == 0) {
#pragma unroll
            for (int r = 0; r < 4; ++r) { const int tl = w * 16 + 4 * kk + r, rr = tile * 128 + tl;
                const float e1 = __expf(ev[1][r] - ev[0][r]), e2 = __expf(ev[2][r] - ev[0][r]), e3 = __expf(ev[3][r] - ev[0][r]); const float inv = 1.f / (1.f + e1 + e2 + e3);
                const float gts[4] = {inv, e1 * inv, e2 * inv, e3 * inv};
#pragma unroll
                for (int k = 0; k < 4; ++k) { const int lp = __hip_atomic_fetch_add(lcnt + ei[k][r], 1, __ATOMIC_RELAXED, __HIP_MEMORY_SCOPE_WORKGROUP);
                    rec_e[tl * 4 + k] = ei[k][r]; rec_p[tl * 4 + k] = lp; tok_g[(size_t)rr * 4 + k] = gts[k]; } }
        }
#pragma unroll 4
        for (int t = 0; t < 16; ++t) { const int r2 = tile * 128 + w * 16 + t; const float rs = rsl[w * 16 + t];
#pragma unroll
            for (int q = 0; q < 4; ++q) { const int idx = 4 * (l + 64 * q); const u32x2 xb = *(const u32x2*)(X1 + (size_t)r2 * DM + idx); const f32x4 xv = (f32x4){bflo(xb.x), bfhi(xb.x), bflo(xb.y), bfhi(xb.y)};
                const f32x4 wp = *(const LAS f32x4*)(wpl + idx), s4 = *(const LAS f32x4*)(shl + idx);
                const f32x4 o = (xv * rs * wp + s4) * HSCALE8;
                *(unsigned*)(H2 + (size_t)r2 * DM + idx) = pg8::pk4_fp8(o.x, o.y, o.z, o.w); } }
        __syncthreads();
        if (F.tid < 32) gbase[F.tid] = (int)__hip_atomic_fetch_add(ctl + CW_CNT + 64 * F.tid, (unsigned)lcnt[F.tid], __ATOMIC_RELAXED, __HIP_MEMORY_SCOPE_AGENT);
        __syncthreads();
        { const int tl = F.tid >> 2, r = tile * 128 + tl; const int e = rec_e[F.tid], pos = gbase[e] + rec_p[F.tid];
          tok_e[(size_t)r * 4 + (F.tid & 3)] = e; tok_p[(size_t)r * 4 + (F.tid & 3)] = pos; rowtok[(size_t)e * TL + pos] = r; }
        __syncthreads();
        if (F.tid < 32) lcnt[F.tid] = 0;
        __syncthreads();
    }
}

__device__ __forceinline__ void moe_tables(Ctx& F, LAS int*& cn, LAS int*& tb) {
    const unsigned* ctl = (const unsigned*)(F.ws + WS_CTL);
    cn = (LAS int*)(F.lds + MISC_OFF); tb = cn + 32;
    __syncthreads();
    if (F.tid < 32) cn[F.tid] = (int)__hip_atomic_load(ctl + CW_CNT + 64 * F.tid, __ATOMIC_RELAXED, __HIP_MEMORY_SCOPE_AGENT);
    __syncthreads();
    if (F.tid == 0) { int s = 0; for (int e = 0; e < 32; ++e) { tb[e] = s; s += (cn[e] + 255) >> 8; } tb[32] = s; }
    __syncthreads();
}

__device__ __forceinline__ void ph_final(Ctx& F, float* dst) {
    LAS int* cn; LAS int* tb; moe_tables(F, cn, tb);
    const float* mod = (const float*)(F.ws + WS_MOD); const unsigned char* YP = (const unsigned char*)(F.ws + WS_YP);
    const int* tok_e = (const int*)(F.ws + WS_TOKE); const int* tok_p = (const int*)(F.ws + WS_TOKP); const float* tok_g = (const float*)(F.ws + WS_TOKG);
    const int gw = F.bid * 8 + F.wave, NGW = F.G * 8;
    f32x4 fn[4];
#pragma unroll
    for (int q = 0; q < 4; ++q) fn[q] = *(const f32x4*)(F.in[IN_FNORM] + 4 * (F.lane + 64 * q));
    constexpr int U = 2;
    int4 ne[U], np[U]; f32x4 ng[U];
#pragma unroll
    for (int u = 0; u < U; ++u) { const int r = gw * U + u; ne[u] = *(const int4*)(tok_e + (size_t)r * 4); np[u] = *(const int4*)(tok_p + (size_t)r * 4); ng[u] = *(const f32x4*)(tok_g + (size_t)r * 4); }
    for (int r0 = gw * U; r0 < TL; r0 += NGW * U) {
        const unsigned char* yr[U][4]; float gt[U][4];
#pragma unroll
        for (int u = 0; u < U; ++u) { const int4 e4 = ne[u], p4 = np[u]; const f32x4 g4 = ng[u];
            yr[u][0] = YP + ((size_t)tb[e4.x] * 256 + p4.x) * DM; yr[u][1] = YP + ((size_t)tb[e4.y] * 256 + p4.y) * DM; yr[u][2] = YP + ((size_t)tb[e4.z] * 256 + p4.z) * DM; yr[u][3] = YP + ((size_t)tb[e4.w] * 256 + p4.w) * DM;
            gt[u][0] = g4.x * (1.0f / PSCALE8); gt[u][1] = g4.y * (1.0f / PSCALE8); gt[u][2] = g4.z * (1.0f / PSCALE8); gt[u][3] = g4.w * (1.0f / PSCALE8); }
        unsigned yw[U][4][4]; f32x4 xv[U][4];
        if (r0 + NGW * U < TL) {
#pragma unroll
            for (int u = 0; u < U; ++u) { const int r = r0 + NGW * U + u; ne[u] = *(const int4*)(tok_e + (size_t)r * 4); np[u] = *(const int4*)(tok_p + (size_t)r * 4); ng[u] = *(const f32x4*)(tok_g + (size_t)r * 4); } }
#pragma unroll
        for (int u = 0; u < U; ++u) {
#pragma unroll
            for (int k = 0; k < 4; ++k)
#pragma unroll
                for (int q = 0; q < 4; ++q) yw[u][k][q] = *(const unsigned*)(yr[u][k] + 4 * (F.lane + 64 * q));
#pragma unroll
            for (int q = 0; q < 4; ++q) { const u32x2 xb = ((const u32x2*)((const bf16_t*)(F.ws + WS_X1) + (size_t)(r0 + u) * DM))[F.lane + 64 * q]; xv[u][q] = (f32x4){bflo(xb.x), bfhi(xb.x), bflo(xb.y), bfhi(xb.y)}; } }
#pragma unroll
        for (int u = 0; u < U; ++u) { const int r = r0 + u; const int b = r >> 13; const float* g2 = mod + b * 6144 + 5 * 1024;
            f32x4 v[4]; float ss = 0.f;
#pragma unroll
            for (int q = 0; q < 4; ++q) { f32x4 m = (f32x4){0.f, 0.f, 0.f, 0.f};
#pragma unroll
                for (int k = 0; k < 4; ++k) { const unsigned w = yw[u][k][q]; const f32x2 lo = __builtin_amdgcn_cvt_pk_f32_fp8((int)w, false), hi = __builtin_amdgcn_cvt_pk_f32_fp8((int)w, true); m += (f32x4){lo.x, lo.y, hi.x, hi.y} * gt[u][k]; }
                v[q] = xv[u][q] + *(const f32x4*)(g2 + 4 * (F.lane + 64 * q)) * m;
                ss += (v[q].x * v[q].x + v[q].y * v[q].y) + (v[q].z * v[q].z + v[q].w * v[q].w); }
            const float rstd = rsqrtf(wave_sum(ss) * (1.f / DM) + EPS);
#pragma unroll
            for (int q = 0; q < 4; ++q) ((f32x4*)(dst + (size_t)r * DM))[F.lane + 64 * q] = v[q] * rstd * fn[q]; }
    }
}

constexpr int NPHASE = 13;
__global__ void __launch_bounds__(512, 2) mega(Params p) {
    extern __shared__ __attribute__((aligned(16))) unsigned char lds_raw[];
    Ctx F;
    F.lds = (LAS unsigned char*)lds_raw; F.tid = threadIdx.x; F.lane = F.tid & 63; F.wave = __builtin_amdgcn_readfirstlane(F.tid >> 6); F.bid = blockIdx.x; F.G = gridDim.x;
    F.in = p.in; F.out = p.out; F.ws = p.ws;
    const int lo = p.ph_lo, hi = p.ph_hi;
#ifndef PH_MASK
#define PH_MASK 0x1fff
#endif
#define IN(k) (((PH_MASK >> (k)) & 1) && lo <= (k) && (k) < hi)
#ifndef PH_REP
#define PH_REP 0
#endif
#ifndef XBAR_EXTRA
#define XBAR_EXTRA 0
#endif
#define REPS(k) (1 + ((PH_REP >> (k)) & 1))
#define RUN(k, ...) do { if (IN(k)) { if (REPS(k) > 1) { const int _rep = 0; __VA_ARGS__; __syncthreads(); } { const int _rep = REPS(k) - 1; __VA_ARGS__; } } } while (0)
#define RUN1(k, ...) do { if (IN(k)) { __VA_ARGS__; } } while (0)
#if MK_FUSED
    volatile LAS unsigned* bst = (volatile LAS unsigned*)(F.lds + LDS_BYTES - 64);
    if (F.tid < 16) bst[F.tid] = 0u;
    __syncthreads();
    XcdBarrier bar = xcd_barrier_post((unsigned*)(F.ws + WS_CTL) + CW_BAR, bst);
#define SEAM(k) do { if (IN(k) && IN((k) + 1)) { xcd_barrier(bar); } } while (0)
#else
#define SEAM(k) do { } while (0)
#endif
    RUN(0, ph_prologue(F)); SEAM(0);
    RUN(1, ph_norm1(F)); SEAM(1);
#if MK_FUSED
    for (int _x = 0; _x < XBAR_EXTRA; ++_x) xcd_barrier(bar);
#endif
    RUN1(2, {
        constexpr int NSETS = (NEXP * 8 * 64 + NEXP * 8 * 32) / 8, NTILE = (TT / 256) * (NP / 256), CPT = 4;
        const int c_hi = NTILE % F.G == 0 ? F.G : NTILE % F.G;
        const int n_lo = (NSETS - CPT * (F.G - c_hi) + F.G - 1) / F.G < 0 ? 0 : (NSETS - CPT * (F.G - c_hi) + F.G - 1) / F.G, n_hi = n_lo + CPT;
        const int grp = (F.bid >> 3) & 7, cut = __builtin_amdgcn_readfirstlane(grp == 7 ? (1 << 20) : grp);
        _Pragma("unroll 1") for (int part = 0; part < 2; ++part) {
            if (part) { __syncthreads(); expert_weight_copies(F, c_hi, n_lo, n_hi); __syncthreads(); }
            const pg8::DenseOrder S{TT / 256, NP / 256, F.G, F.bid, (const char*)(F.ws + WS_WIN), 2048u, 1, part ? cut : 0, part ? (1 << 20) : cut};
            const pg8::EpiBf16 E{(bf16_t*)(F.ws + WS_P), NP, nullptr, 0, 1.0f};
            pg8::gemm_phase<pg8::EpiBf16, pg8::DenseOrder, true>(F.lds, (const bf16_t*)(F.ws + WS_H), S, E);
        }
    }); SEAM(2);
    RUN(3, ph_conv_g(F)); SEAM(3);
#if MK_NAIVE_SCAN
    RUN(4, ph_scan_naive(F)); SEAM(4); SEAM(5);
#else
    RUN(4, ph_scan_a(F)); SEAM(4);
    RUN(5, ph_scan_b(F)); SEAM(5);
    RUN(6, ph_scan_c(F));
#endif
    SEAM(6);
    RUN1(8, {
        pg8::DenseOrder S{TL / 256, DM / 256, F.G, F.bid, (const char*)(F.ws + WS_WOUT), 2048u, REPS(8)};
        pg8::EpiResGate E{F.in[IN_X], (bf16_t*)(F.ws + WS_X1), (const float*)(F.ws + WS_MOD)};
        pg8::gemm_phase<pg8::EpiResGate, pg8::DenseOrder, true>(F.lds, (const bf16_t*)(F.ws + WS_Y), S, E);
    }); SEAM(8);
    RUN(9, ph_router(F)); SEAM(9);
#if MK_FUSED
    RUN1(10, {
        LAS int* cn; LAS int* tb; moe_tables(F, cn, tb);
        const int nMt = __builtin_amdgcn_readfirstlane(tb[32]);
        unsigned* sb1 = (unsigned*)(F.ws + WS_CTL) + CW_SB; unsigned* sb2 = sb1 + 2048;
        int a1;
        {   pg8::MoeOrder<true> S{nMt, 8, F.G, F.bid, (const char*)(F.ws + WS_WGU), 2048, tb, cn, (const int*)(F.ws + WS_ROWTOK), 1024u, 0};
            pg8::EpiSwiglu E{(unsigned char*)(F.ws + WS_ACT), F.in[IN_BGU], 1.0f / (HSCALE8 * WSCALE8), ASCALE8, (LAS float*)(F.lds + MISC_OFF + 2048)};
            a1 = (S.trips() * 3) / 4; a1 = a1 < 1 ? 1 : a1;
            ArriveSync Y{&bar, sb1, a1, false};
            pg8::gemm_phase<pg8::EpiSwiglu, pg8::MoeOrder<true>, true, true, ArriveSync>(F.lds, (const bf16_t*)(F.ws + WS_H), S, E, &Y);
            if (F.tid == 0) { if (!Y.done) sb_arrive(bar, sb1); sb_arrive(bar, sb2); }
        }
        if (IN(11)) {
            if (F.tid == 0) sb_wait(bar, sb1);
            __syncthreads();
            pg8::MoeOrder<false> S{nMt, 4, F.G, F.bid, (const char*)(F.ws + WS_WD), 1024, tb, cn, nullptr, 1024u, 8};
            pg8::EpiFp8 E{(unsigned char*)(F.ws + WS_YP), DM, F.in[IN_BD], 1024, 1.0f / (ASCALE8 * WSCALE8), PSCALE8, (LAS float*)(F.lds + MISC_OFF + 2048)};
            WaitSync<pg8::MoeOrder<false>> Y{&bar, sb2, a1, false, &S, 8};
            pg8::gemm_phase<pg8::EpiFp8, pg8::MoeOrder<false>, true, true, WaitSync<pg8::MoeOrder<false>>>(F.lds, (const bf16_t*)(F.ws + WS_ACT), S, E, &Y);
        }
    }); SEAM(11);
#else
    RUN1(10, {
        LAS int* cn; LAS int* tb; moe_tables(F, cn, tb);
        pg8::MoeOrder<true> S{__builtin_amdgcn_readfirstlane(tb[32]), 8, F.G, F.bid, (const char*)(F.ws + WS_WGU), 2048, tb, cn, (const int*)(F.ws + WS_ROWTOK), 1024u, 0};
        pg8::EpiSwiglu E{(unsigned char*)(F.ws + WS_ACT), F.in[IN_BGU], 1.0f / (HSCALE8 * WSCALE8), ASCALE8, (LAS float*)(F.lds + MISC_OFF + 2048)};
        pg8::gemm_phase<pg8::EpiSwiglu, pg8::MoeOrder<true>, true, true>(F.lds, (const bf16_t*)(F.ws + WS_H), S, E);
    });
    RUN1(11, {
        LAS int* cn; LAS int* tb; moe_tables(F, cn, tb);
        pg8::MoeOrder<false> S{__builtin_amdgcn_readfirstlane(tb[32]), 4, F.G, F.bid, (const char*)(F.ws + WS_WD), 1024, tb, cn, nullptr, 1024u, 0};
        pg8::EpiFp8 E{(unsigned char*)(F.ws + WS_YP), DM, F.in[IN_BD], 1024, 1.0f / (ASCALE8 * WSCALE8), PSCALE8, (LAS float*)(F.lds + MISC_OFF + 2048)};
        pg8::gemm_phase<pg8::EpiFp8, pg8::MoeOrder<false>, true, true>(F.lds, (const bf16_t*)(F.ws + WS_ACT), S, E);
    });
#endif
    RUN(12, ph_final(F, (_rep + 1 < REPS(12)) ? (float*)(F.ws + WS_ACT) : F.out));
#undef IN
#undef SEAM
#undef RUN
#undef RUN1
}

extern "C" void kernel_launch(void* const* d_in, const int* in_sizes, int n_in, void* d_out, int out_size, void* d_ws, size_t ws_size, hipStream_t stream) {
    static int grid = 0;
    if (grid == 0) {
        if (n_in != 26 || out_size != TL * DM || ws_size < WS_END) { fprintf(stderr, "kernel_launch: unexpected problem (n_in %d, out %d, ws %zu)\n", n_in, out_size, ws_size); grid = -1; return; }
        int dev = 0, cus = 0, per_cu = 0;
        if (hipGetDevice(&dev) != hipSuccess || hipDeviceGetAttribute(&cus, hipDeviceAttributeMultiprocessorCount, dev) != hipSuccess) { grid = -1; return; }
        if (hipFuncSetAttribute((const void*)mega, hipFuncAttributeMaxDynamicSharedMemorySize, LDS_BYTES) != hipSuccess) { fprintf(stderr, "kernel_launch: hipFuncSetAttribute failed\n"); grid = -1; return; }
        if (hipOccupancyMaxActiveBlocksPerMultiprocessor(&per_cu, (const void*)mega, 512, LDS_BYTES) != hipSuccess || per_cu < 1) { fprintf(stderr, "kernel_launch: occupancy query says %d\n", per_cu); per_cu = 1; }
        (void)hipGetLastError();
        grid = cus;
    }
    if (grid < 0) return;
    (void)hipMemsetAsync((char*)d_ws + WS_CTL, 0, CTL_ZERO, stream);
    Params a{};
    for (int i = 0; i < 26; ++i) a.in[i] = (const float*)d_in[i];
    a.out = (float*)d_out; a.ws = (unsigned char*)d_ws;
#if MK_FUSED
    a.ph_lo = 0; a.ph_hi = NPHASE;
    hipLaunchKernelGGL(mega, dim3(grid), dim3(512), LDS_BYTES, stream, a);
#else
    for (int ph = 0; ph < NPHASE; ++ph) {
        a.ph_lo = ph; a.ph_hi = ph + 1;
        hipLaunchKernelGGL(mega, dim3(grid), dim3(512), LDS_BYTES, stream, a);
    }
#endif
}
```

```cpp
#include <hip/hip_runtime.h>
#include <hip/hip_cooperative_groups.h>
#include <cstdio>
#include <cstdint>
namespace cg = cooperative_groups;

#ifndef MK_FUSED
#define MK_FUSED 1
#endif
#ifndef MK_NAIVE_SCAN
#define MK_NAIVE_SCAN 0
#endif

#define LAS __attribute__((address_space(3)))
#define GAS __attribute__((address_space(1)))
typedef unsigned short bf16_t;
typedef short bf16x8 __attribute__((ext_vector_type(8)));
typedef float f32x4 __attribute__((ext_vector_type(4)));
typedef float f32x2 __attribute__((ext_vector_type(2)));
typedef unsigned u32x4 __attribute__((ext_vector_type(4)));
typedef unsigned u32x2 __attribute__((ext_vector_type(2)));

constexpr int NB = 4, SEQ = 8192, CTXL = 256, DM = 1024;
constexpr int TL = NB * SEQ;
constexpr int TCX = NB * CTXL;
constexpr int TT = TL + TCX;
constexpr int NP = 3328;
constexpr int CQ = 0, CK = 256, CV = 512, CG = 1024, CZ = 1536, CX = 2048, CGK = 3072, CDT = 3088;
constexpr int NEXP = 32, DFF = 1024;
constexpr float EPS = 1e-6f;
constexpr int MAXTILES = 544;
constexpr int ZROW = TL;

constexpr size_t MiB = 1u << 20;
constexpr size_t WS_CTL = 0, CTL_BYTES = 1 * MiB;
constexpr size_t WS_MOD = 1 * MiB;
constexpr size_t WS_WIN = 2 * MiB;
constexpr size_t WS_WOUT = 9 * MiB;
constexpr size_t WS_WGU = 11 * MiB;
constexpr size_t WS_WD = 139 * MiB;
constexpr size_t WS_TOKE = 203 * MiB;
constexpr size_t WS_TOKP = WS_TOKE + 512 * 1024;
constexpr size_t WS_TOKG = WS_TOKP + 512 * 1024;
constexpr size_t WS_ROWTOK = 205 * MiB;
constexpr size_t WS_H = 209 * MiB;
constexpr size_t WS_P = 276 * MiB;
constexpr size_t WS_XBC = 491 * MiB;
constexpr size_t WS_G = 557 * MiB;
constexpr size_t WS_OG = 623 * MiB;
constexpr size_t WS_OS = 687 * MiB;
constexpr size_t WS_Y = 751 * MiB;
constexpr size_t WS_ACT = 276 * MiB;
constexpr size_t WS_YP = 548 * MiB;
constexpr size_t WS_USG = 820 * MiB;
constexpr size_t WS_SSG = 837 * MiB;
constexpr size_t WS_USS = 853 * MiB;
constexpr size_t WS_SSS = 887 * MiB;
constexpr size_t WS_ASG = 919 * MiB;
constexpr size_t WS_ASS = 920 * MiB;
constexpr size_t WS_X1 = WS_OS;
constexpr size_t WS_END = 921 * MiB;
static_assert(WS_YP + (size_t)MAXTILES * 256 * 1024 <= WS_X1, "x1 buffer clear of the fp8 Yp overlay");
static_assert(WS_P + (size_t)TT * NP * 2 <= WS_XBC && WS_XBC + (size_t)TT * 1024 * 2 <= WS_G && WS_G + (size_t)2 * TT * 256 * 4 <= WS_OG, "ws map");
static_assert(WS_ACT + (size_t)MAXTILES * 256 * 2048 <= WS_YP && WS_YP + (size_t)MAXTILES * 256 * 2048 <= WS_END, "ws map 2");
static_assert(WS_H + (size_t)(TT + 256) * 2048 <= WS_P, "ws map 3");
constexpr int CW_CNT = 1024;
constexpr int CW_BAR = 8192;
constexpr int CW_SB = 12288;
constexpr size_t CTL_ZERO = 65536;
static_assert((CW_BAR + 3456) <= CW_SB && (CW_SB + 4096) * 4 <= (int)CTL_ZERO && (CW_CNT + 64 * 32) * 4 <= (int)CTL_ZERO, "control words inside the per-call memset");

constexpr int RING_BYTES = 131072;
constexpr int MISC_OFF = 132096;
constexpr int LDS_BYTES = 147456;

struct Params { const float* in[26]; float* out; unsigned char* ws; int ph_lo, ph_hi; };

__device__ __forceinline__ unsigned f2bf(float f) { unsigned u = __builtin_bit_cast(unsigned, f); return (u + 0x7fffu + ((u >> 16) & 1u)) >> 16; }
typedef __bf16 bf16x2_t __attribute__((ext_vector_type(2)));
__device__ __forceinline__ unsigned pk2(float lo, float hi) { const f32x2 v = {lo, hi}; const bf16x2_t b = __builtin_convertvector(v, bf16x2_t); return __builtin_bit_cast(unsigned, b); }
__device__ __forceinline__ unsigned pk2(float lo, float hi);
__device__ __forceinline__ float bflo(unsigned w);
__device__ __forceinline__ float bfhi(unsigned w);
__device__ __forceinline__ f32x4 ld_bf4(const bf16_t* p) { const u32x2 w = *(const u32x2*)p; return (f32x4){bflo(w.x), bfhi(w.x), bflo(w.y), bfhi(w.y)}; }
__device__ __forceinline__ void st_bf4(bf16_t* p, f32x4 v) { u32x2 w; w.x = pk2(v.x, v.y); w.y = pk2(v.z, v.w); *(u32x2*)p = w; }
__device__ __forceinline__ float bf2f(unsigned short h) { return __builtin_bit_cast(float, (unsigned)h << 16); }
__device__ __forceinline__ float bflo(unsigned w) { return __builtin_bit_cast(float, w << 16); }
__device__ __forceinline__ float bfhi(unsigned w) { return __builtin_bit_cast(float, w & 0xffff0000u); }
__device__ __forceinline__ float wave_sum(float v) {
#pragma unroll
    for (int o = 1; o < 64; o <<= 1) v += __shfl_xor(v, o);
    return v;
}
__device__ __forceinline__ float silu_f(float v) { return v * __builtin_amdgcn_rcpf(1.f + __builtin_amdgcn_exp2f(-1.4426950408889634f * v)); }
__device__ __forceinline__ float sigmoid_f(float v) { return 1.f / (1.f + __expf(-v)); }
__device__ __forceinline__ float softplus_f(float v) { return fmaxf(v, 0.f) + log1pf(__expf(-fabsf(v))); }
__device__ __forceinline__ float logsigmoid_f(float v) { return fminf(v, 0.f) - log1pf(__expf(-fabsf(v))); }
#define LDS_WAIT() asm volatile("s_waitcnt lgkmcnt(0)" ::: "memory")
#define LBAR() asm volatile("s_waitcnt lgkmcnt(0)\n\ts_barrier" ::: "memory")

namespace pg8 {
constexpr int BM = 256, BK = 64, HALF = 128, HTB = HALF * BK * 2, STAGE_BYTES = 8 * HTB, NXCD = 8, WGM = 8;
constexpr int KD = 1024;
typedef int i32x4 __attribute__((ext_vector_type(4)));
typedef int i32x8 __attribute__((ext_vector_type(8)));
#ifndef PG8_XORSWZ
#define PG8_XORSWZ 1
#endif
#if PG8_XORSWZ
__host__ __device__ __forceinline__ int lds_byte(int r, int c) { return r * 128 + ((((c >> 3) ^ (r >> 1)) & 7) << 4) + (c & 7) * 2; }
__host__ __device__ __forceinline__ void stage_rc(int b, int& R, int& C) { R = b >> 7; C = ((((b >> 4) ^ (R >> 1)) & 7) << 3); }
#else
__host__ __device__ __forceinline__ int lds_byte(int r, int c) { const int st = (r >> 4) * 2 + (c >> 5), rr = r & 15, cc = c & 31, ob = rr * 64 + cc * 2; return st * 1024 + (ob ^ (((ob >> 9) & 1) << 5)); }
__host__ __device__ __forceinline__ void stage_rc(int b, int& R, int& C) { const int st = b / 1024, sb = b % 1024, swz = sb ^ (((sb >> 9) & 1) << 5); R = (st >> 1) * 16 + swz / 64; C = (st & 1) * 32 + (swz % 64) / 2; }
#endif
__host__ __device__ __forceinline__ int perm32(int rho) { const int n = rho >> 4, i = rho & 15; return 8 * (i >> 2) + 4 * n + (i & 3); }

struct Unit { int pm, pn, e, mt; };

__device__ __forceinline__ void tile_of(int L, int nM, int nN, int& pm, int& pn) {
    const int nwg = nM * nN; int wgid = L;
    { const int q = nwg / NXCD, r = nwg % NXCD, xcd = wgid % NXCD, off = wgid / NXCD; wgid = (xcd < r ? xcd * (q + 1) : r * (q + 1) + (xcd - r) * q) + off; }
    const int nig = WGM * nN, gid = wgid / nig, fm = gid * WGM, gsz = (nM - fm) < WGM ? (nM - fm) : WGM;
    pm = fm + ((wgid % nig) % gsz); pn = (wgid % nig) / gsz;
}
struct DenseOrder {
    static constexpr bool GATHER = false;
    int nM, nN, G, c; const char* Bt; unsigned rowb; int dup; int i0 = 0, i1 = 1 << 20;
    __device__ __forceinline__ bool next(int i, Unit& u) const { i += i0; const long L = (long)i * G + c; if (i >= i1 || L >= (long)nM * nN * dup) return false; tile_of((int)L, nM, nN * dup, u.pm, u.pn); u.pn %= nN; u.e = 0; u.mt = u.pm; return true; }
    __device__ __forceinline__ const char* bbase(const Unit& u) const { return Bt + (size_t)u.pn * BM * rowb; }
    __device__ __forceinline__ unsigned arow(const Unit& u, int rl) const { return 0u; }
};
template <bool GATHER_> struct MoeOrder {
    static constexpr bool GATHER = GATHER_;
    int nMt, nN, G, c; const char* Bt; int brows; const LAS int* tb; const LAS int* cn; const int* rowtok; unsigned rowb; int rot;
    __device__ __forceinline__ void chunk(int& nxc, int& rank, int& m0, int& nMx) const {
        const int NC = G < NXCD ? G : NXCD, x = c % NC; nxc = (G - x + NC - 1) / NC; rank = c / NC;
        const int qm = nMt / NC, rm = nMt % NC; nMx = qm + (x < rm ? 1 : 0); m0 = x * qm + (x < rm ? x : rm);
    }
    __device__ __forceinline__ int trips() const { int nxc, rank, m0, nMx; chunk(nxc, rank, m0, nMx); return (nMx * nN + nxc - 1) / nxc; }
    __device__ __forceinline__ bool next(int i, Unit& u) const {
        int nxc, rank, m0, nMx; chunk(nxc, rank, m0, nMx);
        rank = (rank + nxc - (nMx * rot) % nxc) % nxc;
        const int off = i * nxc + rank; if (off >= nMx * nN) return false;
        const int nig = WGM * nN, gid = off / nig, fm = gid * WGM, gsz = (nMx - fm) < WGM ? (nMx - fm) : WGM;
        u.pm = m0 + fm + ((off % nig) % gsz); u.pn = (off % nig) / gsz;
        int e = 0;
#pragma unroll
        for (int q = 1; q < NEXP; ++q) e += (tb[q] <= u.pm) ? 1 : 0;
        e = __builtin_amdgcn_readfirstlane(e); u.e = e; u.mt = u.pm - __builtin_amdgcn_readfirstlane(tb[e]); return true;
    }
    __device__ __forceinline__ int last_trip_of(int pm, int nNp) const {
        int nxc, rank, m0, nMx; chunk(nxc, rank, m0, nMx);
        const int loc = pm - m0, gid = loc / WGM, fm = gid * WGM, gsz = (nMx - fm) < WGM ? (nMx - fm) : WGM;
        return (gid * (WGM * nNp) + (nNp - 1) * gsz + (loc - fm)) / nxc;
    }
    __device__ __forceinline__ const char* bbase(const Unit& u) const { return Bt + (size_t)(u.e * brows + u.pn * BM) * rowb; }
    __device__ __forceinline__ unsigned arow(const Unit& u, int rl) const {
        const int pos = u.mt * BM + rl; const int lim = __builtin_amdgcn_readfirstlane(cn[u.e]); int tok = ZROW; if (pos < lim) tok = rowtok[u.e * TL + pos]; return (unsigned)tok;
    }
};
struct NoSync { static constexpr bool ARRIVE = false, WAIT = false; };

__device__ __forceinline__ unsigned cvt_pk_bf16(float lo, float hi) { unsigned r; asm volatile("v_cvt_pk_bf16_f32 %0, %1, %2" : "=v"(r) : "v"(lo), "v"(hi)); return r; }

struct EpiBf16 {
    static constexpr bool PERM = true, LDSBIAS = false;
    bf16_t* O; int ldc; const float* bias; int bstride; float scale;
    __device__ __forceinline__ void operator()(const f32x4 (&acc)[2][2][4][2], const Unit& u, int wr, int wc, int fr, int fq) const {
        const int row0 = u.pm * BM + wr * 64 + fr; const int col0 = u.pn * BM + wc * 32 + 8 * fq;
        f32x4 bv[2][2];
#pragma unroll
        for (int bj = 0; bj < 2; ++bj)
#pragma unroll
            for (int n = 0; n < 2; ++n) bv[bj][n] = bias ? *(const f32x4*)(bias + (size_t)u.e * bstride + col0 + bj * HALF + 4 * n) : (f32x4){0.f, 0.f, 0.f, 0.f};
#pragma unroll
        for (int ai = 0; ai < 2; ++ai)
#pragma unroll
            for (int m = 0; m < 4; ++m) { bf16_t* rowp = O + (size_t)(row0 + ai * HALF + m * 16) * ldc + col0;
#pragma unroll
                for (int bj = 0; bj < 2; ++bj) { const f32x4 v0 = acc[ai][bj][m][0] * scale + bv[bj][0], v1 = acc[ai][bj][m][1] * scale + bv[bj][1];
                    u32x4 w; w.x = cvt_pk_bf16(v0[0], v0[1]); w.y = cvt_pk_bf16(v0[2], v0[3]); w.z = cvt_pk_bf16(v1[0], v1[1]); w.w = cvt_pk_bf16(v1[2], v1[3]);
                    *(u32x4*)(rowp + bj * HALF) = w; } }
    }
};
__device__ __forceinline__ float clamp448(float v) { return __builtin_amdgcn_fmed3f(v, -448.f, 448.f); }
__device__ __forceinline__ unsigned pk4_fp8(float a, float b, float c, float d) {
    int w = 0; w = __builtin_amdgcn_cvt_pk_fp8_f32(clamp448(a), clamp448(b), w, false); w = __builtin_amdgcn_cvt_pk_fp8_f32(clamp448(c), clamp448(d), w, true); return (unsigned)w; }
__device__ __forceinline__ unsigned pk4_fp8_nc(float a, float b, float c, float d) {
    int w = 0; w = __builtin_amdgcn_cvt_pk_fp8_f32(a, b, w, false); w = __builtin_amdgcn_cvt_pk_fp8_f32(c, d, w, true); return (unsigned)w; }
struct EpiFp8 {
    static constexpr bool PERM = true;
    static constexpr bool LDSBIAS = true;
    unsigned char* O; int ldc; const float* bias; int bstride; float scale, oscale; LAS float* biasl;
    __device__ __forceinline__ const char* bias_src(const Unit& u, int lane) const { return (const char*)(bias + (size_t)u.e * bstride + u.pn * BM) + (unsigned)(16 * lane); }
    __device__ __forceinline__ void operator()(const f32x4 (&acc)[2][2][4][2], const Unit& u, int wr, int wc, int fr, int fq) const {
        const int row0 = u.pm * BM + wr * 64 + fr; const int col0 = u.pn * BM + wc * 32 + 8 * fq;
        f32x4 bv[2][2];
#pragma unroll
        for (int bj = 0; bj < 2; ++bj)
#pragma unroll
            for (int n = 0; n < 2; ++n) bv[bj][n] = *(const LAS f32x4*)(biasl + wc * 32 + 8 * fq + bj * HALF + 4 * n) * oscale;
        const float so = scale * oscale;
#pragma unroll
        for (int ai = 0; ai < 2; ++ai)
#pragma unroll
            for (int m = 0; m < 4; ++m) { unsigned char* rowp = O + (size_t)(row0 + ai * HALF + m * 16) * ldc + col0;
#pragma unroll
                for (int bj = 0; bj < 2; ++bj) { const f32x4 v0 = acc[ai][bj][m][0] * so + bv[bj][0], v1 = acc[ai][bj][m][1] * so + bv[bj][1];
                    u32x2 w; w.x = pk4_fp8(v0[0], v0[1], v0[2], v0[3]); w.y = pk4_fp8(v1[0], v1[1], v1[2], v1[3]);
                    *(u32x2*)(rowp + bj * HALF) = w; } }
    }
};
struct EpiSwiglu {
    static constexpr bool PERM = true;
    static constexpr bool LDSBIAS = true;
    unsigned char* O; const float* bias; float scale, oscale; LAS float* biasl;
    __device__ __forceinline__ const char* bias_src(const Unit& u, int lane) const { return (const char*)(bias + (size_t)u.e * 2048 + u.pn * HALF) + (unsigned)((lane >> 5) * 4096 + 16 * (lane & 31)); }
    __device__ __forceinline__ void operator()(const f32x4 (&acc)[2][2][4][2], const Unit& u, int wr, int wc, int fr, int fq) const {
        const int row0 = u.pm * BM + wr * 64 + fr; const int ff0 = u.pn * HALF + wc * 32 + 8 * fq;
        f32x4 bg[2], bu[2];
#pragma unroll
        for (int n = 0; n < 2; ++n) { bg[n] = *(const LAS f32x4*)(biasl + wc * 32 + 8 * fq + 4 * n); bu[n] = *(const LAS f32x4*)(biasl + HALF + wc * 32 + 8 * fq + 4 * n); }
        const f32x4 os4 = (f32x4){oscale, oscale, oscale, oscale};
#pragma unroll
        for (int ai = 0; ai < 2; ++ai)
#pragma unroll
            for (int m = 0; m < 4; ++m) { unsigned char* rowp = O + (size_t)(row0 + ai * HALF + m * 16) * DFF + ff0;
                float r[8];
#pragma unroll
                for (int n = 0; n < 2; ++n) {
                    f32x4 g = acc[ai][0][m][n] * scale + bg[n]; f32x4 up = acc[ai][1][m][n] * scale + bu[n];
                    g.x = fminf(g.x, 7.f); g.y = fminf(g.y, 7.f); g.z = fminf(g.z, 7.f); g.w = fminf(g.w, 7.f);
                    up.x = __builtin_amdgcn_fmed3f(up.x, -7.f, 7.f); up.y = __builtin_amdgcn_fmed3f(up.y, -7.f, 7.f); up.z = __builtin_amdgcn_fmed3f(up.z, -7.f, 7.f); up.w = __builtin_amdgcn_fmed3f(up.w, -7.f, 7.f);
                    const f32x4 tz = g * -2.4554669595930157f;
                    f32x4 d; d.x = __builtin_amdgcn_exp2f(tz.x); d.y = __builtin_amdgcn_exp2f(tz.y); d.z = __builtin_amdgcn_exp2f(tz.z); d.w = __builtin_amdgcn_exp2f(tz.w);
                    d = d + 1.0f;
                    f32x4 rc; rc.x = __builtin_amdgcn_rcpf(d.x); rc.y = __builtin_amdgcn_rcpf(d.y); rc.z = __builtin_amdgcn_rcpf(d.z); rc.w = __builtin_amdgcn_rcpf(d.w);
                    const f32x4 o = (up * os4 + os4) * (g * rc);
                    r[4 * n] = o.x; r[4 * n + 1] = o.y; r[4 * n + 2] = o.z; r[4 * n + 3] = o.w; }
                u32x2 w; w.x = pk4_fp8_nc(r[0], r[1], r[2], r[3]); w.y = pk4_fp8_nc(r[4], r[5], r[6], r[7]);
                *(u32x2*)rowp = w; }
    }
};
struct EpiResGate {
    static constexpr bool PERM = false, LDSBIAS = false;
    const float* x; bf16_t* out; const float* mod;
    __device__ __forceinline__ void operator()(const f32x4 (&acc)[2][2][4][2], const Unit& u, int wr, int wc, int fr, int fq) const {
        const int row0 = u.pm * BM + wr * 64 + fr, col0 = u.pn * BM + wc * 32 + 4 * fq;
        const float* g1 = mod + (size_t)((u.pm * BM) >> 13) * 6144 + 2048;
        f32x4 gv[2][2];
#pragma unroll
        for (int bj = 0; bj < 2; ++bj)
#pragma unroll
            for (int n = 0; n < 2; ++n) gv[bj][n] = *(const f32x4*)(g1 + col0 + bj * HALF + n * 16);
#pragma unroll
        for (int ai = 0; ai < 2; ++ai)
#pragma unroll
            for (int m = 0; m < 4; ++m) { const size_t off = (size_t)(row0 + ai * HALF + m * 16) * DM + col0;
#pragma unroll
                for (int bj = 0; bj < 2; ++bj)
#pragma unroll
                    for (int n = 0; n < 2; ++n) { const f32x4 xv = *(const f32x4*)(x + off + bj * HALF + n * 16);
                        const f32x4 o = xv + gv[bj][n] * acc[ai][bj][m][n]; u32x2 w; w.x = cvt_pk_bf16(o[0], o[1]); w.y = cvt_pk_bf16(o[2], o[3]);
                        *(u32x2*)(out + off + bj * HALF + n * 16) = w; } }
    }
};

template <class Epi, class Sched, bool ALIGN_EPI, bool FP8 = false, class Sync = NoSync>
__device__ __forceinline__ void gemm_phase(LAS unsigned char* lds, const bf16_t* Aglob, const Sched& S, const Epi& E, Sync* Y = nullptr) {
    const int tid = threadIdx.x, wid = __builtin_amdgcn_readfirstlane(tid >> 6), lane = tid & 63, wr = wid >> 2, wc = wid & 3, fr = lane & 15, fq = lane >> 4;
    constexpr int nt = FP8 ? KD / (2 * BK) : KD / BK;
    constexpr unsigned ROWB = FP8 ? KD : KD * 2; constexpr int RSH = FP8 ? 10 : 11;
    unsigned voffA[2], voffB[2];
#pragma unroll
    for (int i = 0; i < 2; ++i) { int R, C; stage_rc(tid * 16 + i * 8192, R, C); const int Rb = Epi::PERM ? ((R & ~31) + perm32(R & 31)) : R;
        voffA[i] = (unsigned)R * ROWB + (unsigned)C * 2u; voffB[i] = (unsigned)Rb * ROWB + (unsigned)C * 2u; }
    constexpr size_t kstep = (size_t)(BK * 2);
    constexpr size_t hstep = (size_t)HALF * ROWB;
    constexpr size_t tstep = 2 * hstep;
    const unsigned ldsw = (unsigned)wid * 1024u;
    const int aoff = lds_byte(wr * 64 + fr, fq * 8), boff = lds_byte(wc * 32 + fr, fq * 8);
    const int aoff1 = lds_byte(wr * 64 + fr, 32 + fq * 8), boff1 = lds_byte(wc * 32 + fr, 32 + fq * 8);
    const char* Ab = (const char*)Aglob;
#define PG8_SA(b, h) (((b) * 2 + (h)) * HTB)
#define PG8_SB(b, h) ((4 + (b) * 2 + (h)) * HTB)
#define PG8_STAGE_B(bufoff, gbase) do { _Pragma("unroll") for (int _i = 0; _i < 2; ++_i) \
        __builtin_amdgcn_global_load_lds((const unsigned*)((const char*)(gbase) + voffB[_i]), (LAS unsigned*)(lds + (bufoff) + ldsw + _i * 8192), 16, 0, 0); } while (0)
#define PG8_STAGE_A(bufoff, pa, tk, h, kb) do { _Pragma("unroll") for (int _i = 0; _i < 2; ++_i) { \
        const char* _src = Sched::GATHER ? (Ab + (kb) + (size_t)((((tk)[_i] >> (16 * (h))) & 0xffffu) * ROWB + (voffA[_i] & 127u))) : ((pa) + (size_t)(h) * hstep + (kb) + voffA[_i]); \
        __builtin_amdgcn_global_load_lds((const unsigned*)_src, (LAS unsigned*)(lds + (bufoff) + ldsw + _i * 8192), 16, 0, 0); } } while (0)
#define PG8_LD8(p0, p1) __builtin_shufflevector(*(const LAS i32x4*)(p0), *(const LAS i32x4*)(p1), 0, 1, 2, 3, 4, 5, 6, 7)
#define PG8_LDA(dst, b, h) do { _Pragma("unroll") for (int m = 0; m < 4; ++m) dst[m] = PG8_LD8(lds + PG8_SA(b, h) + aoff + m * 2048, lds + PG8_SA(b, h) + aoff1 + m * 2048); } while (0)
#define PG8_LDB(dst, b, h) do { _Pragma("unroll") for (int n = 0; n < 2; ++n) dst[n] = PG8_LD8(lds + PG8_SB(b, h) + boff + n * 2048, lds + PG8_SB(b, h) + boff1 + n * 2048); } while (0)
#define PG8_LO(x) __builtin_bit_cast(bf16x8, __builtin_shufflevector(x, x, 0, 1, 2, 3))
#define PG8_HI(x) __builtin_bit_cast(bf16x8, __builtin_shufflevector(x, x, 4, 5, 6, 7))
#define PG8_MMA(ai, bj, At, Bt) do { __builtin_amdgcn_s_setprio(1); _Pragma("unroll") for (int m = 0; m < 4; ++m) _Pragma("unroll") for (int n = 0; n < 2; ++n) { \
        if constexpr (FP8) asm volatile("v_mfma_scale_f32_16x16x128_f8f6f4 %0, %1, %2, %0, %3, %3 op_sel_hi:[0,0,0]" : "+v"(acc[ai][bj][m][n]) : "v"(Bt[n]), "v"(At[m]), "v"(sc127)); \
        else { acc[ai][bj][m][n] = __builtin_amdgcn_mfma_f32_16x16x32_bf16(PG8_LO(Bt[n]), PG8_LO(At[m]), acc[ai][bj][m][n], 0, 0, 0); \
               acc[ai][bj][m][n] = __builtin_amdgcn_mfma_f32_16x16x32_bf16(PG8_HI(Bt[n]), PG8_HI(At[m]), acc[ai][bj][m][n], 0, 0, 0); } } \
        __builtin_amdgcn_s_setprio(0); } while (0)
#define PG8_WAIT_V(n) asm volatile("s_waitcnt vmcnt(" #n ")" ::: "memory")
#define PG8_WAIT_L(n) asm volatile("s_waitcnt lgkmcnt(" #n ")" ::: "memory")
#define PG8_BAR __builtin_amdgcn_s_barrier()
#define PG8_SCHED __builtin_amdgcn_sched_barrier(0)
#define PG8_TOKS(dst, u) do { if constexpr (Sched::GATHER) { _Pragma("unroll") for (int _i = 0; _i < 2; ++_i) { const int _R = (int)(voffA[_i] >> RSH); \
        dst[_i] = S.arow(u, _R) | (S.arow(u, HALF + _R) << 16); } } } while (0)
    Unit cur, nxt; int ui = 0;
    if (!S.next(0, cur)) return;
    if constexpr (Sync::WAIT) { if (!Y->done && Y->need(cur)) { if (tid == 0) Y->wait(); __builtin_amdgcn_s_barrier(); Y->done = true; } }
    unsigned sc127 = 0u; if constexpr (FP8) asm volatile("v_mov_b32 %0, 0x7f7f7f7f" : "=v"(sc127));
    f32x4 acc[2][2][4][2];
#pragma unroll
    for (int a = 0; a < 2; ++a)
#pragma unroll
        for (int b = 0; b < 2; ++b)
#pragma unroll
            for (int m = 0; m < 4; ++m)
#pragma unroll
                for (int n = 0; n < 2; ++n) acc[a][b][m][n] = (f32x4){0.f, 0.f, 0.f, 0.f};
    i32x8 At[4], B0[2], B1[2];
    unsigned tokC[2] = {0u, 0u}, tokN[2] = {0u, 0u};
    PG8_TOKS(tokC, cur);
    const char* cA = Ab + (size_t)cur.pm * tstep;
    const char* cB = S.bbase(cur);
    PG8_STAGE_B(PG8_SB(0, 0), cB); PG8_STAGE_B(PG8_SB(0, 1), cB + hstep); PG8_STAGE_A(PG8_SA(0, 0), cA, tokC, 0, 0); PG8_STAGE_A(PG8_SA(0, 1), cA, tokC, 1, 0);
    if (wr == 1) PG8_BAR;
    PG8_WAIT_V(2); PG8_BAR;
    PG8_STAGE_B(PG8_SB(1, 0), cB + kstep); PG8_STAGE_A(PG8_SA(1, 0), cA, tokC, 0, kstep); PG8_STAGE_B(PG8_SB(1, 1), cB + hstep + kstep);
    PG8_WAIT_V(6); PG8_BAR;
    for (;;) {
        const bool has_next = S.next(ui + 1, nxt);
        if constexpr (Sync::WAIT) { if (has_next && !Y->done && Y->need(nxt)) { if (tid == 0) Y->wait(); PG8_BAR; Y->done = true; } }
        const char* nA = has_next ? Ab + (size_t)nxt.pm * tstep : cA; const char* nB = has_next ? S.bbase(nxt) : cB;
#pragma unroll 1
        for (int t = 0; t < nt; t += 2) {
            const bool last = (t == nt - 2);
            if constexpr (Epi::LDSBIAS) { if (last && wid == 0) __builtin_amdgcn_global_load_lds((const unsigned*)E.bias_src(cur, lane), (LAS unsigned*)E.biasl, 16, 0, 0); }
            if (last) { if (has_next) { PG8_TOKS(tokN, nxt); } else { tokN[0] = tokC[0]; tokN[1] = tokC[1]; } }
            const size_t k1 = (size_t)(t + 1) * kstep;
            const size_t k2 = last ? 0 : (size_t)(t + 2) * kstep, k3 = k2 + kstep;
            const char* a2 = last ? nA : cA;
            const char* b2 = last ? nB : cB + (size_t)(t + 2) * kstep; const char* b3 = b2 + kstep;
            PG8_LDB(B0, 0, 0); PG8_LDB(B1, 0, 1); PG8_SCHED; PG8_LDA(At, 0, 0); PG8_STAGE_A(PG8_SA(1, 1), cA, tokC, 1, k1);
            PG8_WAIT_V(8); PG8_WAIT_L(0); PG8_BAR; PG8_MMA(0, 0, At, B0); PG8_MMA(0, 1, At, B1); PG8_BAR; PG8_SCHED;
            if (last) { tokC[0] = tokN[0]; tokC[1] = tokN[1]; }
            PG8_LDA(At, 0, 1); PG8_STAGE_B(PG8_SB(0, 0), b2); PG8_STAGE_B(PG8_SB(0, 1), b2 + hstep); PG8_STAGE_A(PG8_SA(0, 0), a2, tokC, 0, k2);
            PG8_WAIT_V(8); PG8_WAIT_L(0); PG8_BAR; PG8_MMA(1, 0, At, B0); PG8_MMA(1, 1, At, B1); PG8_BAR; PG8_SCHED;
            PG8_LDB(B0, 1, 0); PG8_LDB(B1, 1, 1); PG8_SCHED; PG8_LDA(At, 1, 0); PG8_STAGE_A(PG8_SA(0, 1), a2, tokC, 1, k2);
            PG8_WAIT_V(8); PG8_WAIT_L(0); PG8_BAR; PG8_MMA(0, 0, At, B0); PG8_MMA(0, 1, At, B1); PG8_BAR; PG8_SCHED;
            PG8_LDA(At, 1, 1); PG8_STAGE_B(PG8_SB(1, 0), b3); PG8_STAGE_B(PG8_SB(1, 1), b3 + hstep); PG8_STAGE_A(PG8_SA(1, 0), a2, tokC, 0, k3);
            PG8_WAIT_V(8); PG8_WAIT_L(0); PG8_BAR; PG8_MMA(1, 0, At, B0); PG8_MMA(1, 1, At, B1); PG8_BAR; PG8_SCHED;
        }
        if constexpr (ALIGN_EPI) { if (wr == 0) PG8_BAR; }
        if constexpr (Sync::ARRIVE) { static_assert(ALIGN_EPI, "aligned epilogue"); if (ui == Y->a1) { PG8_WAIT_V(0); PG8_BAR; if (tid == 0) Y->arrive(); Y->done = true; } }
        if constexpr (FP8) asm volatile("s_nop 15\n\ts_nop 15" ::: "memory");
        E(acc, cur, wr, wc, fr, fq);
        if (!has_next) break;
#pragma unroll
        for (int a = 0; a < 2; ++a)
#pragma unroll
            for (int b = 0; b < 2; ++b)
#pragma unroll
                for (int m = 0; m < 4; ++m)
#pragma unroll
                    for (int n = 0; n < 2; ++n) acc[a][b][m][n] = (f32x4){0.f, 0.f, 0.f, 0.f};
        cur = nxt; cA = nA; cB = nB; ++ui;
        if constexpr (ALIGN_EPI) { if (wr == 1) PG8_BAR; }
    }
    PG8_WAIT_V(0);
    if constexpr (!ALIGN_EPI) { if (wr == 0) PG8_BAR; }
    PG8_BAR;
#undef PG8_SA
#undef PG8_SB
#undef PG8_STAGE_A
#undef PG8_STAGE_B
#undef PG8_LDA
#undef PG8_LDB
#undef PG8_MMA
#undef PG8_LD8
#undef PG8_LO
#undef PG8_HI
#undef PG8_WAIT_V
#undef PG8_WAIT_L
#undef PG8_BAR
#undef PG8_SCHED
#undef PG8_TOKS
}
}

#define XB_TMO      128
#define XB_XCNT(j)  (256  + 64 * (j))
#define XB_XSUB(j)  (1280 + 64 * (j))
#define XB_XGEN(j)  (2304 + 64 * (j))
#define XB_TOP      3328
#define XB_TOPGEN   3392
#define XCD_BAR_WORDS 3456
#define XB_SPIN_CAP (1u << 18)

__device__ __forceinline__ unsigned xb_ld(unsigned* p)              { return __hip_atomic_load(p, __ATOMIC_RELAXED, __HIP_MEMORY_SCOPE_AGENT); }
__device__ __forceinline__ unsigned xb_add(unsigned* p, unsigned v) { return __hip_atomic_fetch_add(p, v, __ATOMIC_RELAXED, __HIP_MEMORY_SCOPE_AGENT); }
__device__ __forceinline__ unsigned xb_xcc_id() { return (unsigned)__builtin_amdgcn_s_getreg((3 << 11) | 20) & 0xFu; }
#define XB_SPIN(cond, bar) do { unsigned _sp = 0; while (cond) { __builtin_amdgcn_s_sleep(1); \
    if ((++_sp & 255u) == 0u) { if (xb_ld(&(bar)[XB_TMO])) break; if (_sp > XB_SPIN_CAP) { atomicAdd(&(bar)[XB_TMO], 1u); break; } } } } while (0)

struct XcdBarrier {
    unsigned* bar; unsigned x;
    volatile LAS unsigned* st;
};

__device__ __forceinline__ XcdBarrier xcd_barrier_post(unsigned* bar, volatile LAS unsigned* st) {
    XcdBarrier b; b.bar = bar; b.x = xb_xcc_id(); b.st = st;
    if (threadIdx.x == 0) (void)xb_add(&bar[XB_XCNT(b.x)], 1u);
    return b;
}
__device__ __forceinline__ void xcd_barrier_complete(unsigned* bar, unsigned x, unsigned& nloc, unsigned& nx) {
    const unsigned G = gridDim.x * gridDim.y * gridDim.z;
    unsigned sum, cnt, mine, sp = 0u;
    for (;;) {
        sum = 0u; cnt = 0u; mine = 0u;
#pragma unroll
        for (unsigned j = 0; j < 16; ++j) { const unsigned c = xb_ld(&bar[XB_XCNT(j)]); sum += c; cnt += (c > 0u) ? 1u : 0u; mine = (j == x) ? c : mine; }
        if (sum == G) break;
        __builtin_amdgcn_s_sleep(1);
        if ((++sp & 255u) == 0u) { if (xb_ld(&bar[XB_TMO])) break; if (sp > XB_SPIN_CAP) { atomicAdd(&bar[XB_TMO], 1u); break; } }
    }
    nloc = mine > 0u ? mine : 1u; nx = cnt > 0u ? cnt : 1u;
}

__device__ __forceinline__ void xcd_barrier(const XcdBarrier& b) {
    asm volatile("s_waitcnt vmcnt(0)" ::: "memory");
    __syncthreads();
    if (threadIdx.x == 0) {
        unsigned* bar = b.bar;
        __builtin_amdgcn_s_waitcnt(0);
        unsigned nloc = b.st[0], nx = b.st[1];
        if (nloc == 0u) { xcd_barrier_complete(bar, b.x, nloc, nx); b.st[0] = nloc; b.st[1] = nx; }
        const unsigned old = xb_add(&bar[XB_XSUB(b.x)], 1u);
        const unsigned gen = old / nloc;
        if (old + 1u == (gen + 1u) * nloc) {
            __builtin_amdgcn_fence(__ATOMIC_RELEASE, "agent");
            asm volatile("s_waitcnt vmcnt(0)" ::: "memory");
            const unsigned og = xb_add(&bar[XB_TOP], 1u);
            const unsigned tg = og / nx;
            if (og + 1u == (tg + 1u) * nx) xb_add(&bar[XB_TOPGEN], 1u);
            else XB_SPIN(xb_ld(&bar[XB_TOPGEN]) == tg, bar);
            __builtin_amdgcn_fence(__ATOMIC_ACQUIRE, "agent");
            xb_add(&bar[XB_XGEN(b.x)], 1u);
            asm volatile("s_waitcnt vmcnt(0)" ::: "memory");
        } else {
            XB_SPIN(xb_ld(&bar[XB_XGEN(b.x)]) == gen, bar);
            __builtin_amdgcn_fence(__ATOMIC_ACQUIRE, "agent");
            asm volatile("s_waitcnt vmcnt(0)" ::: "memory");
        }
    }
    __syncthreads();
}

#define SB_XSUB(j)  (64 * (j))
#define SB_TOP      1024
#define SB_FLAG     1088
__device__ __forceinline__ void sb_arrive(const XcdBarrier& b, unsigned* sb) {
    const unsigned nloc = b.st[0], nx = b.st[1];
    const unsigned old = xb_add(&sb[SB_XSUB(b.x)], 1u);
    if (old + 1u == nloc) {
        __builtin_amdgcn_fence(__ATOMIC_RELEASE, "agent");
        asm volatile("s_waitcnt vmcnt(0)" ::: "memory");
        const unsigned og = xb_add(&sb[SB_TOP], 1u);
        if (og + 1u == nx) xb_add(&sb[SB_FLAG], 1u);
    }
}
__device__ __forceinline__ void sb_wait(const XcdBarrier& b, unsigned* sb) {
    XB_SPIN(xb_ld(&sb[SB_FLAG]) == 0u, b.bar);
    __builtin_amdgcn_fence(__ATOMIC_ACQUIRE, "agent");
    asm volatile("s_waitcnt vmcnt(0)" ::: "memory");
}
struct ArriveSync {
    static constexpr bool ARRIVE = true, WAIT = false;
    const XcdBarrier* b; unsigned* sb; int a1; bool done;
    __device__ __forceinline__ void arrive() const { sb_arrive(*b, sb); }
};
template <class Sched> struct WaitSync {
    static constexpr bool ARRIVE = false, WAIT = true;
    const XcdBarrier* b; unsigned* sb; int a1; bool done; const Sched* S; int nNp;
    __device__ __forceinline__ bool need(const pg8::Unit& u) const { return S->last_trip_of(u.pm, nNp) >= a1; }
    __device__ __forceinline__ void wait() const { sb_wait(*b, sb); }
};

struct Ctx {
    LAS unsigned char* lds; int tid, lane, wave, bid, G;
    const float* const* in; float* out; unsigned char* ws;
};
#define GIN(F, i) ((const float*)(const GAS float*)(F).in[i])
#define IN_X 0
#define IN_C 1
#define IN_CTX 2
#define IN_CCTX 3
#define IN_WMOD 4
#define IN_BMOD 5
#define IN_NORM1 6
#define IN_WIN 7
#define IN_GKUP 8
#define IN_GKB 9
#define IN_GLANORM 10
#define IN_CONVW 11
#define IN_CONVB 12
#define IN_DTBIAS 13
#define IN_ALOG 14
#define IN_SSDD 15
#define IN_SSDNORM 16
#define IN_WOUT 17
#define IN_NORM2 18
#define IN_WR 19
#define IN_BR 20
#define IN_WGU 21
#define IN_BGU 22
#define IN_WD 23
#define IN_BD 24
#define IN_FNORM 25

__device__ __forceinline__ int map_in(int n) {
    if (n < 1536) return n;
    if (n < 3072) return n + 16;
    if (n < 3088) return n - 1536;
    if (n < 3096) return n;
    return -1;
}
__device__ __forceinline__ void tr_item(const float* W, int N, int k0, int sc, bf16_t* WT, LAS float* scr, int lane) {
#pragma unroll 8
    for (int i = 0; i < 32; ++i) { const int kk = 2 * i + (lane >> 5); scr[kk * 33 + (lane & 31)] = (sc >= 0) ? W[(size_t)(k0 + kk) * N + sc] : 0.f; }
    LDS_WAIT(); asm volatile("" ::: "memory");
    const int c = lane & 7;
#pragma unroll
    for (int j = 0; j < 4; ++j) { const int n = (lane >> 3) + 8 * j; const LAS float* s = scr + (8 * c) * 33 + n;
        u32x4 o; o.x = pk2(s[0 * 33], s[1 * 33]); o.y = pk2(s[2 * 33], s[3 * 33]); o.z = pk2(s[4 * 33], s[5 * 33]); o.w = pk2(s[6 * 33], s[7 * 33]);
        *(u32x4*)(WT + (size_t)n * 1024 + k0 + 8 * c) = o; }
    LDS_WAIT(); asm volatile("" ::: "memory");
}

__device__ __forceinline__ void tr_item8(const float* W, int N, int k0, int sc, unsigned char* WT8, float wscale, LAS float* scr, int lane) {
#pragma unroll 16
    for (int i = 0; i < 64; ++i) { const int kk = 2 * i + (lane >> 5); scr[kk * 33 + (lane & 31)] = W[(size_t)(k0 + kk) * N + sc] * wscale; }
    LDS_WAIT(); asm volatile("" ::: "memory");
    const int c = lane & 7;
#pragma unroll
    for (int j = 0; j < 4; ++j) { const int n = (lane >> 3) + 8 * j; const LAS float* p = scr + (16 * c) * 33 + n;
        u32x4 o; o.x = pg8::pk4_fp8(p[0 * 33], p[1 * 33], p[2 * 33], p[3 * 33]); o.y = pg8::pk4_fp8(p[4 * 33], p[5 * 33], p[6 * 33], p[7 * 33]);
        o.z = pg8::pk4_fp8(p[8 * 33], p[9 * 33], p[10 * 33], p[11 * 33]); o.w = pg8::pk4_fp8(p[12 * 33], p[13 * 33], p[14 * 33], p[15 * 33]);
        *(u32x4*)(WT8 + (size_t)n * 1024 + k0 + 16 * c) = o; }
    LDS_WAIT(); asm volatile("" ::: "memory");
}
constexpr float WSCALE8 = 1024.f, HSCALE8 = 16.f, ASCALE8 = 4.f, PSCALE8 = 32.f;

__device__ __forceinline__ void tr8_load(f32x4 (&v)[16], const float* W, int N, int k0, int n0, int lane) {
    const float* p = W + (size_t)(k0 + (lane >> 3)) * N + n0 + 4 * (lane & 7);
#pragma unroll
    for (int i = 0; i < 16; ++i) v[i] = *(const f32x4*)(p + (size_t)(8 * i) * N);
}
__device__ __forceinline__ void tr8_store(const f32x4 (&v)[16], unsigned char* WT8, int k0, float wscale, LAS float* scr, int lane) {
    LAS float* s = scr + (lane >> 3) * 33 + 4 * (lane & 7);
#pragma unroll
    for (int i = 0; i < 16; ++i) { const f32x4 w = v[i] * wscale; s[(8 * i) * 33 + 0] = w.x; s[(8 * i) * 33 + 1] = w.y; s[(8 * i) * 33 + 2] = w.z; s[(8 * i) * 33 + 3] = w.w; }
    LDS_WAIT(); asm volatile("" ::: "memory");
    const int c = lane & 7;
#pragma unroll
    for (int j = 0; j < 4; ++j) { const int n = (lane >> 3) + 8 * j; const LAS float* p = scr + (16 * c) * 33 + n;
        u32x4 o; o.x = pg8::pk4_fp8(p[0 * 33], p[1 * 33], p[2 * 33], p[3 * 33]); o.y = pg8::pk4_fp8(p[4 * 33], p[5 * 33], p[6 * 33], p[7 * 33]);
        o.z = pg8::pk4_fp8(p[8 * 33], p[9 * 33], p[10 * 33], p[11 * 33]); o.w = pg8::pk4_fp8(p[12 * 33], p[13 * 33], p[14 * 33], p[15 * 33]);
        *(u32x4*)(WT8 + (size_t)n * 1024 + k0 + 16 * c) = o; }
    LDS_WAIT(); asm volatile("" ::: "memory");
}
struct Tr8Item { const float* W; int N, k0, n0; unsigned char* dst; };
__device__ __forceinline__ Tr8Item tr8_decode(const Ctx& F, int r) {
    constexpr int I_GU = NEXP * 8 * 64;
    Tr8Item t;
    if (r < I_GU) { const int e = r / (8 * 64), q = r % (8 * 64), nb = q % 64, kb = q / 64; const int n0 = nb * 32, tile = n0 >> 8, w = n0 & 255;
        t.W = GIN(F, IN_WGU) + (size_t)e * 1024 * 2048; t.N = 2048; t.k0 = kb * 128; t.n0 = (w < 128) ? tile * 128 + w : 1024 + tile * 128 + (w - 128);
        t.dst = (unsigned char*)(F.ws + WS_WGU) + ((size_t)e * 2048 + n0) * 1024; }
    else { r -= I_GU; const int e = r / (8 * 32), q = r % (8 * 32), nb = q % 32, kb = q / 32;
        t.W = GIN(F, IN_WD) + (size_t)e * 1024 * 1024; t.N = 1024; t.k0 = kb * 128; t.n0 = nb * 32;
        t.dst = (unsigned char*)(F.ws + WS_WD) + ((size_t)e * 1024 + nb * 32) * 1024; }
    return t;
}
__device__ __forceinline__ void expert_weight_copies(Ctx& F, int c_hi, int n_lo, int n_hi) {
    LAS float* scr = (LAS float*)(F.lds + F.wave * 16896);
    constexpr int NI = NEXP * 8 * 64 + NEXP * 8 * 32;
    const int s0 = F.bid < c_hi ? F.bid * n_lo : c_hi * n_lo + (F.bid - c_hi) * n_hi, ns = F.bid < c_hi ? n_lo : n_hi;
    int lane = F.lane; asm volatile("" : "+v"(lane));
    f32x4 va[16], vb[16];
    int it = s0 * 8 + F.wave; const int hi = (s0 + ns) * 8 < NI ? (s0 + ns) * 8 : NI;
    if (it < hi) { const Tr8Item t = tr8_decode(F, it); tr8_load(va, t.W, t.N, t.k0, t.n0, lane); }
    while (it < hi) {
        const int it2 = it + 8, it3 = it2 + 8;
        if (it2 < hi) { const Tr8Item t = tr8_decode(F, it2); tr8_load(vb, t.W, t.N, t.k0, t.n0, lane); }
        { const Tr8Item t = tr8_decode(F, it); tr8_store(va, t.dst, t.k0, WSCALE8, scr, lane); }
        if (it3 < hi) { const Tr8Item t = tr8_decode(F, it3); tr8_load(va, t.W, t.N, t.k0, t.n0, lane); }
        if (it2 < hi) { const Tr8Item t = tr8_decode(F, it2); tr8_store(vb, t.dst, t.k0, WSCALE8, scr, lane); }
        it = it3;
    }
}
__device__ __forceinline__ void prologue_items(Ctx& F, int part) {
    LAS float* scr = (LAS float*)(F.lds + F.wave * 16896);
    const int gw = F.bid * 8 + F.wave, NGW = F.G * 8;
    constexpr int I_IN = 16 * (NP / 32), I_OUT = 16 * 32, I_GU = NEXP * 8 * 64, I_D = NEXP * 8 * 32;
    bf16_t* WinT = (bf16_t*)(F.ws + WS_WIN); bf16_t* WoutT = (bf16_t*)(F.ws + WS_WOUT); unsigned char* WguT = (unsigned char*)(F.ws + WS_WGU); unsigned char* WdT = (unsigned char*)(F.ws + WS_WD);
    const int lo = part ? I_IN + I_OUT : 0, hi = part ? I_IN + I_OUT + I_GU + I_D : I_IN + I_OUT;
    for (int it = lo + gw; it < hi; it += NGW) {
        int r = it; const int l31 = F.lane & 31;
        if (r < I_IN) { const int nb = r % (NP / 32), kb = r / (NP / 32); tr_item(GIN(F, IN_WIN), 3096, kb * 64, map_in(nb * 32 + l31), WinT + (size_t)nb * 32 * 1024, scr, F.lane); continue; } r -= I_IN;
        if (r < I_OUT) { const int nb = r % 32, kb = r / 32; tr_item(GIN(F, IN_WOUT), 1024, kb * 64, nb * 32 + l31, WoutT + (size_t)nb * 32 * 1024, scr, F.lane); continue; } r -= I_OUT;
        if (r < I_GU) { const int e = r / (8 * 64), q = r % (8 * 64), nb = q % 64, kb = q / 64; const int n0 = nb * 32, tile = n0 >> 8, w = n0 & 255;
            const int sc0 = (w < 128) ? tile * 128 + w : 1024 + tile * 128 + (w - 128);
            tr_item8(GIN(F, IN_WGU) + (size_t)e * 1024 * 2048, 2048, kb * 128, sc0 + l31, WguT + ((size_t)e * 2048 + n0) * 1024, WSCALE8, scr, F.lane); continue; } r -= I_GU;
        { const int e = r / (8 * 32), q = r % (8 * 32), nb = q % 32, kb = q / 32;
            tr_item8(GIN(F, IN_WD) + (size_t)e * 1024 * 1024, 1024, kb * 128, nb * 32 + l31, WdT + ((size_t)e * 1024 + nb * 32) * 1024, WSCALE8, scr, F.lane); }
    }
}
__device__ __forceinline__ void ph_prologue(Ctx& F) {
    float* mod = (float*)(F.ws + WS_MOD);
    for (int item = F.bid; item < 192; item += F.G) {
        LAS float* sc = (LAS float*)F.lds;
        for (int i = F.tid; i < 5 * 1024; i += 512) { const int j = i >> 10, k = i & 1023; const float v = (j < 4) ? GIN(F, IN_C)[j * 1024 + k] : GIN(F, IN_CCTX)[k]; sc[i] = silu_f(v); }
        __syncthreads();
        const int nn = F.tid & 31, kq = F.tid >> 5, n = item * 32 + nn;
        float a0 = 0.f, a1 = 0.f, a2 = 0.f, a3 = 0.f, a4 = 0.f;
        const float* wm = GIN(F, IN_WMOD);
#pragma unroll 8
        for (int i = 0; i < 64; ++i) { const int k = kq + 16 * i; const float w = wm[(size_t)k * 6144 + n];
            a0 += sc[k] * w; a1 += sc[1024 + k] * w; a2 += sc[2048 + k] * w; a3 += sc[3072 + k] * w; a4 += sc[4096 + k] * w; }
        LAS float* red = (LAS float*)(F.lds + 20480);
        red[(kq * 5 + 0) * 32 + nn] = a0; red[(kq * 5 + 1) * 32 + nn] = a1; red[(kq * 5 + 2) * 32 + nn] = a2; red[(kq * 5 + 3) * 32 + nn] = a3; red[(kq * 5 + 4) * 32 + nn] = a4;
        __syncthreads();
        if (F.tid < 160) { const int j = F.tid >> 5; float s = GIN(F, IN_BMOD)[n];
            for (int q = 0; q < 16; ++q) s += red[(q * 5 + j) * 32 + nn];
            mod[j * 6144 + n] = s; }
        __syncthreads();
    }
    prologue_items(F, 0);
}
__device__ __forceinline__ void ph_norm1(Ctx& F) {
    const float* mod = (const float*)(F.ws + WS_MOD); bf16_t* H = (bf16_t*)(F.ws + WS_H);
    const int gw = F.bid * 8 + F.wave, NGW = F.G * 8;
    f32x4 nw[4];
#pragma unroll
    for (int q = 0; q < 4; ++q) nw[q] = *(const f32x4*)(GIN(F, IN_NORM1) + 4 * (F.lane + 64 * q));
    constexpr int U = 2;
    for (int r0 = gw * U; r0 < TT; r0 += NGW * U) {
        f32x4 v[U][4];
#pragma unroll
        for (int u = 0; u < U; ++u) { const int r = r0 + u;
            const float* src = (r < TL) ? GIN(F, IN_X) + (size_t)r * DM : GIN(F, IN_CTX) + (size_t)(r - TL) * DM;
#pragma unroll
            for (int q = 0; q < 4; ++q) v[u][q] = ((const f32x4*)src)[F.lane + 64 * q]; }
#pragma unroll
        for (int u = 0; u < U; ++u) { const int r = r0 + u; const int j = (r < TL) ? (r >> 13) : 4;
            const float* sh = mod + j * 6144; const float* scl = sh + 1024;
            float ss = 0.f;
#pragma unroll
            for (int q = 0; q < 4; ++q) ss += (v[u][q].x * v[u][q].x + v[u][q].y * v[u][q].y) + (v[u][q].z * v[u][q].z + v[u][q].w * v[u][q].w);
            const float rstd = rsqrtf(wave_sum(ss) * (1.f / DM) + EPS);
#pragma unroll
            for (int q = 0; q < 4; ++q) { const int idx = 4 * (F.lane + 64 * q);
                const f32x4 s1 = *(const f32x4*)(scl + idx), h1 = *(const f32x4*)(sh + idx);
                const f32x4 o = (v[u][q] * rstd * nw[q]) * (s1 + 1.0f) + h1;
                u32x2 pk; pk.x = pk2(o.x, o.y); pk.y = pk2(o.z, o.w);
                *(u32x2*)(H + (size_t)r * DM + idx) = pk; } }
    }
}

__device__ __forceinline__ void ph_conv_g(Ctx& F) {
    const char* P = (const char*)(F.ws + WS_P); bf16_t* XBC = (bf16_t*)(F.ws + WS_XBC);
    const int ch = (F.tid & 127) * 8, qd = F.tid >> 7;
    f32x2 wgt[9][4];
#pragma unroll
    for (int t = 0; t < 9; ++t) { const f32x4 a = *(const f32x4*)(GIN(F, IN_CONVW) + t * 1024 + ch), b4 = *(const f32x4*)(GIN(F, IN_CONVW) + t * 1024 + ch + 4);
        wgt[t][0] = (f32x2){a.x, a.y}; wgt[t][1] = (f32x2){a.z, a.w}; wgt[t][2] = (f32x2){b4.x, b4.y}; wgt[t][3] = (f32x2){b4.z, b4.w}; }
    f32x2 cb[4]; { const f32x4 a = *(const f32x4*)(GIN(F, IN_CONVB) + ch), b4 = *(const f32x4*)(GIN(F, IN_CONVB) + ch + 4); cb[0] = (f32x2){a.x, a.y}; cb[1] = (f32x2){a.z, a.w}; cb[2] = (f32x2){b4.x, b4.y}; cb[3] = (f32x2){b4.z, b4.w}; }
    for (int item = F.bid; item < 2048 + 64; item += F.G) {
        const bool lat = item < 2048;
        int rowbase, x0, W, y = 0, H = 1;
        if (lat) { const int b = item >> 9, yy = (item >> 2) & 127, qg = item & 3; y = yy; H = 128; W = 64; rowbase = b * SEQ + yy * 64; x0 = (qg * 4 + qd) * 4; }
        else { const int q = item - 2048, b = q >> 4, qg = q & 15; W = CTXL; rowbase = TL + b * CTXL; x0 = (qg * 4 + qd) * 4; }
        f32x2 acc[4][4];
#pragma unroll
        for (int p = 0; p < 4; ++p)
#pragma unroll
            for (int i = 0; i < 4; ++i) acc[p][i] = cb[i];
        u32x4 v[3][6];
#pragma unroll
        for (int dy = 0; dy < 3; ++dy) { const int yy = y + dy - 1; const bool rowok = lat ? (yy >= 0 && yy < H) : (dy == 1);
#pragma unroll
            for (int dx = 0; dx < 6; ++dx) { const int xx = x0 + dx - 1; v[dy][dx] = (u32x4){0u, 0u, 0u, 0u};
                if (rowok && xx >= 0 && xx < W) v[dy][dx] = *(const u32x4*)(P + (unsigned)((rowbase + (dy - 1) * 64 + xx) * NP + CX + ch) * 2u); } }
#pragma unroll
        for (int dy = 0; dy < 3; ++dy)
#pragma unroll
            for (int dx = 0; dx < 6; ++dx) { const u32x4 u = v[dy][dx]; f32x2 f[4];
                f[0] = (f32x2){bflo(u.x), bfhi(u.x)}; f[1] = (f32x2){bflo(u.y), bfhi(u.y)}; f[2] = (f32x2){bflo(u.z), bfhi(u.z)}; f[3] = (f32x2){bflo(u.w), bfhi(u.w)};
#pragma unroll
                for (int p = 0; p < 4; ++p) { const int kx = dx - p;
                    if (kx >= 0 && kx < 3) {
#pragma unroll
                        for (int i = 0; i < 4; ++i) acc[p][i] = __builtin_elementwise_fma(f[i], wgt[dy * 3 + kx][i], acc[p][i]); } } }
#pragma unroll
        for (int p = 0; p < 4; ++p) { u32x4 o; o.x = pk2(silu_f(acc[p][0].x), silu_f(acc[p][0].y)); o.y = pk2(silu_f(acc[p][1].x), silu_f(acc[p][1].y)); o.z = pk2(silu_f(acc[p][2].x), silu_f(acc[p][2].y)); o.w = pk2(silu_f(acc[p][3].x), silu_f(acc[p][3].y));
            *(u32x4*)(XBC + (size_t)(rowbase + x0 + p) * 1024 + ch) = o; }
    }
}

__device__ __forceinline__ int scan_row(int b, int dir, int s) {
    if (s < CTXL) { const int t = dir ? (CTXL - 1 - s) : s; return TL + b * CTXL + t; }
    const int s2 = s - CTXL; const int t = dir ? (SEQ - 1 - s2) : s2; return b * SEQ + t;
}

__device__ __forceinline__ void ph_scan_naive(Ctx& F) {
    const bf16_t* P = (const bf16_t*)(F.ws + WS_P); const bf16_t* XBC = (const bf16_t*)(F.ws + WS_XBC); const float* Gb = (const float*)(F.ws + WS_G);
    bf16_t* OG = (bf16_t*)(F.ws + WS_OG); bf16_t* OS = (bf16_t*)(F.ws + WS_OS);
    constexpr int NSTEP = CTXL + SEQ, BT = 16;
    for (int item = F.bid; item < 96; item += F.G) {
        if (item < 32) {
            const int b = item >> 3, h = (item >> 1) & 3, dir = item & 1;
            LAS float* qs = (LAS float*)F.lds; LAS float* ks = qs + BT * 64; LAS float* as = ks + BT * 64; LAS float* vs = as + BT * 64;
            const int v = F.tid >> 2, d0 = (F.tid & 3) * 16;
            float S[16];
#pragma unroll
            for (int d = 0; d < 16; ++d) S[d] = 0.f;
#pragma unroll 1
            for (int s0 = 0; s0 < NSTEP; s0 += BT) {
                __syncthreads();
#pragma unroll 1
                for (int i = F.tid; i < BT * 64; i += 512) { const int tk = i >> 6, d = i & 63; const int row = scan_row(b, dir, s0 + tk);
                    qs[i] = bf2f(P[(size_t)row * NP + CQ + h * 64 + d]) * 0.125f; ks[i] = bf2f(P[(size_t)row * NP + CK + h * 64 + d]);
                    as[i] = __expf(Gb[((size_t)dir * TT + row) * 256 + h * 64 + d]); }
#pragma unroll 1
                for (int i = F.tid; i < BT * 128; i += 512) { const int tk = i >> 7, vv = i & 127; const int row = scan_row(b, dir, s0 + tk); vs[i] = bf2f(P[(size_t)row * NP + CV + h * 128 + vv]); }
                __syncthreads();
#pragma unroll 1
                for (int tk = 0; tk < BT; ++tk) { const float vt = vs[tk * 128 + v]; float o = 0.f;
#pragma unroll
                    for (int d = 0; d < 16; ++d) { S[d] = as[tk * 64 + d0 + d] * S[d] + ks[tk * 64 + d0 + d] * vt; o += qs[tk * 64 + d0 + d] * S[d]; }
                    o += __shfl_xor(o, 1); o += __shfl_xor(o, 2);
                    const int row = scan_row(b, dir, s0 + tk);
                    if (row < TL && (F.tid & 3) == 0) OG[((size_t)dir * TL + row) * 512 + h * 128 + v] = (bf16_t)f2bf(o); }
            }
        } else {
            const int it = item - 32, b = it >> 4, hh = (it >> 1) & 7, dir = it & 1, g = hh >> 2;
            LAS float* Bs = (LAS float*)F.lds; LAS float* Cs = Bs + BT * 128; LAS float* xs = Cs + BT * 128; LAS float* dts = xs + BT * 64; LAS float* das = dts + BT;
            const int pp = F.tid >> 3, sb = (F.tid & 7) * 16;
            const float Ah = -__expf(GIN(F, IN_ALOG)[dir * 8 + hh]), dtb = GIN(F, IN_DTBIAS)[dir * 8 + hh];
            float S[16];
#pragma unroll
            for (int s = 0; s < 16; ++s) S[s] = 0.f;
#pragma unroll 1
            for (int s0 = 0; s0 < NSTEP; s0 += BT) {
                __syncthreads();
#pragma unroll 1
                for (int i = F.tid; i < BT * 128; i += 512) { const int tk = i >> 7, ss = i & 127; const int row = scan_row(b, dir, s0 + tk);
                    Bs[i] = bf2f(XBC[(size_t)row * 1024 + 512 + g * 128 + ss]); Cs[i] = bf2f(XBC[(size_t)row * 1024 + 768 + g * 128 + ss]); }
#pragma unroll 1
                for (int i = F.tid; i < BT * 64; i += 512) { const int tk = i >> 6, c = i & 63; const int row = scan_row(b, dir, s0 + tk); xs[i] = bf2f(XBC[(size_t)row * 1024 + hh * 64 + c]); }
                if (F.tid < BT) { const int row = scan_row(b, dir, s0 + F.tid);
                    const float dt = softplus_f(bf2f(P[(size_t)row * NP + CDT + hh]) + dtb);
                    dts[F.tid] = dt; das[F.tid] = __expf(dt * Ah); }
                __syncthreads();
#pragma unroll 1
                for (int tk = 0; tk < BT; ++tk) { const float dt = dts[tk], dA = das[tk]; const float xdt = xs[tk * 64 + pp] * dt; float y = 0.f;
#pragma unroll
                    for (int s = 0; s < 16; ++s) { S[s] = dA * S[s] + xdt * Bs[tk * 128 + sb + s]; y += Cs[tk * 128 + sb + s] * S[s]; }
                    y += __shfl_xor(y, 1); y += __shfl_xor(y, 2); y += __shfl_xor(y, 4);
                    const int row = scan_row(b, dir, s0 + tk);
                    if (row < TL && (F.tid & 7) == 0) OS[((size_t)dir * TL + row) * 512 + hh * 64 + pp] = (bf16_t)f2bf(y); }
            }
        }
        __syncthreads();
    }
}


typedef short s16x4 __attribute__((ext_vector_type(4)));
__device__ __forceinline__ f32x4 mfma16(bf16x8 a, bf16x8 b, f32x4 c) { return __builtin_amdgcn_mfma_f32_16x16x32_bf16(a, b, c, 0, 0, 0); }
__device__ __forceinline__ bf16x8 ldfrag(const LAS bf16_t* p) { return *(const LAS bf16x8*)p; }
__device__ __forceinline__ bf16x8 ldfrag_perm(const LAS bf16_t* p) { const s16x4 lo = *(const LAS s16x4*)p, hi = *(const LAS s16x4*)(p + 16); return (bf16x8){lo[0], lo[1], lo[2], lo[3], hi[0], hi[1], hi[2], hi[3]}; }
__device__ __forceinline__ bf16x8 ldfrag_tr(const LAS bf16_t* p, int pitch) {
    const s16x4 lo = __builtin_bit_cast(s16x4, __builtin_amdgcn_ds_read_tr16_b64_v4i16((LAS s16x4*)p));
    const s16x4 hi = __builtin_bit_cast(s16x4, __builtin_amdgcn_ds_read_tr16_b64_v4i16((LAS s16x4*)(p + 4 * pitch)));
    return (bf16x8){lo[0], lo[1], lo[2], lo[3], hi[0], hi[1], hi[2], hi[3]};
}
__device__ __forceinline__ bf16x8 acc2frag(f32x4 t0, f32x4 t1) {
    u32x4 w; w.x = pk2(t0[0], t0[1]); w.y = pk2(t0[2], t0[3]); w.z = pk2(t1[0], t1[1]); w.w = pk2(t1[2], t1[3]);
    return __builtin_bit_cast(bf16x8, w);
}
__device__ __forceinline__ int chunk_rlo(int b, int dir, int seg, int c) {
    if (seg == 0) { const int s0 = 64 * c; return TL + b * CTXL + (dir ? (CTXL - 64 - s0) : s0); }
    const int s2 = 512 * (seg - 1) + 64 * c; return b * SEQ + (dir ? (SEQ - 64 - s2) : s2);
}
constexpr int GP = 72, VP = 136, XP = 264;
constexpr int GL_QT = 0, GL_KT = 9216, GL_KHT = 18432, GL_VN = 27648, GL_PM = 45056, GL_TT = 54272, GL_AD = 56320, GL_GL = 56576, GL_OT = 91392;
constexpr int GLP = 68;
constexpr int SL_CM = 0, SL_BM = 17408, SL_XM = 34816, SL_MM = 68608, SL_AC = 105472, SL_DT = 106496, SL_W = 107520, SL_E = 108544, SL_DA = 109568, SL_YT = 109584;

struct GlaRegs { unsigned q[8], k[8]; u32x4 v[2]; };
__device__ __forceinline__ float logsigmoid2_16(float v) {
    const float t = v * 1.4426950408889634f; return (fminf(t, 0.f) - __builtin_amdgcn_logf(1.f + __builtin_amdgcn_exp2f(-fabsf(t)))) * (1.f / 16.f); }
template <bool OUT> __device__ __forceinline__ void gla_load(GlaRegs& R, const Ctx& F, int rlo, int dir, int h) {
    const char* P = (const char*)(F.ws + WS_P);
#pragma unroll
    for (int u = 0; u < 2; ++u) { const int idx = F.tid + 512 * u, j = idx >> 4, ch = idx & 15, row = dir ? rlo + 63 - j : rlo + j;
        R.v[u] = *(const u32x4*)(P + (unsigned)(row * NP + CV + h * 128 + ch * 8) * 2u); }
#pragma unroll
    for (int k = 0; k < 8; ++k) { const int j = 8 * F.wave + k, row = dir ? rlo + 63 - j : rlo + j;
        if (OUT) R.q[k] = *(const unsigned short*)(P + (unsigned)(row * NP + CQ + h * 64 + F.lane) * 2u);
        R.k[k] = *(const unsigned short*)(P + (unsigned)(row * NP + CK + h * 64 + F.lane) * 2u); }
}
__device__ __forceinline__ u32x4 gla_load_gk(const Ctx& F, int rlo, int dir) {
    const int j = F.tid >> 1, row = dir ? rlo + 63 - j : rlo + j;
    return *(const u32x4*)((const char*)(F.ws + WS_P) + (unsigned)(row * NP + CGK + (F.tid & 1) * 8) * 2u);
}
__device__ __forceinline__ void gla_store_gk(LAS float* GK, const Ctx& F, u32x4 v) {
    LAS float* o = GK + (F.tid >> 1) * 16 + (F.tid & 1) * 8;
    *(LAS f32x4*)o = (f32x4){bflo(v.x), bfhi(v.x), bflo(v.y), bfhi(v.y)}; *(LAS f32x4*)(o + 4) = (f32x4){bflo(v.z), bfhi(v.z), bflo(v.w), bfhi(v.w)};
}
template <bool OUT> __device__ __forceinline__ void gla_item(const Ctx& F, int seq, int seg) {
    const int b = seq >> 3, h = (seq >> 1) & 3, dir = seq & 1;
    const int l = F.lane, g4 = l >> 4, l15 = l & 15, w = F.wave;
    LAS bf16_t* QT = (LAS bf16_t*)(F.lds + GL_QT); LAS bf16_t* KT = (LAS bf16_t*)(F.lds + GL_KT); LAS bf16_t* KHT = (LAS bf16_t*)(F.lds + GL_KHT);
    LAS bf16_t* VN = (LAS bf16_t*)(F.lds + GL_VN); LAS bf16_t* PM = (LAS bf16_t*)(F.lds + GL_PM); LAS float* TTl = (LAS float*)(F.lds + GL_TT); LAS float* AD = (LAS float*)(F.lds + GL_AD);
    bf16_t* OG = (bf16_t*)(F.ws + WS_OG); LAS bf16_t* OT = (LAS bf16_t*)(F.lds + GL_OT);
#define GLA_FLUSH(rl) do { _Pragma("unroll") for (int u = 0; u < 2; ++u) { const int idx = F.tid + 512 * u, i = idx >> 4, ch = idx & 15, row = dir ? (rl) + 63 - i : (rl) + i; \
        *(u32x4*)((char*)OG + (unsigned)((dir * TL + row) * 512 + h * 128 + ch * 8) * 2u) = *(const LAS u32x4*)(OT + i * VP + ch * 8); } } while (0)
    f32x4 S[4];
    if (OUT) { const bf16_t* src = (const bf16_t*)(F.ws + WS_SSG) + ((size_t)seq * 16 + (seg - 1)) * 8192 + w * 1024 + l * 16;
#pragma unroll
        for (int dt = 0; dt < 4; ++dt) S[dt] = ld_bf4(src + dt * 4); }
    else {
#pragma unroll
        for (int dt = 0; dt < 4; ++dt) S[dt] = (f32x4){0.f, 0.f, 0.f, 0.f}; }
    float segsum = 0.f;
    const int nch = (seg == 0) ? 4 : 8;
    LAS float* GLb = (LAS float*)(F.lds + GL_GL);
    bf16x8 Aw; f32x4 gb4;
    { const int dcol = h * 64 + 16 * (w & 3) + l15, kb = 8 * (g4 & 1); float wv[8];
#pragma unroll
      for (int t = 0; t < 8; ++t) { const float x = GIN(F, IN_GKUP)[(dir * 16 + kb + t) * 256 + dcol]; const float hi = __builtin_bit_cast(float, pk2(x, 0.f) << 16); wv[t] = (g4 >= 2) ? (x - hi) : x; }
      u32x4 pw; pw.x = pk2(wv[0], wv[1]); pw.y = pk2(wv[2], wv[3]); pw.z = pk2(wv[4], wv[5]); pw.w = pk2(wv[6], wv[7]); Aw = __builtin_bit_cast(bf16x8, pw);
      gb4 = *(const f32x4*)(GIN(F, IN_GKB) + dir * 256 + h * 64 + 16 * (w & 3) + 4 * g4); }
#define GLA_GKLOAD(dst, cc) do { const int _rl = chunk_rlo(b, dir, seg, (cc)); _Pragma("unroll") for (int jj = 0; jj < 2; ++jj) { const int j = 16 * (2 * (w >> 2) + jj) + l15, row = dir ? _rl + 63 - j : _rl + j; \
        dst[jj] = *(const u32x4*)((const char*)(F.ws + WS_P) + (unsigned)(row * NP + CGK + 8 * (g4 & 1)) * 2u); } } while (0)
#define GLA_GCOMP(src, cc) do { _Pragma("unroll") for (int jj = 0; jj < 2; ++jj) { const f32x4 ga = mfma16(Aw, __builtin_bit_cast(bf16x8, src[jj]), (f32x4){0.f, 0.f, 0.f, 0.f}); \
        f32x4 gv; gv.x = logsigmoid2_16(ga.x + gb4.x); gv.y = logsigmoid2_16(ga.y + gb4.y); gv.z = logsigmoid2_16(ga.z + gb4.z); gv.w = logsigmoid2_16(ga.w + gb4.w); \
        *(LAS f32x4*)(GLb + ((cc) & 1) * (64 * GLP) + (16 * (2 * (w >> 2) + jj) + l15) * GLP + 16 * (w & 3) + 4 * g4) = gv; } } while (0)
    u32x4 gkf[2];
    GLA_GKLOAD(gkf, 0); GLA_GCOMP(gkf, 0); GLA_GKLOAD(gkf, 1);
    GlaRegs R; gla_load<OUT>(R, F, chunk_rlo(b, dir, seg, 0), dir, h);
    LBAR();
#pragma unroll 1
    for (int c = 0; c < nch; ++c) {
        const int rlo = chunk_rlo(b, dir, seg, c);
        if (OUT && c > 0) GLA_FLUSH(chunk_rlo(b, dir, seg, c - 1));
        float cs[8]; { float run = 0.f; const LAS float* gl = GLb + (c & 1) * (64 * GLP) + (8 * w) * GLP + l;
#pragma unroll
            for (int k = 0; k < 8; ++k) { run += gl[k * GLP]; cs[k] = run; }
            TTl[w * 64 + l] = run; }
        LBAR();
        float base = 0.f, tot = 0.f;
#pragma unroll
        for (int q = 0; q < 8; ++q) { const float t = TTl[q * 64 + l]; tot += t; base += (q < w) ? t : 0.f; }
        const float etot = __builtin_amdgcn_exp2f(tot);
        { float kh[8];
#pragma unroll
          for (int k2 = 0; k2 < 8; k2 += 2) { float qv[2], kv[2];
#pragma unroll
              for (int u = 0; u < 2; ++u) { const int k = k2 + u; const float bj = base + cs[k]; const float kf = __builtin_bit_cast(float, R.k[k] << 16);
                  const float ek = __builtin_amdgcn_exp2f(-bj);
                  if (OUT) { qv[u] = __builtin_bit_cast(float, R.q[k] << 16) * 0.125f * __builtin_amdgcn_exp2f(bj); kv[u] = kf * ek; }
                  kh[k] = kf * (etot * ek); }
              if (OUT) { const int j = 8 * w + k2; const unsigned qw = pk2(qv[0], qv[1]), kw = pk2(kv[0], kv[1]);
                  QT[j * GP + l] = (bf16_t)(qw & 0xffffu); QT[(j + 1) * GP + l] = (bf16_t)(qw >> 16); KT[j * GP + l] = (bf16_t)(kw & 0xffffu); KT[(j + 1) * GP + l] = (bf16_t)(kw >> 16); } }
          u32x4 pk; pk.x = pk2(kh[0], kh[1]); pk.y = pk2(kh[2], kh[3]); pk.z = pk2(kh[4], kh[5]); pk.w = pk2(kh[6], kh[7]);
          *(LAS u32x4*)(KHT + l * GP + 8 * w) = pk; }
        if (w == 0) { AD[l] = etot; segsum += tot; }
#pragma unroll
        for (int u = 0; u < 2; ++u) { const int idx = F.tid + 512 * u, j = idx >> 4, ch = idx & 15; *(LAS u32x4*)(VN + j * VP + ch * 8) = R.v[u]; }
        LBAR();
        if (c + 1 < nch) gla_load<OUT>(R, F, chunk_rlo(b, dir, seg, c + 1), dir, h);
        if (c + 1 < nch) { GLA_GCOMP(gkf, c + 1); if (c + 2 < nch) GLA_GKLOAD(gkf, c + 2); }
        if (OUT) {
            const int jt = w & 3;
#pragma unroll
            for (int ii = 0; ii < 2; ++ii) { const int it = 2 * (w >> 2) + ii; f32x4 acc = (f32x4){0.f, 0.f, 0.f, 0.f};
                if (jt <= it) {
#pragma unroll
                    for (int ks = 0; ks < 2; ++ks) acc = mfma16(ldfrag(KT + (16 * jt + l15) * GP + 32 * ks + 8 * g4), ldfrag(QT + (16 * it + l15) * GP + 32 * ks + 8 * g4), acc); }
                const int i = 16 * it + l15, j0 = 16 * jt + 4 * g4;
                float p0 = (j0 + 0 <= i) ? acc[0] : 0.f, p1 = (j0 + 1 <= i) ? acc[1] : 0.f, p2 = (j0 + 2 <= i) ? acc[2] : 0.f, p3 = (j0 + 3 <= i) ? acc[3] : 0.f;
                u32x2 pk; pk.x = pk2(p0, p1); pk.y = pk2(p2, p3);
                *(LAS u32x2*)(PM + i * GP + j0) = pk; }
            LBAR();
        }
        bf16x8 Bv[2];
#pragma unroll
        for (int ks = 0; ks < 2; ++ks) Bv[ks] = ldfrag_tr(VN + (32 * ks + 8 * g4 + (l15 >> 2)) * VP + 16 * w + 4 * (l & 3), VP);
        if (OUT) {
            bf16x8 Bs[2];
#pragma unroll
            for (int ks = 0; ks < 2; ++ks) Bs[ks] = acc2frag(S[2 * ks], S[2 * ks + 1]);
#pragma unroll
            for (int it = 0; it < 4; ++it) { f32x4 acc = (f32x4){0.f, 0.f, 0.f, 0.f};
#pragma unroll
                for (int ks = 0; ks < 2; ++ks) acc = mfma16(ldfrag(PM + (16 * it + l15) * GP + 32 * ks + 8 * g4), Bv[ks], acc);
#pragma unroll
                for (int ks = 0; ks < 2; ++ks) acc = mfma16(ldfrag_perm(QT + (16 * it + l15) * GP + 32 * ks + 4 * g4), Bs[ks], acc);
                { const unsigned w01 = pk2(acc[0], acc[1]), w23 = pk2(acc[2], acc[3]); LAS bf16_t* op = OT + (16 * it + 4 * g4) * VP + 16 * w + l15;
                  op[0] = (bf16_t)(w01 & 0xffffu); op[VP] = (bf16_t)(w01 >> 16); op[2 * VP] = (bf16_t)(w23 & 0xffffu); op[3 * VP] = (bf16_t)(w23 >> 16); } }
        }
#pragma unroll
        for (int dt = 0; dt < 4; ++dt) { const f32x4 av = *(const LAS f32x4*)(AD + 16 * dt + 4 * g4); S[dt] = S[dt] * av;
#pragma unroll
            for (int ks = 0; ks < 2; ++ks) S[dt] = mfma16(ldfrag(KHT + (16 * dt + l15) * GP + 32 * ks + 8 * g4), Bv[ks], S[dt]); }
        LBAR();
    }
    if (OUT) { GLA_FLUSH(chunk_rlo(b, dir, seg, nch - 1)); LBAR(); }
#undef GLA_FLUSH
#undef GLA_GKLOAD
#undef GLA_GCOMP
    if (!OUT) { bf16_t* dst = (bf16_t*)(F.ws + WS_USG) + ((size_t)seq * 17 + seg) * 8192 + w * 1024 + l * 16;
#pragma unroll
        for (int dt = 0; dt < 4; ++dt) st_bf4(dst + dt * 4, S[dt]);
        if (w == 0) ((float*)(F.ws + WS_ASG))[((size_t)seq * 17 + seg) * 64 + l] = segsum; }
}

struct SsdRegs { u32x4 c[2], bm[2], x[4]; unsigned dtraw; };
template <bool OUT> __device__ __forceinline__ void ssd_load1(SsdRegs& R, const Ctx& F, int rlo, int dir, int g) {
    const char* P = (const char*)(F.ws + WS_P); const char* XBC = (const char*)(F.ws + WS_XBC);
#pragma unroll
    for (int u = 0; u < 2; ++u) { const int idx = F.tid + 512 * u, j = idx >> 4, ch = idx & 15, row = dir ? rlo + 63 - j : rlo + j;
        R.bm[u] = *(const u32x4*)(XBC + (unsigned)(row * 1024 + 512 + g * 128 + ch * 8) * 2u); }
    R.dtraw = 0u;
    if (F.wave < 4) { const int row = dir ? rlo + 63 - F.lane : rlo + F.lane; R.dtraw = *(const unsigned short*)(P + (unsigned)(row * NP + CDT + g * 4 + F.wave) * 2u); }
}
template <bool OUT> __device__ __forceinline__ void ssd_load2(SsdRegs& R, const Ctx& F, int rlo, int dir, int g) {
    const char* XBC = (const char*)(F.ws + WS_XBC);
    if (OUT) {
#pragma unroll
        for (int u = 0; u < 2; ++u) { const int idx = F.tid + 512 * u, j = idx >> 4, ch = idx & 15, row = dir ? rlo + 63 - j : rlo + j;
            R.c[u] = *(const u32x4*)(XBC + (unsigned)(row * 1024 + 768 + g * 128 + ch * 8) * 2u); } }
#pragma unroll
    for (int u = 0; u < 4; ++u) { const int idx = F.tid + 512 * u, j = idx >> 5, ch = idx & 31, row = dir ? rlo + 63 - j : rlo + j;
        R.x[u] = *(const u32x4*)(XBC + (unsigned)(row * 1024 + g * 256 + ch * 8) * 2u); }
}
template <bool OUT> __device__ __forceinline__ void ssd_item(const Ctx& F, int sg, int seg) {
    const int b = sg >> 2, g = (sg >> 1) & 1, dir = sg & 1;
    const int l = F.lane, g4 = l >> 4, l15 = l & 15, w = F.wave, r = w >> 1, ph = w & 1;
    LAS bf16_t* CM = (LAS bf16_t*)(F.lds + SL_CM); LAS bf16_t* BM = (LAS bf16_t*)(F.lds + SL_BM); LAS bf16_t* XM = (LAS bf16_t*)(F.lds + SL_XM); LAS bf16_t* MM = (LAS bf16_t*)(F.lds + SL_MM);
    LAS float* AC = (LAS float*)(F.lds + SL_AC); LAS float* DTl = (LAS float*)(F.lds + SL_DT); LAS float* Wl = (LAS float*)(F.lds + SL_W); LAS float* El = (LAS float*)(F.lds + SL_E); LAS float* DAl = (LAS float*)(F.lds + SL_DA);
    bf16_t* OS = (bf16_t*)(F.ws + WS_OS); LAS bf16_t* YT = (LAS bf16_t*)(F.lds + SL_YT);
#define SSD_FLUSH(rl) do { _Pragma("unroll") for (int u = 0; u < 4; ++u) { const int idx = F.tid + 512 * u, i = idx >> 5, ch = idx & 31, row = dir ? (rl) + 63 - i : (rl) + i; \
        *(u32x4*)((char*)OS + (unsigned)((dir * TL + row) * 512 + g * 256 + ch * 8) * 2u) = *(const LAS u32x4*)(YT + i * XP + ch * 8); } } while (0)
    f32x4 ST[8][2];
    if (OUT) { const bf16_t* src = (const bf16_t*)(F.ws + WS_SSS) + ((size_t)sg * 16 + (seg - 1)) * 32768 + w * 4096 + l * 64;
#pragma unroll
        for (int st = 0; st < 8; ++st)
#pragma unroll
            for (int nt = 0; nt < 2; ++nt) ST[st][nt] = ld_bf4(src + (st * 2 + nt) * 4); }
    else {
#pragma unroll
        for (int st = 0; st < 8; ++st)
#pragma unroll
            for (int nt = 0; nt < 2; ++nt) ST[st][nt] = (f32x4){0.f, 0.f, 0.f, 0.f}; }
    const int hh4 = (w < 4) ? (g * 4 + w) : 0;
    const float Ah = -__expf(GIN(F, IN_ALOG)[dir * 8 + hh4]) * 1.4426950408889634f, dtb = GIN(F, IN_DTBIAS)[dir * 8 + hh4];
    float segsum = 0.f;
    const int nch = (seg == 0) ? 4 : 8;
    SsdRegs R; ssd_load1<OUT>(R, F, chunk_rlo(b, dir, seg, 0), dir, g); ssd_load2<OUT>(R, F, chunk_rlo(b, dir, seg, 0), dir, g);
#pragma unroll 1
    for (int c = 0; c < nch; ++c) {
        const int rlo = chunk_rlo(b, dir, seg, c);
        if (OUT && c > 0) SSD_FLUSH(chunk_rlo(b, dir, seg, c - 1));
#pragma unroll
        for (int u = 0; u < 2; ++u) { const int idx = F.tid + 512 * u, j = idx >> 4, ch = idx & 15;
            if (OUT) *(LAS u32x4*)(CM + j * VP + ch * 8) = R.c[u];
            *(LAS u32x4*)(BM + j * VP + ch * 8) = R.bm[u]; }
#pragma unroll
        for (int u = 0; u < 4; ++u) { const int idx = F.tid + 512 * u, j = idx >> 5, ch = idx & 31; *(LAS u32x4*)(XM + j * XP + ch * 8) = R.x[u]; }
        if (w < 4) { const float dtx = __builtin_bit_cast(float, R.dtraw << 16) + dtb;
            const float dt = fmaxf(dtx, 0.f) + 0.6931471805599453f * __builtin_amdgcn_logf(1.f + __builtin_amdgcn_exp2f(-fabsf(dtx) * 1.4426950408889634f)); float a = dt * Ah;
#pragma unroll
            for (int off = 1; off < 64; off <<= 1) { const float t = __shfl_up(a, off); if (l >= off) a += t; }
            const float alast = __shfl(a, 63);
            AC[w * 64 + l] = a; DTl[w * 64 + l] = dt; Wl[w * 64 + l] = __builtin_amdgcn_exp2f(alast - a) * dt; El[w * 64 + l] = __builtin_amdgcn_exp2f(a);
            if (l == 0) DAl[w] = __builtin_amdgcn_exp2f(alast);
            segsum += alast; }
        LBAR();
        if (c + 1 < nch) ssd_load1<OUT>(R, F, chunk_rlo(b, dir, seg, c + 1), dir, g);
        if (OUT) {
            const int jt = w & 3;
#pragma unroll
            for (int ii = 0; ii < 2; ++ii) { const int it = 2 * (w >> 2) + ii; f32x4 acc = (f32x4){0.f, 0.f, 0.f, 0.f};
                if (jt <= it) {
#pragma unroll
                    for (int ks = 0; ks < 4; ++ks) acc = mfma16(ldfrag(BM + (16 * jt + l15) * VP + 32 * ks + 8 * g4), ldfrag(CM + (16 * it + l15) * VP + 32 * ks + 8 * g4), acc); }
                const int i = 16 * it + l15, j0 = 16 * jt + 4 * g4;
#pragma unroll
                for (int rr = 0; rr < 4; ++rr) { const float ai = AC[rr * 64 + i]; const f32x4 aj = *(const LAS f32x4*)(AC + rr * 64 + j0), dj = *(const LAS f32x4*)(DTl + rr * 64 + j0);
                    float m[4];
#pragma unroll
                    for (int q = 0; q < 4; ++q) m[q] = (j0 + q <= i) ? acc[q] * __builtin_amdgcn_exp2f(fminf(ai - aj[q], 0.f)) * dj[q] : 0.f;
                    u32x2 pk; pk.x = pk2(m[0], m[1]); pk.y = pk2(m[2], m[3]);
                    *(LAS u32x2*)(MM + (rr * 64 + i) * GP + j0) = pk; } }
            LBAR();
        }
        const int p0 = 64 * r + 32 * ph;
        if (OUT) {
#pragma unroll
            for (int nt = 0; nt < 2; ++nt) {
                f32x4 ay[4];
#pragma unroll
                for (int it = 0; it < 4; ++it) ay[it] = (f32x4){0.f, 0.f, 0.f, 0.f};
                bf16x8 Ac[4], An[4];
#pragma unroll
                for (int it = 0; it < 4; ++it) Ac[it] = ldfrag_perm(CM + (16 * it + l15) * VP + 4 * g4);
#pragma unroll
                for (int ks = 0; ks < 4; ++ks) {
                    if (ks < 3) {
#pragma unroll
                        for (int it = 0; it < 4; ++it) An[it] = ldfrag_perm(CM + (16 * it + l15) * VP + 32 * (ks + 1) + 4 * g4); }
                    else {
#pragma unroll
                        for (int it = 0; it < 4; ++it) An[it] = ldfrag(MM + (r * 64 + 16 * it + l15) * GP + 8 * g4); }
                    const bf16x8 Bst = acc2frag(ST[2 * ks][nt], ST[2 * ks + 1][nt]);
#pragma unroll
                    for (int it = 0; it < 4; ++it) ay[it] = mfma16(Ac[it], Bst, ay[it]);
                    __builtin_amdgcn_sched_barrier(0);
#pragma unroll
                    for (int it = 0; it < 4; ++it) Ac[it] = An[it]; }
                bf16x8 Bx0 = ldfrag_tr(XM + (8 * g4 + (l15 >> 2)) * XP + p0 + 16 * nt + 4 * (l & 3), XP);
                const bf16x8 Bx1 = ldfrag_tr(XM + (32 + 8 * g4 + (l15 >> 2)) * XP + p0 + 16 * nt + 4 * (l & 3), XP);
#pragma unroll
                for (int it = 0; it < 4; ++it) { const f32x4 ev = *(const LAS f32x4*)(El + r * 64 + 16 * it + 4 * g4); ay[it] = ay[it] * ev; }
#pragma unroll
                for (int it = 0; it < 4; ++it) An[it] = ldfrag(MM + (r * 64 + 16 * it + l15) * GP + 32 + 8 * g4);
#pragma unroll
                for (int it = 0; it < 4; ++it) ay[it] = mfma16(Ac[it], Bx0, ay[it]);
                __builtin_amdgcn_sched_barrier(0);
#pragma unroll
                for (int it = 0; it < 4; ++it) ay[it] = mfma16(An[it], Bx1, ay[it]);
#pragma unroll
                for (int it = 0; it < 4; ++it) { const unsigned w01 = pk2(ay[it][0], ay[it][1]), w23 = pk2(ay[it][2], ay[it][3]); LAS bf16_t* yp = YT + (16 * it + 4 * g4) * XP + p0 + 16 * nt + l15;
                    yp[0] = (bf16_t)(w01 & 0xffffu); yp[XP] = (bf16_t)(w01 >> 16); yp[2 * XP] = (bf16_t)(w23 & 0xffffu); yp[3 * XP] = (bf16_t)(w23 >> 16); }
                __builtin_amdgcn_sched_barrier(0);
            }
        }
        if (c + 1 < nch) ssd_load2<OUT>(R, F, chunk_rlo(b, dir, seg, c + 1), dir, g);
        { const float dA = DAl[r];
          bf16x8 Bx[2][2];
#pragma unroll
          for (int ks = 0; ks < 2; ++ks)
#pragma unroll
              for (int nt = 0; nt < 2; ++nt) Bx[ks][nt] = ldfrag_tr(XM + (32 * ks + 8 * g4 + (l15 >> 2)) * XP + p0 + 16 * nt + 4 * (l & 3), XP);
          bf16x8 Af[2]; Af[0] = ldfrag_tr(BM + (8 * g4 + (l15 >> 2)) * VP + 4 * (l & 3), VP); Af[1] = ldfrag_tr(BM + (32 + 8 * g4 + (l15 >> 2)) * VP + 4 * (l & 3), VP);
          bf16x8 Bw[2][2];
#pragma unroll
          for (int ks = 0; ks < 2; ++ks) { const f32x4 w0 = *(const LAS f32x4*)(Wl + r * 64 + 32 * ks + 8 * g4), w1 = *(const LAS f32x4*)(Wl + r * 64 + 32 * ks + 8 * g4 + 4);
#pragma unroll
              for (int nt = 0; nt < 2; ++nt) { const u32x4 xv = __builtin_bit_cast(u32x4, Bx[ks][nt]); u32x4 o;
                  o.x = pk2(bflo(xv.x) * w0[0], bfhi(xv.x) * w0[1]); o.y = pk2(bflo(xv.y) * w0[2], bfhi(xv.y) * w0[3]);
                  o.z = pk2(bflo(xv.z) * w1[0], bfhi(xv.z) * w1[1]); o.w = pk2(bflo(xv.w) * w1[2], bfhi(xv.w) * w1[3]);
                  Bw[ks][nt] = __builtin_bit_cast(bf16x8, o); } }
#pragma unroll
          for (int st = 0; st < 8; ++st) { ST[st][0] = ST[st][0] * dA; ST[st][1] = ST[st][1] * dA;
              bf16x8 Ag[2]; if (st < 7) { Ag[0] = ldfrag_tr(BM + (8 * g4 + (l15 >> 2)) * VP + 16 * (st + 1) + 4 * (l & 3), VP); Ag[1] = ldfrag_tr(BM + (32 + 8 * g4 + (l15 >> 2)) * VP + 16 * (st + 1) + 4 * (l & 3), VP); }
              else { Ag[0] = Af[0]; Ag[1] = Af[1]; }
#pragma unroll
              for (int ks = 0; ks < 2; ++ks) { ST[st][0] = mfma16(Af[ks], Bw[ks][0], ST[st][0]); ST[st][1] = mfma16(Af[ks], Bw[ks][1], ST[st][1]); }
              __builtin_amdgcn_sched_barrier(0);
              Af[0] = Ag[0]; Af[1] = Ag[1]; } }
        LBAR();
    }
    if (OUT) { SSD_FLUSH(chunk_rlo(b, dir, seg, nch - 1)); LBAR(); }
#undef SSD_FLUSH
    if (!OUT) { bf16_t* dst = (bf16_t*)(F.ws + WS_USS) + ((size_t)sg * 17 + seg) * 32768 + w * 4096 + l * 64;
#pragma unroll
        for (int st = 0; st < 8; ++st)
#pragma unroll
            for (int nt = 0; nt < 2; ++nt) st_bf4(dst + (st * 2 + nt) * 4, ST[st][nt]);
        if (w < 4 && l == 0) ((float*)(F.ws + WS_ASS))[((size_t)sg * 17 + seg) * 4 + w] = segsum; }
}

__device__ __forceinline__ void ph_scan_a(Ctx& F) {
    for (int item = F.bid; item < 240 + 480 + 16 + 32; item += F.G) {
        if (item < 240) ssd_item<false>(F, item / 15, 1 + item % 15);
        else if (item < 720) { const int q = item - 240; gla_item<false>(F, q / 15, 1 + q % 15); }
        else if (item < 736) ssd_item<false>(F, item - 720, 0);
        else gla_item<false>(F, item - 736, 0);
    }
}
__device__ __forceinline__ void ph_scan_b(Ctx& F) {
    const int gt = F.bid * 512 + F.tid, NT = F.G * 512;
    for (int it = gt; it < 32 * 2048 + 16 * 8192; it += NT) {
        if (it < 32 * 2048) {
            const int seq = it >> 11, e4 = it & 2047, e = e4 * 4, lane = (e >> 4) & 63, dt = (e >> 2) & 3, d0 = 16 * dt + 4 * (lane >> 4);
            const bf16_t* U = (const bf16_t*)(F.ws + WS_USG) + (size_t)seq * 17 * 8192 + e; const float* A = (const float*)(F.ws + WS_ASG) + (size_t)seq * 17 * 64 + d0;
            bf16_t* O = (bf16_t*)(F.ws + WS_SSG) + (size_t)seq * 16 * 8192 + e;
            f32x4 S = ld_bf4(U); st_bf4(O, S);
#pragma unroll 1
            for (int m = 1; m < 16; ++m) { const f32x4 u = ld_bf4(U + (size_t)m * 8192); const f32x4 a = *(const f32x4*)(A + m * 64);
                S.x = __builtin_amdgcn_exp2f(a.x) * S.x + u.x; S.y = __builtin_amdgcn_exp2f(a.y) * S.y + u.y; S.z = __builtin_amdgcn_exp2f(a.z) * S.z + u.z; S.w = __builtin_amdgcn_exp2f(a.w) * S.w + u.w;
                st_bf4(O + (size_t)m * 8192, S); }
        } else {
            const int q = it - 32 * 2048, sg = q >> 13, e4 = q & 8191, e = e4 * 4, r = (e >> 12) >> 1;
            const bf16_t* U = (const bf16_t*)(F.ws + WS_USS) + (size_t)sg * 17 * 32768 + e; const float* A = (const float*)(F.ws + WS_ASS) + (size_t)sg * 17 * 4 + r;
            bf16_t* O = (bf16_t*)(F.ws + WS_SSS) + (size_t)sg * 16 * 32768 + e;
            f32x4 S = ld_bf4(U); st_bf4(O, S);
#pragma unroll 1
            for (int m = 1; m < 16; ++m) { const f32x4 u = ld_bf4(U + (size_t)m * 32768); const float a = __builtin_amdgcn_exp2f(A[m * 4]);
                S = S * a + u; st_bf4(O + (size_t)m * 32768, S); }
        }
    }
}
__device__ __forceinline__ void combine_gla_block(const Ctx& F, int b, int h, int seg) {
    const char* OG = (const char*)(F.ws + WS_OG); const char* P = (const char*)(F.ws + WS_P); char* Y = (char*)(F.ws + WS_Y);
    int l = F.lane; asm volatile("" : "+v"(l));
    const int sub = l >> 4, c8 = (l & 15) * 8, row0 = b * SEQ + 512 * (seg - 1);
    float nw[8]; { const f32x4 n0 = *(const f32x4*)(GIN(F, IN_GLANORM) + c8), n1 = *(const f32x4*)(GIN(F, IN_GLANORM) + c8 + 4); nw[0] = n0.x; nw[1] = n0.y; nw[2] = n0.z; nw[3] = n0.w; nw[4] = n1.x; nw[5] = n1.y; nw[6] = n1.z; nw[7] = n1.w; }
    constexpr int U = 4;
    for (int t0 = F.wave * 4 * U; t0 < 512; t0 += 8 * 4 * U) {
        u32x4 a[U], c[U], g[U];
#pragma unroll
        for (int u = 0; u < U; ++u) { const int row = row0 + t0 + 4 * u + sub;
            a[u] = *(const u32x4*)(OG + (unsigned)(row * 512 + h * 128 + c8) * 2u); c[u] = *(const u32x4*)(OG + (unsigned)((TL + row) * 512 + h * 128 + c8) * 2u);
            g[u] = *(const u32x4*)(P + (unsigned)(row * NP + CG + h * 128 + c8) * 2u); }
#pragma unroll
        for (int u = 0; u < U; ++u) { const int row = row0 + t0 + 4 * u + sub;
            float o[8], gt[8];
            o[0] = bflo(a[u].x) + bflo(c[u].x); o[1] = bfhi(a[u].x) + bfhi(c[u].x); o[2] = bflo(a[u].y) + bflo(c[u].y); o[3] = bfhi(a[u].y) + bfhi(c[u].y);
            o[4] = bflo(a[u].z) + bflo(c[u].z); o[5] = bfhi(a[u].z) + bfhi(c[u].z); o[6] = bflo(a[u].w) + bflo(c[u].w); o[7] = bfhi(a[u].w) + bfhi(c[u].w);
            gt[0] = bflo(g[u].x); gt[1] = bfhi(g[u].x); gt[2] = bflo(g[u].y); gt[3] = bfhi(g[u].y); gt[4] = bflo(g[u].z); gt[5] = bfhi(g[u].z); gt[6] = bflo(g[u].w); gt[7] = bfhi(g[u].w);
            float ss = 0.f;
#pragma unroll
            for (int i = 0; i < 8; ++i) ss += o[i] * o[i];
            ss += __shfl_xor(ss, 1); ss += __shfl_xor(ss, 2); ss += __shfl_xor(ss, 4); ss += __shfl_xor(ss, 8);
            const float rstd = rsqrtf(ss * (1.f / 128.f) + EPS);
#pragma unroll
            for (int i = 0; i < 8; ++i) o[i] = o[i] * rstd * nw[i] * silu_f(gt[i]);
            u32x4 w; w.x = pk2(o[0], o[1]); w.y = pk2(o[2], o[3]); w.z = pk2(o[4], o[5]); w.w = pk2(o[6], o[7]);
            *(u32x4*)(Y + (unsigned)(row * 1024 + h * 128 + c8) * 2u) = w; }
    }
}
__device__ __forceinline__ void combine_ssd_block(const Ctx& F, int b, int g, int seg) {
    const char* OS = (const char*)(F.ws + WS_OS); const char* P = (const char*)(F.ws + WS_P); const char* XBC = (const char*)(F.ws + WS_XBC); char* Y = (char*)(F.ws + WS_Y);
    int l = F.lane; asm volatile("" : "+v"(l));
    const int sub = l >> 5, c0 = g * 256 + (l & 31) * 8, row0 = b * SEQ + 512 * (seg - 1);
    float nw[8]; { const f32x4 n0 = *(const f32x4*)(GIN(F, IN_SSDNORM) + c0), n1 = *(const f32x4*)(GIN(F, IN_SSDNORM) + c0 + 4); nw[0] = n0.x; nw[1] = n0.y; nw[2] = n0.z; nw[3] = n0.w; nw[4] = n1.x; nw[5] = n1.y; nw[6] = n1.z; nw[7] = n1.w; }
    const float Dh = GIN(F, IN_SSDD)[c0 >> 6];
    constexpr int U = 4;
    for (int t0 = F.wave * 2 * U; t0 < 512; t0 += 8 * 2 * U) {
        u32x4 a[U], c[U], z[U], x[U];
#pragma unroll
        for (int u = 0; u < U; ++u) { const int row = row0 + t0 + 2 * u + sub;
            a[u] = *(const u32x4*)(OS + (unsigned)(row * 512 + c0) * 2u); c[u] = *(const u32x4*)(OS + (unsigned)((TL + row) * 512 + c0) * 2u);
            z[u] = *(const u32x4*)(P + (unsigned)(row * NP + CZ + c0) * 2u); x[u] = *(const u32x4*)(XBC + (unsigned)(row * 1024 + c0) * 2u); }
#pragma unroll
        for (int u = 0; u < U; ++u) { const int row = row0 + t0 + 2 * u + sub;
            float v[8];
#define SSDV(i, A, C, X, Z) v[i] = (A + C + Dh * X) * silu_f(Z)
            SSDV(0, bflo(a[u].x), bflo(c[u].x), bflo(x[u].x), bflo(z[u].x)); SSDV(1, bfhi(a[u].x), bfhi(c[u].x), bfhi(x[u].x), bfhi(z[u].x));
            SSDV(2, bflo(a[u].y), bflo(c[u].y), bflo(x[u].y), bflo(z[u].y)); SSDV(3, bfhi(a[u].y), bfhi(c[u].y), bfhi(x[u].y), bfhi(z[u].y));
            SSDV(4, bflo(a[u].z), bflo(c[u].z), bflo(x[u].z), bflo(z[u].z)); SSDV(5, bfhi(a[u].z), bfhi(c[u].z), bfhi(x[u].z), bfhi(z[u].z));
            SSDV(6, bflo(a[u].w), bflo(c[u].w), bflo(x[u].w), bflo(z[u].w)); SSDV(7, bfhi(a[u].w), bfhi(c[u].w), bfhi(x[u].w), bfhi(z[u].w));
#undef SSDV
            float ss = 0.f;
#pragma unroll
            for (int i = 0; i < 8; ++i) ss += v[i] * v[i];
            ss += __shfl_xor(ss, 1); ss += __shfl_xor(ss, 2); ss += __shfl_xor(ss, 4); ss += __shfl_xor(ss, 8); ss += __shfl_xor(ss, 16);
            const float rstd = rsqrtf(ss * (1.f / 256.f) + EPS);
            u32x4 w; w.x = pk2(v[0] * rstd * nw[0], v[1] * rstd * nw[1]); w.y = pk2(v[2] * rstd * nw[2], v[3] * rstd * nw[3]); w.z = pk2(v[4] * rstd * nw[4], v[5] * rstd * nw[5]); w.w = pk2(v[6] * rstd * nw[6], v[7] * rstd * nw[7]);
            *(u32x4*)(Y + (unsigned)(row * 1024 + 512 + c0) * 2u) = w; }
    }
}
__device__ __forceinline__ void ph_scan_c(Ctx& F) {
    const bool deal = (F.G == 256);
    const int first = deal ? (F.bid < 128 ? F.bid : 128 + 2 * (F.bid - 128)) : F.bid;
    const int count = deal ? (F.bid < 128 ? 1 : 2) : (384 - F.bid + F.G - 1) / F.G;
    const int step = deal ? 1 : F.G;
#pragma unroll 1
    for (int k2 = 0; k2 < 2 * count; ++k2) {
        const int pit = first + (k2 >> 1) * step, d = k2 & 1;
        { GAS unsigned char* g = (GAS unsigned char*)F.ws; asm volatile("" : "+s"(g)); F.ws = (unsigned char*)g; }
        if (pit < 128) { const int seg = 1 + (pit & 15); ssd_item<true>(F, (pit >> 4) * 2 + d, d ? 17 - seg : seg); }
        else { const int seg = 1 + ((pit - 128) & 15); gla_item<true>(F, ((pit - 128) >> 4) * 2 + d, d ? 17 - seg : seg); }
        if (d) {
            asm volatile("s_waitcnt vmcnt(0)" ::: "memory"); __syncthreads();
            if (pit < 128) combine_ssd_block(F, pit >> 5, (pit >> 4) & 1, 1 + (pit & 15));
            else combine_gla_block(F, (pit - 128) >> 6, ((pit - 128) >> 4) & 3, 1 + ((pit - 128) & 15));
        }
    }
}

#define UNP(dst, w0, w1) dst[0] = bflo(w0.x); dst[1] = bfhi(w0.x); dst[2] = bflo(w0.y); dst[3] = bfhi(w0.y); dst[4] = bflo(w0.z); dst[5] = bfhi(w0.z); dst[6] = bflo(w0.w); dst[7] = bfhi(w0.w); \
        dst[8] = bflo(w1.x); dst[9] = bfhi(w1.x); dst[10] = bflo(w1.y); dst[11] = bfhi(w1.y); dst[12] = bflo(w1.z); dst[13] = bfhi(w1.z); dst[14] = bflo(w1.w); dst[15] = bfhi(w1.w)
__device__ __forceinline__ void ph_combine(Ctx& F) {
    const bf16_t* P = (const bf16_t*)(F.ws + WS_P); const bf16_t* XBC = (const bf16_t*)(F.ws + WS_XBC);
    const bf16_t* OG = (const bf16_t*)(F.ws + WS_OG); const bf16_t* OS = (const bf16_t*)(F.ws + WS_OS); bf16_t* Y = (bf16_t*)(F.ws + WS_Y);
    const int gw = F.bid * 8 + F.wave, NGW = F.G * 8, l = F.lane;
    const bool gla = l < 32; const int c0 = gla ? 16 * l : 16 * (l - 32);
    float nwv[16]; { const float* nw = gla ? GIN(F, IN_GLANORM) + (c0 & 127) : GIN(F, IN_SSDNORM) + c0;
#pragma unroll
        for (int i = 0; i < 16; ++i) nwv[i] = nw[i]; }
    const float Dh = GIN(F, IN_SSDD)[c0 >> 6];
    constexpr int U = 4;
    for (int r0 = gw * U; r0 < TL; r0 += NGW * U) {
        u32x4 a0[U], a1[U], b0[U], b1[U], g0[U], g1[U], x0[U], x1[U];
#pragma unroll
        for (int u = 0; u < U; ++u) { const int r = r0 + u;
            const bf16_t* o0 = (gla ? OG : OS) + (size_t)r * 512 + c0; const bf16_t* o1 = o0 + (size_t)TL * 512;
            const bf16_t* gz = P + (size_t)r * NP + (gla ? CG : CZ) + c0; const bf16_t* xp = XBC + (size_t)r * 1024 + c0;
            a0[u] = *(const u32x4*)o0; a1[u] = *(const u32x4*)(o0 + 8); b0[u] = *(const u32x4*)o1; b1[u] = *(const u32x4*)(o1 + 8); g0[u] = *(const u32x4*)gz; g1[u] = *(const u32x4*)(gz + 8);
            x0[u] = (u32x4){0u, 0u, 0u, 0u}; x1[u] = x0[u];
            if (!gla) { x0[u] = *(const u32x4*)xp; x1[u] = *(const u32x4*)(xp + 8); } }
#pragma unroll
        for (int u = 0; u < U; ++u) { const int r = r0 + u;
            float v[16], gt[16], t0[16], t1[16], xv[16]; UNP(t0, a0[u], a1[u]); UNP(t1, b0[u], b1[u]); UNP(gt, g0[u], g1[u]); UNP(xv, x0[u], x1[u]);
#pragma unroll
            for (int i = 0; i < 16; ++i) { const float sg = silu_f(gt[i]); v[i] = gla ? (t0[i] + t1[i]) : (t0[i] + t1[i] + Dh * xv[i]) * sg; gt[i] = sg; }
            float ss = 0.f;
#pragma unroll
            for (int i = 0; i < 16; ++i) ss += v[i] * v[i];
            ss += __shfl_xor(ss, 1); ss += __shfl_xor(ss, 2); ss += __shfl_xor(ss, 4);
            const float s8 = __shfl_xor(ss, 8); if (!gla) ss += s8;
            const float rstd = rsqrtf(ss * (gla ? (1.f / 128.f) : (1.f / 256.f)) + EPS);
            float o[16];
#pragma unroll
            for (int i = 0; i < 16; ++i) { float y = v[i] * rstd * nwv[i]; if (gla) y *= gt[i]; o[i] = y; }
            u32x4 w0, w1; w0.x = pk2(o[0], o[1]); w0.y = pk2(o[2], o[3]); w0.z = pk2(o[4], o[5]); w0.w = pk2(o[6], o[7]); w1.x = pk2(o[8], o[9]); w1.y = pk2(o[10], o[11]); w1.z = pk2(o[12], o[13]); w1.w = pk2(o[14], o[15]);
            bf16_t* yp = Y + (size_t)r * 1024 + (gla ? 0 : 512) + c0;
            *(u32x4*)yp = w0; *(u32x4*)(yp + 8) = w1; }
    }
}

constexpr int WRS = 1028;
__device__ __forceinline__ void ph_router(Ctx& F) {
    const float* mod = (const float*)(F.ws + WS_MOD); unsigned char* H2 = (unsigned char*)(F.ws + WS_H);
    unsigned* ctl = (unsigned*)(F.ws + WS_CTL);
    int* tok_e = (int*)(F.ws + WS_TOKE); int* tok_p = (int*)(F.ws + WS_TOKP); float* tok_g = (float*)(F.ws + WS_TOKG); int* rowtok = (int*)(F.ws + WS_ROWTOK);
    LAS float* WT = (LAS float*)F.lds;
    LAS int* lcnt = (LAS int*)(F.lds + MISC_OFF);
    LAS int* gbase = lcnt + 32;
    LAS int* rec_e = gbase + 32;
    LAS int* rec_p = rec_e + 512;
    LAS float* biasl = (LAS float*)(rec_p + 512);
    LAS float* rsl = biasl + 32;
    LAS float* wpl = rsl + 128;
    LAS float* shl = wpl + 1024;
    const int l = F.lane, i16 = l & 15, kk = l >> 4, w = F.wave;
    if (F.bid == 0) { for (int i = F.tid; i < 256; i += 512) ((unsigned*)(H2 + (size_t)ZROW * DM))[i] = 0u; }
    int cur_b = -1;
    for (int tile = F.bid; tile < TL / 128; tile += F.G) {
        const int b = (tile * 128) >> 13;
        if (b != cur_b) {
            cur_b = b;
            __syncthreads();
            const float* sh = mod + b * 6144 + 3 * 1024; const float* scl = sh + 1024;
            for (int k = F.tid; k < 1024; k += 512) { wpl[k] = GIN(F, IN_NORM2)[k] * (1.f + scl[k]); shl[k] = sh[k]; }
            if (F.tid < 32) lcnt[F.tid] = 0;
            __syncthreads();
            { float ba = 0.f;
#pragma unroll 16
              for (int j = 0; j < 64; ++j) { const int i = F.tid + 512 * j, k = i >> 5, e = i & 31; const float wr = GIN(F, IN_WR)[i]; WT[e * WRS + k] = wr * wpl[k]; ba += shl[k] * wr; }
              LAS float* red = (LAS float*)(rec_e);
              red[(F.tid >> 5) * 32 + (F.tid & 31)] = ba; }
            __syncthreads();
            if (F.tid < 32) { float a = GIN(F, IN_BR)[F.tid];
#pragma unroll
                for (int q = 0; q < 16; ++q) a += ((LAS float*)rec_e)[q * 32 + F.tid];
                biasl[F.tid] = a; }
            __syncthreads();
        }
        const int row = tile * 128 + w * 16 + i16;
        const bf16_t* X1 = (const bf16_t*)(F.ws + WS_X1);
        const bf16_t* xr = X1 + (size_t)row * DM + 256 * kk;
        const LAS float* w0p = WT + i16 * WRS + 256 * kk; const LAS float* w1p = w0p + 16 * WRS;
        f32x4 a0 = (f32x4){0.f, 0.f, 0.f, 0.f}, a1 = a0; float ss = 0.f;
#pragma unroll 4
        for (int q = 0; q < 32; ++q) { const u32x4 xb = *(const u32x4*)(xr + 8 * q); float xv[8];
            xv[0] = bflo(xb.x); xv[1] = bfhi(xb.x); xv[2] = bflo(xb.y); xv[3] = bfhi(xb.y); xv[4] = bflo(xb.z); xv[5] = bfhi(xb.z); xv[6] = bflo(xb.w); xv[7] = bfhi(xb.w);
            const f32x4 w0a = *(const LAS f32x4*)(w0p + 8 * q), w0b = *(const LAS f32x4*)(w0p + 8 * q + 4), w1a = *(const LAS f32x4*)(w1p + 8 * q), w1b = *(const LAS f32x4*)(w1p + 8 * q + 4);
#pragma unroll
            for (int c = 0; c < 8; ++c) ss += xv[c] * xv[c];
#pragma unroll
            for (int c = 0; c < 4; ++c) { a0 = __builtin_amdgcn_mfma_f32_16x16x4f32(xv[c], w0a[c], a0, 0, 0, 0); a1 = __builtin_amdgcn_mfma_f32_16x16x4f32(xv[c], w1a[c], a1, 0, 0, 0); }
#pragma unroll
            for (int c = 0; c < 4; ++c) { a0 = __builtin_amdgcn_mfma_f32_16x16x4f32(xv[4 + c], w0b[c], a0, 0, 0, 0); a1 = __builtin_amdgcn_mfma_f32_16x16x4f32(xv[4 + c], w1b[c], a1, 0, 0, 0); } }
        ss += __shfl_xor(ss, 16); ss += __shfl_xor(ss, 32);
        const float rstd_i = rsqrtf(ss * (1.f / DM) + EPS);
        if (kk == 0) rsl[w * 16 + i16] = rstd_i;
        LDS_WAIT(); asm volatile("" ::: "memory");
        const f32x4 rs4 = *(const LAS f32x4*)(rsl + w * 16 + 4 * kk);
        const float bz0 = biasl[i16], bz1 = biasl[16 + i16];
        float v0[4], v1[4];
#pragma unroll
        for (int r = 0; r < 4; ++r) { v0[r] = a0[r] * rs4[r] + bz0; v1[r] = a1[r] * rs4[r] + bz1; }
        int ei[4][4]; float ev[4][4];
#pragma unroll
        for (int k = 0; k < 4; ++k)
#pragma unroll
            for (int r = 0; r < 4; ++r) { float bv = v0[r]; int bi = i16; if (v1[r] > bv) { bv = v1[r]; bi = 16 + i16; }
#pragma unroll
                for (int o = 1; o < 16; o <<= 1) { const float ov = __shfl_xor(bv, o); const int oi = __shfl_xor(bi, o); if (ov > bv || (ov == bv && oi < bi)) { bv = ov; bi = oi; } }
                ei[k][r] = bi; ev[k][r] = bv; if (bi == i16) v0[r] = -3.3e38f; if (bi == 16 + i16) v1[r] = -3.3e38f; }
        if (i16 == 0) {
#pragma unroll
            for (int r = 0; r < 4; ++r) { const int tl = w * 16 + 4 * kk + r, rr = tile * 128 + tl;
                const float e1 = __expf(ev[1][r] - ev[0][r]), e2 = __expf(ev[2][r] - ev[0][r]), e3 = __expf(ev[3][r] - ev[0][r]); const float inv = 1.f / (1.f + e1 + e2 + e3);
                const float gts[4] = {inv, e1 * inv, e2 * inv, e3 * inv};
#pragma unroll
                for (int k = 0; k < 4; ++k) { const int lp = __hip_atomic_fetch_add(lcnt + ei[k][r], 1, __ATOMIC_RELAXED, __HIP_MEMORY_SCOPE_WORKGROUP);
                    rec_e[tl * 4 + k] = ei[k][r]; rec_p[tl * 4 + k] = lp; tok_g[(size_t)rr * 4 + k] = gts[k]; } }
        }
#pragma unroll 4
        for (int t = 0; t < 16; ++t) { const int r2 = tile * 128 + w * 16 + t; const float rs = rsl[w * 16 + t];
#pragma unroll
            for (int q = 0; q < 4; ++q) { const int idx = 4 * (l + 64 * q); const u32x2 xb = *(const u32x2*)(X1 + (size_t)r2 * DM + idx); const f32x4 xv = (f32x4){bflo(xb.x), bfhi(xb.x), bflo(xb.y), bfhi(xb.y)};
                const f32x4 wp = *(const LAS f32x4*)(wpl + idx), s4 = *(const LAS f32x4*)(shl + idx);
                const f32x4 o = (xv * rs * wp + s4) * HSCALE8;
                *(unsigned*)(H2 + (size_t)r2 * DM + idx) = pg8::pk4_fp8(o.x, o.y, o.z, o.w); } }
        __syncthreads();
        if (F.tid < 32) gbase[F.tid] = (int)__hip_atomic_fetch_add(ctl + CW_CNT + 64 * F.tid, (unsigned)lcnt[F.tid], __ATOMIC_RELAXED, __HIP_MEMORY_SCOPE_AGENT);
        __syncthreads();
        { const int tl = F.tid >> 2, r = tile * 128 + tl; const int e = rec_e[F.tid], pos = gbase[e] + rec_p[F.tid];
          tok_e[(size_t)r * 4 + (F.tid & 3)] = e; tok_p[(size_t)r * 4 + (F.tid & 3)] = pos; rowtok[(size_t)e * TL + pos] = r; }
        __syncthreads();
        if (F.tid < 32) lcnt[F.tid] = 0;
        __syncthreads();
    }
}

__device__ __forceinline__ void moe_tables(Ctx& F, LAS int*& cn, LAS int*& tb) {
    const unsigned* ctl = (const unsigned*)(F.ws + WS_CTL);
    cn = (LAS int*)(F.lds + MISC_OFF); tb = cn + 32;
    __syncthreads();
    if (F.tid < 32) cn[F.tid] = (int)__hip_atomic_load(ctl + CW_CNT + 64 * F.tid, __ATOMIC_RELAXED, __HIP_MEMORY_SCOPE_AGENT);
    __syncthreads();
    if (F.tid == 0) { int s = 0; for (int e = 0; e < 32; ++e) { tb[e] = s; s += (cn[e] + 255) >> 8; } tb[32] = s; }
    __syncthreads();
}

__device__ __forceinline__ void ph_final(Ctx& F, float* dst) {
    LAS int* cn; LAS int* tb; moe_tables(F, cn, tb);
    const float* mod = (const float*)(F.ws + WS_MOD); const unsigned char* YP = (const unsigned char*)(F.ws + WS_YP);
    const int* tok_e = (const int*)(F.ws + WS_TOKE); const int* tok_p = (const int*)(F.ws + WS_TOKP); const float* tok_g = (const float*)(F.ws + WS_TOKG);
    const int gw = F.bid * 8 + F.wave, NGW = F.G * 8;
    f32x4 fn[4];
#pragma unroll
    for (int q = 0; q < 4; ++q) fn[q] = *(const f32x4*)(GIN(F, IN_FNORM) + 4 * (F.lane + 64 * q));
    constexpr int U = 2;
    int4 ne[U], np[U]; f32x4 ng[U];
#pragma unroll
    for (int u = 0; u < U; ++u) { const int r = gw * U + u; ne[u] = *(const int4*)(tok_e + (size_t)r * 4); np[u] = *(const int4*)(tok_p + (size_t)r * 4); ng[u] = *(const f32x4*)(tok_g + (size_t)r * 4); }
    for (int r0 = gw * U; r0 < TL; r0 += NGW * U) {
        const unsigned char* yr[U][4]; float gt[U][4];
#pragma unroll
        for (int u = 0; u < U; ++u) { const int4 e4 = ne[u], p4 = np[u]; const f32x4 g4 = ng[u];
            yr[u][0] = YP + ((size_t)tb[e4.x] * 256 + p4.x) * DM; yr[u][1] = YP + ((size_t)tb[e4.y] * 256 + p4.y) * DM; yr[u][2] = YP + ((size_t)tb[e4.z] * 256 + p4.z) * DM; yr[u][3] = YP + ((size_t)tb[e4.w] * 256 + p4.w) * DM;
            gt[u][0] = g4.x * (1.0f / PSCALE8); gt[u][1] = g4.y * (1.0f / PSCALE8); gt[u][2] = g4.z * (1.0f / PSCALE8); gt[u][3] = g4.w * (1.0f / PSCALE8); }
        unsigned yw[U][4][4]; f32x4 xv[U][4];
        if (r0 + NGW * U < TL) {
#pragma unroll
            for (int u = 0; u < U; ++u) { const int r = r0 + NGW * U + u; ne[u] = *(const int4*)(tok_e + (size_t)r * 4); np[u] = *(const int4*)(tok_p + (size_t)r * 4); ng[u] = *(const f32x4*)(tok_g + (size_t)r * 4); } }
#pragma unroll
        for (int u = 0; u < U; ++u) {
#pragma unroll
            for (int k = 0; k < 4; ++k)
#pragma unroll
                for (int q = 0; q < 4; ++q) yw[u][k][q] = *(const unsigned*)(yr[u][k] + 4 * (F.lane + 64 * q));
#pragma unroll
            for (int q = 0; q < 4; ++q) { const u32x2 xb = ((const u32x2*)((const bf16_t*)(F.ws + WS_X1) + (size_t)(r0 + u) * DM))[F.lane + 64 * q]; xv[u][q] = (f32x4){bflo(xb.x), bfhi(xb.x), bflo(xb.y), bfhi(xb.y)}; } }
#pragma unroll
        for (int u = 0; u < U; ++u) { const int r = r0 + u; const int b = r >> 13; const float* g2 = mod + b * 6144 + 5 * 1024;
            f32x4 v[4]; float ss = 0.f;
#pragma unroll
            for (int q = 0; q < 4; ++q) { f32x4 m = (f32x4){0.f, 0.f, 0.f, 0.f};
#pragma unroll
                for (int k = 0; k < 4; ++k) { const unsigned w = yw[u][k][q]; const f32x2 lo = __builtin_amdgcn_cvt_pk_f32_fp8((int)w, false), hi = __builtin_amdgcn_cvt_pk_f32_fp8((int)w, true); m += (f32x4){lo.x, lo.y, hi.x, hi.y} * gt[u][k]; }
                v[q] = xv[u][q] + *(const f32x4*)(g2 + 4 * (F.lane + 64 * q)) * m;
                ss += (v[q].x * v[q].x + v[q].y * v[q].y) + (v[q].z * v[q].z + v[q].w * v[q].w); }
            const float rstd = rsqrtf(wave_sum(ss) * (1.f / DM) + EPS);
#pragma unroll
            for (int q = 0; q < 4; ++q) ((f32x4*)(dst + (size_t)r * DM))[F.lane + 64 * q] = v[q] * rstd * fn[q]; }
    }
}

constexpr int NPHASE = 13;
__global__ void __launch_bounds__(512, 2) mega(Params p) {
    extern __shared__ __attribute__((aligned(16))) unsigned char lds_raw[];
    Ctx F;
    F.lds = (LAS unsigned char*)lds_raw; F.tid = threadIdx.x; F.lane = F.tid & 63; F.wave = __builtin_amdgcn_readfirstlane(F.tid >> 6); F.bid = blockIdx.x; F.G = gridDim.x;
    F.in = p.in; F.out = (float*)(GAS float*)p.out; F.ws = (unsigned char*)(GAS unsigned char*)p.ws;
    const int lo = p.ph_lo, hi = p.ph_hi;
#ifndef PH_MASK
#define PH_MASK 0x1fff
#endif
#define IN(k) (((PH_MASK >> (k)) & 1) && lo <= (k) && (k) < hi)
#ifndef PH_REP
#define PH_REP 0
#endif
#ifndef XBAR_EXTRA
#define XBAR_EXTRA 0
#endif
#define REPS(k) (1 + ((PH_REP >> (k)) & 1))
#define RUN(k, ...) do { if (IN(k)) { if (REPS(k) > 1) { const int _rep = 0; __VA_ARGS__; __syncthreads(); } { const int _rep = REPS(k) - 1; __VA_ARGS__; } } } while (0)
#define RUN1(k, ...) do { if (IN(k)) { __VA_ARGS__; } } while (0)
#if MK_FUSED
    volatile LAS unsigned* bst = (volatile LAS unsigned*)(F.lds + LDS_BYTES - 64);
    if (F.tid < 16) bst[F.tid] = 0u;
    __syncthreads();
    XcdBarrier bar = xcd_barrier_post((unsigned*)(F.ws + WS_CTL) + CW_BAR, bst);
#define SEAM(k) do { if (IN(k) && IN((k) + 1)) { xcd_barrier(bar); } } while (0)
#else
#define SEAM(k) do { } while (0)
#endif
    RUN(0, ph_prologue(F)); SEAM(0);
    RUN(1, ph_norm1(F)); SEAM(1);
#if MK_FUSED
    for (int _x = 0; _x < XBAR_EXTRA; ++_x) xcd_barrier(bar);
#endif
    RUN1(2, {
        constexpr int NSETS = (NEXP * 8 * 64 + NEXP * 8 * 32) / 8, NTILE = (TT / 256) * (NP / 256), CPT = 4;
        const int c_hi = NTILE % F.G == 0 ? F.G : NTILE % F.G;
        const int n_lo = (NSETS - CPT * (F.G - c_hi) + F.G - 1) / F.G < 0 ? 0 : (NSETS - CPT * (F.G - c_hi) + F.G - 1) / F.G, n_hi = n_lo + CPT;
        const int grp = (F.bid >> 3) & 7, cut = __builtin_amdgcn_readfirstlane(grp == 7 ? (1 << 20) : grp);
        _Pragma("unroll 1") for (int part = 0; part < 2; ++part) {
            if (part) { __syncthreads(); expert_weight_copies(F, c_hi, n_lo, n_hi); __syncthreads(); }
            const pg8::DenseOrder S{TT / 256, NP / 256, F.G, F.bid, (const char*)(F.ws + WS_WIN), 2048u, 1, part ? cut : 0, part ? (1 << 20) : cut};
            const pg8::EpiBf16 E{(bf16_t*)(F.ws + WS_P), NP, nullptr, 0, 1.0f};
            pg8::gemm_phase<pg8::EpiBf16, pg8::DenseOrder, true>(F.lds, (const bf16_t*)(F.ws + WS_H), S, E);
        }
    }); SEAM(2);
    RUN(3, ph_conv_g(F)); SEAM(3);
#if MK_NAIVE_SCAN
    RUN(4, ph_scan_naive(F)); SEAM(4); SEAM(5);
#else
    RUN(4, ph_scan_a(F)); SEAM(4);
    RUN(5, ph_scan_b(F)); SEAM(5);
    RUN(6, ph_scan_c(F));
#endif
    SEAM(6);
    RUN1(8, {
        pg8::DenseOrder S{TL / 256, DM / 256, F.G, F.bid, (const char*)(F.ws + WS_WOUT), 2048u, REPS(8)};
        pg8::EpiResGate E{GIN(F, IN_X), (bf16_t*)(F.ws + WS_X1), (const float*)(F.ws + WS_MOD)};
        pg8::gemm_phase<pg8::EpiResGate, pg8::DenseOrder, true>(F.lds, (const bf16_t*)(F.ws + WS_Y), S, E);
    }); SEAM(8);
    RUN(9, ph_router(F)); SEAM(9);
#if MK_FUSED
    RUN1(10, {
        LAS int* cn; LAS int* tb; moe_tables(F, cn, tb);
        const int nMt = __builtin_amdgcn_readfirstlane(tb[32]);
        unsigned* sb1 = (unsigned*)(F.ws + WS_CTL) + CW_SB; unsigned* sb2 = sb1 + 2048;
        int a1;
        {   pg8::MoeOrder<true> S{nMt, 8, F.G, F.bid, (const char*)(F.ws + WS_WGU), 2048, tb, cn, (const int*)(F.ws + WS_ROWTOK), 1024u, 0};
            pg8::EpiSwiglu E{(unsigned char*)(F.ws + WS_ACT), GIN(F, IN_BGU), 1.0f / (HSCALE8 * WSCALE8), ASCALE8, (LAS float*)(F.lds + MISC_OFF + 2048)};
            a1 = (S.trips() * 3) / 4; a1 = a1 < 1 ? 1 : a1;
            ArriveSync Y{&bar, sb1, a1, false};
            pg8::gemm_phase<pg8::EpiSwiglu, pg8::MoeOrder<true>, true, true, ArriveSync>(F.lds, (const bf16_t*)(F.ws + WS_H), S, E, &Y);
            if (F.tid == 0) { if (!Y.done) sb_arrive(bar, sb1); sb_arrive(bar, sb2); }
        }
        if (IN(11)) {
            if (F.tid == 0) sb_wait(bar, sb1);
            __syncthreads();
            pg8::MoeOrder<false> S{nMt, 4, F.G, F.bid, (const char*)(F.ws + WS_WD), 1024, tb, cn, nullptr, 1024u, 8};
            pg8::EpiFp8 E{(unsigned char*)(F.ws + WS_YP), DM, GIN(F, IN_BD), 1024, 1.0f / (ASCALE8 * WSCALE8), PSCALE8, (LAS float*)(F.lds + MISC_OFF + 2048)};
            WaitSync<pg8::MoeOrder<false>> Y{&bar, sb2, a1, false, &S, 8};
            pg8::gemm_phase<pg8::EpiFp8, pg8::MoeOrder<false>, true, true, WaitSync<pg8::MoeOrder<false>>>(F.lds, (const bf16_t*)(F.ws + WS_ACT), S, E, &Y);
        }
    }); SEAM(11);
#else
    RUN1(10, {
        LAS int* cn; LAS int* tb; moe_tables(F, cn, tb);
        pg8::MoeOrder<true> S{__builtin_amdgcn_readfirstlane(tb[32]), 8, F.G, F.bid, (const char*)(F.ws + WS_WGU), 2048, tb, cn, (const int*)(F.ws + WS_ROWTOK), 1024u, 0};
        pg8::EpiSwiglu E{(unsigned char*)(F.ws + WS_ACT), GIN(F, IN_BGU), 1.0f / (HSCALE8 * WSCALE8), ASCALE8, (LAS float*)(F.lds + MISC_OFF + 2048)};
        pg8::gemm_phase<pg8::EpiSwiglu, pg8::MoeOrder<true>, true, true>(F.lds, (const bf16_t*)(F.ws + WS_H), S, E);
    });
    RUN1(11, {
        LAS int* cn; LAS int* tb; moe_tables(F, cn, tb);
        pg8::MoeOrder<false> S{__builtin_amdgcn_readfirstlane(tb[32]), 4, F.G, F.bid, (const char*)(F.ws + WS_WD), 1024, tb, cn, nullptr, 1024u, 0};
        pg8::EpiFp8 E{(unsigned char*)(F.ws + WS_YP), DM, GIN(F, IN_BD), 1024, 1.0f / (ASCALE8 * WSCALE8), PSCALE8, (LAS float*)(F.lds + MISC_OFF + 2048)};
        pg8::gemm_phase<pg8::EpiFp8, pg8::MoeOrder<false>, true, true>(F.lds, (const bf16_t*)(F.ws + WS_ACT), S, E);
    });
#endif
    RUN(12, ph_final(F, (_rep + 1 < REPS(12)) ? (float*)(F.ws + WS_ACT) : F.out));
#undef IN
#undef SEAM
#undef RUN
#undef RUN1
}

extern "C" void kernel_launch(void* const* d_in, const int* in_sizes, int n_in, void* d_out, int out_size, void* d_ws, size_t ws_size, hipStream_t stream) {
    static int grid = 0;
    if (grid == 0) {
        if (n_in != 26 || out_size != TL * DM || ws_size < WS_END) { fprintf(stderr, "kernel_launch: unexpected problem (n_in %d, out %d, ws %zu)\n", n_in, out_size, ws_size); grid = -1; return; }
        int dev = 0, cus = 0, per_cu = 0;
        if (hipGetDevice(&dev) != hipSuccess || hipDeviceGetAttribute(&cus, hipDeviceAttributeMultiprocessorCount, dev) != hipSuccess) { grid = -1; return; }
        if (hipFuncSetAttribute((const void*)mega, hipFuncAttributeMaxDynamicSharedMemorySize, LDS_BYTES) != hipSuccess) { fprintf(stderr, "kernel_launch: hipFuncSetAttribute failed\n"); grid = -1; return; }
        if (hipOccupancyMaxActiveBlocksPerMultiprocessor(&per_cu, (const void*)mega, 512, LDS_BYTES) != hipSuccess || per_cu < 1) { fprintf(stderr, "kernel_launch: occupancy query says %d\n", per_cu); per_cu = 1; }
        (void)hipGetLastError();
        grid = cus;
    }
    if (grid < 0) return;
    (void)hipMemsetAsync((char*)d_ws + WS_CTL, 0, CTL_ZERO, stream);
    Params a{};
    for (int i = 0; i < 26; ++i) a.in[i] = (const float*)d_in[i];
    a.out = (float*)d_out; a.ws = (unsigned char*)d_ws;
#if MK_FUSED
    a.ph_lo = 0; a.ph_hi = NPHASE;
    hipLaunchKernelGGL(mega, dim3(grid), dim3(512), LDS_BYTES, stream, a);
#else
    for (int ph = 0; ph < NPHASE; ++ph) {
        a.ph_lo = ph; a.ph_hi = ph + 1;
        hipLaunchKernelGGL(mega, dim3(grid), dim3(512), LDS_BYTES, stream, a);
    }
#endif
}
```

```cpp
#include <hip/hip_runtime.h>
#include <hip/hip_cooperative_groups.h>
#include <cstdio>
#include <cstdint>
namespace cg = cooperative_groups;

#ifndef MK_FUSED
#define MK_FUSED 1
#endif
#ifndef MK_NAIVE_SCAN
#define MK_NAIVE_SCAN 0
#endif

#define LAS __attribute__((address_space(3)))
#define GAS __attribute__((address_space(1)))
typedef unsigned short bf16_t;
typedef short bf16x8 __attribute__((ext_vector_type(8)));
typedef float f32x4 __attribute__((ext_vector_type(4)));
typedef float f32x2 __attribute__((ext_vector_type(2)));
typedef unsigned u32x4 __attribute__((ext_vector_type(4)));
typedef unsigned u32x2 __attribute__((ext_vector_type(2)));

constexpr int NB = 4, SEQ = 8192, CTXL = 256, DM = 1024;
constexpr int TL = NB * SEQ;
constexpr int TCX = NB * CTXL;
constexpr int TT = TL + TCX;
constexpr int NP = 3328;
constexpr int CQ = 0, CK = 256, CV = 512, CG = 1024, CZ = 1536, CX = 2048, CGK = 3072, CDT = 3088;
constexpr int NEXP = 32, DFF = 1024;
constexpr float EPS = 1e-6f;
constexpr int MAXTILES = 544;
constexpr int ZROW = TL;

constexpr size_t MiB = 1u << 20;
constexpr size_t WS_CTL = 0, CTL_BYTES = 1 * MiB;
constexpr size_t WS_MOD = 1 * MiB;
constexpr size_t WS_WIN = 2 * MiB;
constexpr size_t WS_WOUT = 9 * MiB;
constexpr size_t WS_WGU = 11 * MiB;
constexpr size_t WS_WD = 139 * MiB;
constexpr size_t WS_TOKE = 203 * MiB;
constexpr size_t WS_TOKP = WS_TOKE + 512 * 1024;
constexpr size_t WS_TOKG = WS_TOKP + 512 * 1024;
constexpr size_t WS_ROWTOK = 205 * MiB;
constexpr size_t WS_H = 209 * MiB;
constexpr size_t WS_P = 276 * MiB;
constexpr size_t WS_XBC = 491 * MiB;
constexpr size_t WS_G = 557 * MiB;
constexpr size_t WS_OG = 623 * MiB;
constexpr size_t WS_OS = 687 * MiB;
constexpr size_t WS_Y = 751 * MiB;
constexpr size_t WS_ACT = 276 * MiB;
constexpr size_t WS_YP = 548 * MiB;
constexpr size_t WS_USG = 820 * MiB;
constexpr size_t WS_SSG = 837 * MiB;
constexpr size_t WS_USS = 853 * MiB;
constexpr size_t WS_SSS = 887 * MiB;
constexpr size_t WS_ASG = 919 * MiB;
constexpr size_t WS_ASS = 920 * MiB;
constexpr size_t WS_X1 = WS_OS;
constexpr size_t WS_END = 921 * MiB;
static_assert(WS_YP + (size_t)MAXTILES * 256 * 1024 <= WS_X1, "x1 buffer clear of the fp8 Yp overlay");
static_assert(WS_P + (size_t)TT * NP * 2 <= WS_XBC && WS_XBC + (size_t)TT * 1024 * 2 <= WS_G && WS_G + (size_t)2 * TT * 256 * 4 <= WS_OG, "ws map");
static_assert(WS_ACT + (size_t)MAXTILES * 256 * 2048 <= WS_YP && WS_YP + (size_t)MAXTILES * 256 * 2048 <= WS_END, "ws map 2");
static_assert(WS_H + (size_t)(TT + 256) * 2048 <= WS_P, "ws map 3");
constexpr int CW_CNT = 1024;
constexpr int CW_BAR = 8192;
constexpr int CW_SB = 12288;
constexpr size_t CTL_ZERO = 65536;
static_assert((CW_BAR + 3456) <= CW_SB && (CW_SB + 4096) * 4 <= (int)CTL_ZERO && (CW_CNT + 64 * 32) * 4 <= (int)CTL_ZERO, "control words inside the per-call memset");

constexpr int RING_BYTES = 131072;
constexpr int MISC_OFF = 132096;
constexpr int LDS_BYTES = 147456;

struct Params { const float* in[26]; float* out; unsigned char* ws; int ph_lo, ph_hi; };

__device__ __forceinline__ unsigned f2bf(float f) { unsigned u = __builtin_bit_cast(unsigned, f); return (u + 0x7fffu + ((u >> 16) & 1u)) >> 16; }
typedef __bf16 bf16x2_t __attribute__((ext_vector_type(2)));
__device__ __forceinline__ unsigned pk2(float lo, float hi) { const f32x2 v = {lo, hi}; const bf16x2_t b = __builtin_convertvector(v, bf16x2_t); return __builtin_bit_cast(unsigned, b); }
__device__ __forceinline__ unsigned pk2(float lo, float hi);
__device__ __forceinline__ float bflo(unsigned w);
__device__ __forceinline__ float bfhi(unsigned w);
__device__ __forceinline__ f32x4 ld_bf4(const bf16_t* p) { const u32x2 w = *(const u32x2*)p; return (f32x4){bflo(w.x), bfhi(w.x), bflo(w.y), bfhi(w.y)}; }
__device__ __forceinline__ void st_bf4(bf16_t* p, f32x4 v) { u32x2 w; w.x = pk2(v.x, v.y); w.y = pk2(v.z, v.w); *(u32x2*)p = w; }
__device__ __forceinline__ float bf2f(unsigned short h) { return __builtin_bit_cast(float, (unsigned)h << 16); }
__device__ __forceinline__ float bflo(unsigned w) { return __builtin_bit_cast(float, w << 16); }
__device__ __forceinline__ float bfhi(unsigned w) { return __builtin_bit_cast(float, w & 0xffff0000u); }
__device__ __forceinline__ float wave_sum(float v) {
#pragma unroll
    for (int o = 1; o < 64; o <<= 1) v += __shfl_xor(v, o);
    return v;
}
__device__ __forceinline__ float silu_f(float v) { return v * __builtin_amdgcn_rcpf(1.f + __builtin_amdgcn_exp2f(-1.4426950408889634f * v)); }
__device__ __forceinline__ float sigmoid_f(float v) { return 1.f / (1.f + __expf(-v)); }
__device__ __forceinline__ float softplus_f(float v) { return fmaxf(v, 0.f) + log1pf(__expf(-fabsf(v))); }
__device__ __forceinline__ float logsigmoid_f(float v) { return fminf(v, 0.f) - log1pf(__expf(-fabsf(v))); }
#define LDS_WAIT() asm volatile("s_waitcnt lgkmcnt(0)" ::: "memory")
#define LBAR() asm volatile("s_waitcnt lgkmcnt(0)\n\ts_barrier" ::: "memory")

namespace pg8 {
constexpr int BM = 256, BK = 64, HALF = 128, HTB = HALF * BK * 2, STAGE_BYTES = 8 * HTB, NXCD = 8, WGM = 8;
constexpr int KD = 1024;
typedef int i32x4 __attribute__((ext_vector_type(4)));
typedef int i32x8 __attribute__((ext_vector_type(8)));
#ifndef PG8_XORSWZ
#define PG8_XORSWZ 1
#endif
#if PG8_XORSWZ
__host__ __device__ __forceinline__ int lds_byte(int r, int c) { return r * 128 + ((((c >> 3) ^ (r >> 1)) & 7) << 4) + (c & 7) * 2; }
__host__ __device__ __forceinline__ void stage_rc(int b, int& R, int& C) { R = b >> 7; C = ((((b >> 4) ^ (R >> 1)) & 7) << 3); }
#else
__host__ __device__ __forceinline__ int lds_byte(int r, int c) { const int st = (r >> 4) * 2 + (c >> 5), rr = r & 15, cc = c & 31, ob = rr * 64 + cc * 2; return st * 1024 + (ob ^ (((ob >> 9) & 1) << 5)); }
__host__ __device__ __forceinline__ void stage_rc(int b, int& R, int& C) { const int st = b / 1024, sb = b % 1024, swz = sb ^ (((sb >> 9) & 1) << 5); R = (st >> 1) * 16 + swz / 64; C = (st & 1) * 32 + (swz % 64) / 2; }
#endif
__host__ __device__ __forceinline__ int perm32(int rho) { const int n = rho >> 4, i = rho & 15; return 8 * (i >> 2) + 4 * n + (i & 3); }

struct Unit { int pm, pn, e, mt; };

__device__ __forceinline__ void tile_of(int L, int nM, int nN, int& pm, int& pn) {
    const int nwg = nM * nN; int wgid = L;
    { const int q = nwg / NXCD, r = nwg % NXCD, xcd = wgid % NXCD, off = wgid / NXCD; wgid = (xcd < r ? xcd * (q + 1) : r * (q + 1) + (xcd - r) * q) + off; }
    const int nig = WGM * nN, gid = wgid / nig, fm = gid * WGM, gsz = (nM - fm) < WGM ? (nM - fm) : WGM;
    pm = fm + ((wgid % nig) % gsz); pn = (wgid % nig) / gsz;
}
struct DenseOrder {
    static constexpr bool GATHER = false;
    int nM, nN, G, c; const char* Bt; unsigned rowb; int dup; int i0 = 0, i1 = 1 << 20;
    __device__ __forceinline__ bool next(int i, Unit& u) const { i += i0; const long L = (long)i * G + c; if (i >= i1 || L >= (long)nM * nN * dup) return false; tile_of((int)L, nM, nN * dup, u.pm, u.pn); u.pn %= nN; u.e = 0; u.mt = u.pm; return true; }
    __device__ __forceinline__ const char* bbase(const Unit& u) const { return Bt + (size_t)u.pn * BM * rowb; }
    __device__ __forceinline__ unsigned arow(const Unit& u, int rl) const { return 0u; }
};
template <bool GATHER_> struct MoeOrder {
    static constexpr bool GATHER = GATHER_;
    int nMt, nN, G, c; const char* Bt; int brows; const LAS int* tb; const LAS int* cn; const int* rowtok; unsigned rowb; int rot;
    __device__ __forceinline__ void chunk(int& nxc, int& rank, int& m0, int& nMx) const {
        const int NC = G < NXCD ? G : NXCD, x = c % NC; nxc = (G - x + NC - 1) / NC; rank = c / NC;
        const int qm = nMt / NC, rm = nMt % NC; nMx = qm + (x < rm ? 1 : 0); m0 = x * qm + (x < rm ? x : rm);
    }
    __device__ __forceinline__ int trips() const { int nxc, rank, m0, nMx; chunk(nxc, rank, m0, nMx); return (nMx * nN + nxc - 1) / nxc; }
    __device__ __forceinline__ bool next(int i, Unit& u) const {
        int nxc, rank, m0, nMx; chunk(nxc, rank, m0, nMx);
        rank = (rank + nxc - (nMx * rot) % nxc) % nxc;
        const int off = i * nxc + rank; if (off >= nMx * nN) return false;
        const int nig = WGM * nN, gid = off / nig, fm = gid * WGM, gsz = (nMx - fm) < WGM ? (nMx - fm) : WGM;
        u.pm = m0 + fm + ((off % nig) % gsz); u.pn = (off % nig) / gsz;
        int e = 0;
#pragma unroll
        for (int q = 1; q < NEXP; ++q) e += (tb[q] <= u.pm) ? 1 : 0;
        e = __builtin_amdgcn_readfirstlane(e); u.e = e; u.mt = u.pm - __builtin_amdgcn_readfirstlane(tb[e]); return true;
    }
    __device__ __forceinline__ int last_trip_of(int pm, int nNp) const {
        int nxc, rank, m0, nMx; chunk(nxc, rank, m0, nMx);
        const int loc = pm - m0, gid = loc / WGM, fm = gid * WGM, gsz = (nMx - fm) < WGM ? (nMx - fm) : WGM;
        return (gid * (WGM * nNp) + (nNp - 1) * gsz + (loc - fm)) / nxc;
    }
    __device__ __forceinline__ const char* bbase(const Unit& u) const { return Bt + (size_t)(u.e * brows + u.pn * BM) * rowb; }
    __device__ __forceinline__ unsigned arow(const Unit& u, int rl) const {
        const int pos = u.mt * BM + rl; const int lim = __builtin_amdgcn_readfirstlane(cn[u.e]); int tok = ZROW; if (pos < lim) tok = rowtok[u.e * TL + pos]; return (unsigned)tok;
    }
};
struct NoSync { static constexpr bool ARRIVE = false, WAIT = false; };

__device__ __forceinline__ unsigned cvt_pk_bf16(float lo, float hi) { unsigned r; asm volatile("v_cvt_pk_bf16_f32 %0, %1, %2" : "=v"(r) : "v"(lo), "v"(hi)); return r; }

struct EpiBf16 {
    static constexpr bool PERM = true, LDSBIAS = false;
    bf16_t* O; int ldc; const float* bias; int bstride; float scale;
    __device__ __forceinline__ void operator()(const f32x4 (&acc)[2][2][4][2], const Unit& u, int wr, int wc, int fr, int fq) const {
        const int row0 = u.pm * BM + wr * 64 + fr; const int col0 = u.pn * BM + wc * 32 + 8 * fq;
        f32x4 bv[2][2];
#pragma unroll
        for (int bj = 0; bj < 2; ++bj)
#pragma unroll
            for (int n = 0; n < 2; ++n) bv[bj][n] = bias ? *(const f32x4*)(bias + (size_t)u.e * bstride + col0 + bj * HALF + 4 * n) : (f32x4){0.f, 0.f, 0.f, 0.f};
#pragma unroll
        for (int ai = 0; ai < 2; ++ai)
#pragma unroll
            for (int m = 0; m < 4; ++m) { bf16_t* rowp = O + (size_t)(row0 + ai * HALF + m * 16) * ldc + col0;
#pragma unroll
                for (int bj = 0; bj < 2; ++bj) { const f32x4 v0 = acc[ai][bj][m][0] * scale + bv[bj][0], v1 = acc[ai][bj][m][1] * scale + bv[bj][1];
                    u32x4 w; w.x = cvt_pk_bf16(v0[0], v0[1]); w.y = cvt_pk_bf16(v0[2], v0[3]); w.z = cvt_pk_bf16(v1[0], v1[1]); w.w = cvt_pk_bf16(v1[2], v1[3]);
                    *(u32x4*)(rowp + bj * HALF) = w; } }
    }
};
__device__ __forceinline__ float clamp448(float v) { return __builtin_amdgcn_fmed3f(v, -448.f, 448.f); }
__device__ __forceinline__ unsigned pk4_fp8(float a, float b, float c, float d) {
    int w = 0; w = __builtin_amdgcn_cvt_pk_fp8_f32(clamp448(a), clamp448(b), w, false); w = __builtin_amdgcn_cvt_pk_fp8_f32(clamp448(c), clamp448(d), w, true); return (unsigned)w; }
__device__ __forceinline__ unsigned pk4_fp8_nc(float a, float b, float c, float d) {
    int w = 0; w = __builtin_amdgcn_cvt_pk_fp8_f32(a, b, w, false); w = __builtin_amdgcn_cvt_pk_fp8_f32(c, d, w, true); return (unsigned)w; }
struct EpiFp8 {
    static constexpr bool PERM = true;
    static constexpr bool LDSBIAS = true;
    unsigned char* O; int ldc; const float* bias; int bstride; float scale, oscale; LAS float* biasl;
    __device__ __forceinline__ const char* bias_src(const Unit& u, int lane) const { return (const char*)(bias + (size_t)u.e * bstride + u.pn * BM) + (unsigned)(16 * lane); }
    __device__ __forceinline__ void operator()(const f32x4 (&acc)[2][2][4][2], const Unit& u, int wr, int wc, int fr, int fq) const {
        const int row0 = u.pm * BM + wr * 64 + fr; const int col0 = u.pn * BM + wc * 32 + 8 * fq;
        f32x4 bv[2][2];
#pragma unroll
        for (int bj = 0; bj < 2; ++bj)
#pragma unroll
            for (int n = 0; n < 2; ++n) bv[bj][n] = *(const LAS f32x4*)(biasl + wc * 32 + 8 * fq + bj * HALF + 4 * n) * oscale;
        const float so = scale * oscale;
#pragma unroll
        for (int ai = 0; ai < 2; ++ai)
#pragma unroll
            for (int m = 0; m < 4; ++m) { unsigned char* rowp = O + (size_t)(row0 + ai * HALF + m * 16) * ldc + col0;
#pragma unroll
                for (int bj = 0; bj < 2; ++bj) { const f32x4 v0 = acc[ai][bj][m][0] * so + bv[bj][0], v1 = acc[ai][bj][m][1] * so + bv[bj][1];
                    u32x2 w; w.x = pk4_fp8(v0[0], v0[1], v0[2], v0[3]); w.y = pk4_fp8(v1[0], v1[1], v1[2], v1[3]);
                    *(u32x2*)(rowp + bj * HALF) = w; } }
    }
};
struct EpiSwiglu {
    static constexpr bool PERM = true;
    static constexpr bool LDSBIAS = true;
    unsigned char* O; const float* bias; float scale, oscale; LAS float* biasl;
    __device__ __forceinline__ const char* bias_src(const Unit& u, int lane) const { return (const char*)(bias + (size_t)u.e * 2048 + u.pn * HALF) + (unsigned)((lane >> 5) * 4096 + 16 * (lane & 31)); }
    __device__ __forceinline__ void operator()(const f32x4 (&acc)[2][2][4][2], const Unit& u, int wr, int wc, int fr, int fq) const {
        const int row0 = u.pm * BM + wr * 64 + fr; const int ff0 = u.pn * HALF + wc * 32 + 8 * fq;
        f32x4 bg[2], bu[2];
#pragma unroll
        for (int n = 0; n < 2; ++n) { bg[n] = *(const LAS f32x4*)(biasl + wc * 32 + 8 * fq + 4 * n); bu[n] = *(const LAS f32x4*)(biasl + HALF + wc * 32 + 8 * fq + 4 * n); }
        const f32x4 os4 = (f32x4){oscale, oscale, oscale, oscale};
#pragma unroll
        for (int ai = 0; ai < 2; ++ai)
#pragma unroll
            for (int m = 0; m < 4; ++m) { unsigned char* rowp = O + (size_t)(row0 + ai * HALF + m * 16) * DFF + ff0;
                float r[8];
#pragma unroll
                for (int n = 0; n < 2; ++n) {
                    f32x4 g = acc[ai][0][m][n] * scale + bg[n]; f32x4 up = acc[ai][1][m][n] * scale + bu[n];
                    g.x = fminf(g.x, 7.f); g.y = fminf(g.y, 7.f); g.z = fminf(g.z, 7.f); g.w = fminf(g.w, 7.f);
                    up.x = __builtin_amdgcn_fmed3f(up.x, -7.f, 7.f); up.y = __builtin_amdgcn_fmed3f(up.y, -7.f, 7.f); up.z = __builtin_amdgcn_fmed3f(up.z, -7.f, 7.f); up.w = __builtin_amdgcn_fmed3f(up.w, -7.f, 7.f);
                    const f32x4 tz = g * -2.4554669595930157f;
                    f32x4 d; d.x = __builtin_amdgcn_exp2f(tz.x); d.y = __builtin_amdgcn_exp2f(tz.y); d.z = __builtin_amdgcn_exp2f(tz.z); d.w = __builtin_amdgcn_exp2f(tz.w);
                    d = d + 1.0f;
                    f32x4 rc; rc.x = __builtin_amdgcn_rcpf(d.x); rc.y = __builtin_amdgcn_rcpf(d.y); rc.z = __builtin_amdgcn_rcpf(d.z); rc.w = __builtin_amdgcn_rcpf(d.w);
                    const f32x4 o = (up * os4 + os4) * (g * rc);
                    r[4 * n] = o.x; r[4 * n + 1] = o.y; r[4 * n + 2] = o.z; r[4 * n + 3] = o.w; }
                u32x2 w; w.x = pk4_fp8_nc(r[0], r[1], r[2], r[3]); w.y = pk4_fp8_nc(r[4], r[5], r[6], r[7]);
                *(u32x2*)rowp = w; }
    }
};
struct EpiResGate {
    static constexpr bool PERM = false, LDSBIAS = false;
    const float* x; bf16_t* out; const float* mod;
    __device__ __forceinline__ void operator()(const f32x4 (&acc)[2][2][4][2], const Unit& u, int wr, int wc, int fr, int fq) const {
        const int row0 = u.pm * BM + wr * 64 + fr, col0 = u.pn * BM + wc * 32 + 4 * fq;
        const float* g1 = mod + (size_t)((u.pm * BM) >> 13) * 6144 + 2048;
        f32x4 gv[2][2];
#pragma unroll
        for (int bj = 0; bj < 2; ++bj)
#pragma unroll
            for (int n = 0; n < 2; ++n) gv[bj][n] = *(const f32x4*)(g1 + col0 + bj * HALF + n * 16);
#pragma unroll
        for (int ai = 0; ai < 2; ++ai)
#pragma unroll
            for (int m = 0; m < 4; ++m) { const size_t off = (size_t)(row0 + ai * HALF + m * 16) * DM + col0;
#pragma unroll
                for (int bj = 0; bj < 2; ++bj)
#pragma unroll
                    for (int n = 0; n < 2; ++n) { const f32x4 xv = *(const f32x4*)(x + off + bj * HALF + n * 16);
                        const f32x4 o = xv + gv[bj][n] * acc[ai][bj][m][n]; u32x2 w; w.x = cvt_pk_bf16(o[0], o[1]); w.y = cvt_pk_bf16(o[2], o[3]);
                        *(u32x2*)(out + off + bj * HALF + n * 16) = w; } }
    }
};

template <class Epi, class Sched, bool ALIGN_EPI, bool FP8 = false, class Sync = NoSync>
__device__ __forceinline__ void gemm_phase(LAS unsigned char* lds, const bf16_t* Aglob, const Sched& S, const Epi& E, Sync* Y = nullptr) {
    const int tid = threadIdx.x, wid = __builtin_amdgcn_readfirstlane(tid >> 6), lane = tid & 63, wr = wid >> 2, wc = wid & 3, fr = lane & 15, fq = lane >> 4;
    constexpr int nt = FP8 ? KD / (2 * BK) : KD / BK;
    constexpr unsigned ROWB = FP8 ? KD : KD * 2; constexpr int RSH = FP8 ? 10 : 11;
    unsigned voffA[2], voffB[2];
#pragma unroll
    for (int i = 0; i < 2; ++i) { int R, C; stage_rc(tid * 16 + i * 8192, R, C); const int Rb = Epi::PERM ? ((R & ~31) + perm32(R & 31)) : R;
        voffA[i] = (unsigned)R * ROWB + (unsigned)C * 2u; voffB[i] = (unsigned)Rb * ROWB + (unsigned)C * 2u; }
    constexpr size_t kstep = (size_t)(BK * 2);
    constexpr size_t hstep = (size_t)HALF * ROWB;
    constexpr size_t tstep = 2 * hstep;
    const unsigned ldsw = (unsigned)wid * 1024u;
    const int aoff = lds_byte(wr * 64 + fr, fq * 8), boff = lds_byte(wc * 32 + fr, fq * 8);
    const int aoff1 = lds_byte(wr * 64 + fr, 32 + fq * 8), boff1 = lds_byte(wc * 32 + fr, 32 + fq * 8);
    const char* Ab = (const char*)Aglob;
#define PG8_SA(b, h) (((b) * 2 + (h)) * HTB)
#define PG8_SB(b, h) ((4 + (b) * 2 + (h)) * HTB)
#define PG8_STAGE_B(bufoff, gbase) do { _Pragma("unroll") for (int _i = 0; _i < 2; ++_i) \
        __builtin_amdgcn_global_load_lds((const unsigned*)((const char*)(gbase) + voffB[_i]), (LAS unsigned*)(lds + (bufoff) + ldsw + _i * 8192), 16, 0, 0); } while (0)
#define PG8_STAGE_A(bufoff, pa, tk, h, kb) do { _Pragma("unroll") for (int _i = 0; _i < 2; ++_i) { \
        const char* _src = Sched::GATHER ? (Ab + (kb) + (size_t)((((tk)[_i] >> (16 * (h))) & 0xffffu) * ROWB + (voffA[_i] & 127u))) : ((pa) + (size_t)(h) * hstep + (kb) + voffA[_i]); \
        __builtin_amdgcn_global_load_lds((const unsigned*)_src, (LAS unsigned*)(lds + (bufoff) + ldsw + _i * 8192), 16, 0, 0); } } while (0)
#define PG8_LD8(p0, p1) __builtin_shufflevector(*(const LAS i32x4*)(p0), *(const LAS i32x4*)(p1), 0, 1, 2, 3, 4, 5, 6, 7)
#define PG8_LDA(dst, b, h) do { _Pragma("unroll") for (int m = 0; m < 4; ++m) dst[m] = PG8_LD8(lds + PG8_SA(b, h) + aoff + m * 2048, lds + PG8_SA(b, h) + aoff1 + m * 2048); } while (0)
#define PG8_LDB(dst, b, h) do { _Pragma("unroll") for (int n = 0; n < 2; ++n) dst[n] = PG8_LD8(lds + PG8_SB(b, h) + boff + n * 2048, lds + PG8_SB(b, h) + boff1 + n * 2048); } while (0)
#define PG8_LO(x) __builtin_bit_cast(bf16x8, __builtin_shufflevector(x, x, 0, 1, 2, 3))
#define PG8_HI(x) __builtin_bit_cast(bf16x8, __builtin_shufflevector(x, x, 4, 5, 6, 7))
#define PG8_MMA(ai, bj, At, Bt) do { __builtin_amdgcn_s_setprio(1); _Pragma("unroll") for (int m = 0; m < 4; ++m) _Pragma("unroll") for (int n = 0; n < 2; ++n) { \
        if constexpr (FP8) asm volatile("v_mfma_scale_f32_16x16x128_f8f6f4 %0, %1, %2, %0, %3, %3 op_sel_hi:[0,0,0]" : "+v"(acc[ai][bj][m][n]) : "v"(Bt[n]), "v"(At[m]), "v"(sc127)); \
        else { acc[ai][bj][m][n] = __builtin_amdgcn_mfma_f32_16x16x32_bf16(PG8_LO(Bt[n]), PG8_LO(At[m]), acc[ai][bj][m][n], 0, 0, 0); \
               acc[ai][bj][m][n] = __builtin_amdgcn_mfma_f32_16x16x32_bf16(PG8_HI(Bt[n]), PG8_HI(At[m]), acc[ai][bj][m][n], 0, 0, 0); } } \
        __builtin_amdgcn_s_setprio(0); } while (0)
#define PG8_WAIT_V(n) asm volatile("s_waitcnt vmcnt(" #n ")" ::: "memory")
#define PG8_WAIT_L(n) asm volatile("s_waitcnt lgkmcnt(" #n ")" ::: "memory")
#define PG8_BAR __builtin_amdgcn_s_barrier()
#define PG8_SCHED __builtin_amdgcn_sched_barrier(0)
#define PG8_TOKS(dst, u) do { if constexpr (Sched::GATHER) { _Pragma("unroll") for (int _i = 0; _i < 2; ++_i) { const int _R = (int)(voffA[_i] >> RSH); \
        dst[_i] = S.arow(u, _R) | (S.arow(u, HALF + _R) << 16); } } } while (0)
    Unit cur, nxt; int ui = 0;
    if (!S.next(0, cur)) return;
    if constexpr (Sync::WAIT) { if (!Y->done && Y->need(cur)) { if (tid == 0) Y->wait(); __builtin_amdgcn_s_barrier(); Y->done = true; } }
    unsigned sc127 = 0u; if constexpr (FP8) asm volatile("v_mov_b32 %0, 0x7f7f7f7f" : "=v"(sc127));
    f32x4 acc[2][2][4][2];
#pragma unroll
    for (int a = 0; a < 2; ++a)
#pragma unroll
        for (int b = 0; b < 2; ++b)
#pragma unroll
            for (int m = 0; m < 4; ++m)
#pragma unroll
                for (int n = 0; n < 2; ++n) acc[a][b][m][n] = (f32x4){0.f, 0.f, 0.f, 0.f};
    i32x8 At[4], B0[2], B1[2];
    unsigned tokC[2] = {0u, 0u}, tokN[2] = {0u, 0u};
    PG8_TOKS(tokC, cur);
    const char* cA = Ab + (size_t)cur.pm * tstep;
    const char* cB = S.bbase(cur);
    PG8_STAGE_B(PG8_SB(0, 0), cB); PG8_STAGE_B(PG8_SB(0, 1), cB + hstep); PG8_STAGE_A(PG8_SA(0, 0), cA, tokC, 0, 0); PG8_STAGE_A(PG8_SA(0, 1), cA, tokC, 1, 0);
    if (wr == 1) PG8_BAR;
    PG8_WAIT_V(2); PG8_BAR;
    PG8_STAGE_B(PG8_SB(1, 0), cB + kstep); PG8_STAGE_A(PG8_SA(1, 0), cA, tokC, 0, kstep); PG8_STAGE_B(PG8_SB(1, 1), cB + hstep + kstep);
    PG8_WAIT_V(6); PG8_BAR;
    for (;;) {
        const bool has_next = S.next(ui + 1, nxt);
        if constexpr (Sync::WAIT) { if (has_next && !Y->done && Y->need(nxt)) { if (tid == 0) Y->wait(); PG8_BAR; Y->done = true; } }
        const char* nA = has_next ? Ab + (size_t)nxt.pm * tstep : cA; const char* nB = has_next ? S.bbase(nxt) : cB;
#pragma unroll 1
        for (int t = 0; t < nt; t += 2) {
            const bool last = (t == nt - 2);
            if constexpr (Epi::LDSBIAS) { if (last && wid == 0) __builtin_amdgcn_global_load_lds((const unsigned*)E.bias_src(cur, lane), (LAS unsigned*)E.biasl, 16, 0, 0); }
            if (last) { if (has_next) { PG8_TOKS(tokN, nxt); } else { tokN[0] = tokC[0]; tokN[1] = tokC[1]; } }
            const size_t k1 = (size_t)(t + 1) * kstep;
            const size_t k2 = last ? 0 : (size_t)(t + 2) * kstep, k3 = k2 + kstep;
            const char* a2 = last ? nA : cA;
            const char* b2 = last ? nB : cB + (size_t)(t + 2) * kstep; const char* b3 = b2 + kstep;
            PG8_LDB(B0, 0, 0); PG8_LDB(B1, 0, 1); PG8_SCHED; PG8_LDA(At, 0, 0); PG8_STAGE_A(PG8_SA(1, 1), cA, tokC, 1, k1);
            PG8_WAIT_V(8); PG8_WAIT_L(0); PG8_BAR; PG8_MMA(0, 0, At, B0); PG8_MMA(0, 1, At, B1); PG8_BAR; PG8_SCHED;
            if (last) { tokC[0] = tokN[0]; tokC[1] = tokN[1]; }
            PG8_LDA(At, 0, 1); PG8_STAGE_B(PG8_SB(0, 0), b2); PG8_STAGE_B(PG8_SB(0, 1), b2 + hstep); PG8_STAGE_A(PG8_SA(0, 0), a2, tokC, 0, k2);
            PG8_WAIT_V(8); PG8_WAIT_L(0); PG8_BAR; PG8_MMA(1, 0, At, B0); PG8_MMA(1, 1, At, B1); PG8_BAR; PG8_SCHED;
            PG8_LDB(B0, 1, 0); PG8_LDB(B1, 1, 1); PG8_SCHED; PG8_LDA(At, 1, 0); PG8_STAGE_A(PG8_SA(0, 1), a2, tokC, 1, k2);
            PG8_WAIT_V(8); PG8_WAIT_L(0); PG8_BAR; PG8_MMA(0, 0, At, B0); PG8_MMA(0, 1, At, B1); PG8_BAR; PG8_SCHED;
            PG8_LDA(At, 1, 1); PG8_STAGE_B(PG8_SB(1, 0), b3); PG8_STAGE_B(PG8_SB(1, 1), b3 + hstep); PG8_STAGE_A(PG8_SA(1, 0), a2, tokC, 0, k3);
            PG8_WAIT_V(8); PG8_WAIT_L(0); PG8_BAR; PG8_MMA(1, 0, At, B0); PG8_MMA(1, 1, At, B1); PG8_BAR; PG8_SCHED;
        }
        if constexpr (ALIGN_EPI) { if (wr == 0) PG8_BAR; }
        if constexpr (Sync::ARRIVE) { static_assert(ALIGN_EPI, "aligned epilogue"); if (ui == Y->a1) { PG8_WAIT_V(0); PG8_BAR; if (tid == 0) Y->arrive(); Y->done = true; } }
        if constexpr (FP8) asm volatile("s_nop 15\n\ts_nop 15" ::: "memory");
        E(acc, cur, wr, wc, fr, fq);
        if (!has_next) break;
#pragma unroll
        for (int a = 0; a < 2; ++a)
#pragma unroll
            for (int b = 0; b < 2; ++b)
#pragma unroll
                for (int m = 0; m < 4; ++m)
#pragma unroll
                    for (int n = 0; n < 2; ++n) acc[a][b][m][n] = (f32x4){0.f, 0.f, 0.f, 0.f};
        cur = nxt; cA = nA; cB = nB; ++ui;
        if constexpr (ALIGN_EPI) { if (wr == 1) PG8_BAR; }
    }
    PG8_WAIT_V(0);
    if constexpr (!ALIGN_EPI) { if (wr == 0) PG8_BAR; }
    PG8_BAR;
#undef PG8_SA
#undef PG8_SB
#undef PG8_STAGE_A
#undef PG8_STAGE_B
#undef PG8_LDA
#undef PG8_LDB
#undef PG8_MMA
#undef PG8_LD8
#undef PG8_LO
#undef PG8_HI
#undef PG8_WAIT_V
#undef PG8_WAIT_L
#undef PG8_BAR
#undef PG8_SCHED
#undef PG8_TOKS
}
}

#define XB_TMO      128
#define XB_XCNT(j)  (256  + 64 * (j))
#define XB_XSUB(j)  (1280 + 64 * (j))
#define XB_XGEN(j)  (2304 + 64 * (j))
#define XB_TOP      3328
#define XB_TOPGEN   3392
#define XCD_BAR_WORDS 3456
#define XB_SPIN_CAP (1u << 18)

__device__ __forceinline__ unsigned xb_ld(unsigned* p)              { return __hip_atomic_load(p, __ATOMIC_RELAXED, __HIP_MEMORY_SCOPE_AGENT); }
__device__ __forceinline__ unsigned xb_add(unsigned* p, unsigned v) { return __hip_atomic_fetch_add(p, v, __ATOMIC_RELAXED, __HIP_MEMORY_SCOPE_AGENT); }
__device__ __forceinline__ unsigned xb_xcc_id() { return (unsigned)__builtin_amdgcn_s_getreg((3 << 11) | 20) & 0xFu; }
#define XB_SPIN(cond, bar) do { unsigned _sp = 0; while (cond) { __builtin_amdgcn_s_sleep(1); \
    if ((++_sp & 255u) == 0u) { if (xb_ld(&(bar)[XB_TMO])) break; if (_sp > XB_SPIN_CAP) { atomicAdd(&(bar)[XB_TMO], 1u); break; } } } } while (0)

struct XcdBarrier {
    unsigned* bar; unsigned x;
    volatile LAS unsigned* st;
};

__device__ __forceinline__ XcdBarrier xcd_barrier_post(unsigned* bar, volatile LAS unsigned* st) {
    XcdBarrier b; b.bar = bar; b.x = xb_xcc_id(); b.st = st;
    if (threadIdx.x == 0) (void)xb_add(&bar[XB_XCNT(b.x)], 1u);
    return b;
}
__device__ __forceinline__ void xcd_barrier_complete(unsigned* bar, unsigned x, unsigned& nloc, unsigned& nx) {
    const unsigned G = gridDim.x * gridDim.y * gridDim.z;
    unsigned sum, cnt, mine, sp = 0u;
    for (;;) {
        sum = 0u; cnt = 0u; mine = 0u;
#pragma unroll
        for (unsigned j = 0; j < 16; ++j) { const unsigned c = xb_ld(&bar[XB_XCNT(j)]); sum += c; cnt += (c > 0u) ? 1u : 0u; mine = (j == x) ? c : mine; }
        if (sum == G) break;
        __builtin_amdgcn_s_sleep(1);
        if ((++sp & 255u) == 0u) { if (xb_ld(&bar[XB_TMO])) break; if (sp > XB_SPIN_CAP) { atomicAdd(&bar[XB_TMO], 1u); break; } }
    }
    nloc = mine > 0u ? mine : 1u; nx = cnt > 0u ? cnt : 1u;
}

__device__ __forceinline__ void xcd_barrier(const XcdBarrier& b) {
    asm volatile("s_waitcnt vmcnt(0)" ::: "memory");
    __syncthreads();
    if (threadIdx.x == 0) {
        unsigned* bar = b.bar;
        __builtin_amdgcn_s_waitcnt(0);
        unsigned nloc = b.st[0], nx = b.st[1];
        if (nloc == 0u) { xcd_barrier_complete(bar, b.x, nloc, nx); b.st[0] = nloc; b.st[1] = nx; }
        const unsigned old = xb_add(&bar[XB_XSUB(b.x)], 1u);
        const unsigned gen = old / nloc;
        if (old + 1u == (gen + 1u) * nloc) {
            __builtin_amdgcn_fence(__ATOMIC_RELEASE, "agent");
            asm volatile("s_waitcnt vmcnt(0)" ::: "memory");
            const unsigned og = xb_add(&bar[XB_TOP], 1u);
            const unsigned tg = og / nx;
            if (og + 1u == (tg + 1u) * nx) xb_add(&bar[XB_TOPGEN], 1u);
            else XB_SPIN(xb_ld(&bar[XB_TOPGEN]) == tg, bar);
            __builtin_amdgcn_fence(__ATOMIC_ACQUIRE, "agent");
            xb_add(&bar[XB_XGEN(b.x)], 1u);
            asm volatile("s_waitcnt vmcnt(0)" ::: "memory");
        } else {
            XB_SPIN(xb_ld(&bar[XB_XGEN(b.x)]) == gen, bar);
            __builtin_amdgcn_fence(__ATOMIC_ACQUIRE, "agent");
            asm volatile("s_waitcnt vmcnt(0)" ::: "memory");
        }
    }
    __syncthreads();
}

#define SB_XSUB(j)  (64 * (j))
#define SB_TOP      1024
#define SB_FLAG     1088
__device__ __forceinline__ void sb_arrive(const XcdBarrier& b, unsigned* sb) {
    const unsigned nloc = b.st[0], nx = b.st[1];
    const unsigned old = xb_add(&sb[SB_XSUB(b.x)], 1u);
    if (old + 1u == nloc) {
        __builtin_amdgcn_fence(__ATOMIC_RELEASE, "agent");
        asm volatile("s_waitcnt vmcnt(0)" ::: "memory");
        const unsigned og = xb_add(&sb[SB_TOP], 1u);
        if (og + 1u == nx) xb_add(&sb[SB_FLAG], 1u);
    }
}
__device__ __forceinline__ void sb_wait(const XcdBarrier& b, unsigned* sb) {
    XB_SPIN(xb_ld(&sb[SB_FLAG]) == 0u, b.bar);
    __builtin_amdgcn_fence(__ATOMIC_ACQUIRE, "agent");
    asm volatile("s_waitcnt vmcnt(0)" ::: "memory");
}
struct ArriveSync {
    static constexpr bool ARRIVE = true, WAIT = false;
    const XcdBarrier* b; unsigned* sb; int a1; bool done;
    __device__ __forceinline__ void arrive() const { sb_arrive(*b, sb); }
};
template <class Sched> struct WaitSync {
    static constexpr bool ARRIVE = false, WAIT = true;
    const XcdBarrier* b; unsigned* sb; int a1; bool done; const Sched* S; int nNp;
    __device__ __forceinline__ bool need(const pg8::Unit& u) const { return S->last_trip_of(u.pm, nNp) >= a1; }
    __device__ __forceinline__ void wait() const { sb_wait(*b, sb); }
};

struct Ctx {
    LAS unsigned char* lds; int tid, lane, wave, bid, G;
    const float* const* in; float* out; unsigned char* ws;
};
#define GIN(F, i) ((const float*)(const GAS float*)(F).in[i])
#define IN_X 0
#define IN_C 1
#define IN_CTX 2
#define IN_CCTX 3
#define IN_WMOD 4
#define IN_BMOD 5
#define IN_NORM1 6
#define IN_WIN 7
#define IN_GKUP 8
#define IN_GKB 9
#define IN_GLANORM 10
#define IN_CONVW 11
#define IN_CONVB 12
#define IN_DTBIAS 13
#define IN_ALOG 14
#define IN_SSDD 15
#define IN_SSDNORM 16
#define IN_WOUT 17
#define IN_NORM2 18
#define IN_WR 19
#define IN_BR 20
#define IN_WGU 21
#define IN_BGU 22
#define IN_WD 23
#define IN_BD 24
#define IN_FNORM 25

__device__ __forceinline__ int map_in(int n) {
    if (n < 1536) return n;
    if (n < 3072) return n + 16;
    if (n < 3088) return n - 1536;
    if (n < 3096) return n;
    return -1;
}
__device__ __forceinline__ void tr_item(const float* W, int N, int k0, int sc, bf16_t* WT, LAS float* scr, int lane) {
#pragma unroll 8
    for (int i = 0; i < 32; ++i) { const int kk = 2 * i + (lane >> 5); scr[kk * 33 + (lane & 31)] = (sc >= 0) ? W[(size_t)(k0 + kk) * N + sc] : 0.f; }
    LDS_WAIT(); asm volatile("" ::: "memory");
    const int c = lane & 7;
#pragma unroll
    for (int j = 0; j < 4; ++j) { const int n = (lane >> 3) + 8 * j; const LAS float* s = scr + (8 * c) * 33 + n;
        u32x4 o; o.x = pk2(s[0 * 33], s[1 * 33]); o.y = pk2(s[2 * 33], s[3 * 33]); o.z = pk2(s[4 * 33], s[5 * 33]); o.w = pk2(s[6 * 33], s[7 * 33]);
        *(u32x4*)(WT + (size_t)n * 1024 + k0 + 8 * c) = o; }
    LDS_WAIT(); asm volatile("" ::: "memory");
}

__device__ __forceinline__ void tr_item8(const float* W, int N, int k0, int sc, unsigned char* WT8, float wscale, LAS float* scr, int lane) {
#pragma unroll 16
    for (int i = 0; i < 64; ++i) { const int kk = 2 * i + (lane >> 5); scr[kk * 33 + (lane & 31)] = W[(size_t)(k0 + kk) * N + sc] * wscale; }
    LDS_WAIT(); asm volatile("" ::: "memory");
    const int c = lane & 7;
#pragma unroll
    for (int j = 0; j < 4; ++j) { const int n = (lane >> 3) + 8 * j; const LAS float* p = scr + (16 * c) * 33 + n;
        u32x4 o; o.x = pg8::pk4_fp8(p[0 * 33], p[1 * 33], p[2 * 33], p[3 * 33]); o.y = pg8::pk4_fp8(p[4 * 33], p[5 * 33], p[6 * 33], p[7 * 33]);
        o.z = pg8::pk4_fp8(p[8 * 33], p[9 * 33], p[10 * 33], p[11 * 33]); o.w = pg8::pk4_fp8(p[12 * 33], p[13 * 33], p[14 * 33], p[15 * 33]);
        *(u32x4*)(WT8 + (size_t)n * 1024 + k0 + 16 * c) = o; }
    LDS_WAIT(); asm volatile("" ::: "memory");
}
constexpr float WSCALE8 = 1024.f, HSCALE8 = 16.f, ASCALE8 = 4.f, PSCALE8 = 32.f;

__device__ __forceinline__ void tr8_load(f32x4 (&v)[16], const float* W, int N, int k0, int n0, int lane) {
    const float* p = W + (size_t)(k0 + (lane >> 3)) * N + n0 + 4 * (lane & 7);
#pragma unroll
    for (int i = 0; i < 16; ++i) v[i] = *(const f32x4*)(p + (size_t)(8 * i) * N);
}
__device__ __forceinline__ void tr8_store(const f32x4 (&v)[16], unsigned char* WT8, int k0, float wscale, LAS float* scr, int lane) {
    LAS float* s = scr + (lane >> 3) * 33 + 4 * (lane & 7);
#pragma unroll
    for (int i = 0; i < 16; ++i) { const f32x4 w = v[i] * wscale; s[(8 * i) * 33 + 0] = w.x; s[(8 * i) * 33 + 1] = w.y; s[(8 * i) * 33 + 2] = w.z; s[(8 * i) * 33 + 3] = w.w; }
    LDS_WAIT(); asm volatile("" ::: "memory");
    const int c = lane & 7;
#pragma unroll
    for (int j = 0; j < 4; ++j) { const int n = (lane >> 3) + 8 * j; const LAS float* p = scr + (16 * c) * 33 + n;
        u32x4 o; o.x = pg8::pk4_fp8(p[0 * 33], p[1 * 33], p[2 * 33], p[3 * 33]); o.y = pg8::pk4_fp8(p[4 * 33], p[5 * 33], p[6 * 33], p[7 * 33]);
        o.z = pg8::pk4_fp8(p[8 * 33], p[9 * 33], p[10 * 33], p[11 * 33]); o.w = pg8::pk4_fp8(p[12 * 33], p[13 * 33], p[14 * 33], p[15 * 33]);
        *(u32x4*)(WT8 + (size_t)n * 1024 + k0 + 16 * c) = o; }
    LDS_WAIT(); asm volatile("" ::: "memory");
}
struct Tr8Item { const float* W; int N, k0, n0; unsigned char* dst; };
__device__ __forceinline__ Tr8Item tr8_decode(const Ctx& F, int r) {
    constexpr int I_GU = NEXP * 8 * 64;
    Tr8Item t;
    if (r < I_GU) { const int e = r / (8 * 64), q = r % (8 * 64), nb = q % 64, kb = q / 64; const int n0 = nb * 32, tile = n0 >> 8, w = n0 & 255;
        t.W = GIN(F, IN_WGU) + (size_t)e * 1024 * 2048; t.N = 2048; t.k0 = kb * 128; t.n0 = (w < 128) ? tile * 128 + w : 1024 + tile * 128 + (w - 128);
        t.dst = (unsigned char*)(F.ws + WS_WGU) + ((size_t)e * 2048 + n0) * 1024; }
    else { r -= I_GU; const int e = r / (8 * 32), q = r % (8 * 32), nb = q % 32, kb = q / 32;
        t.W = GIN(F, IN_WD) + (size_t)e * 1024 * 1024; t.N = 1024; t.k0 = kb * 128; t.n0 = nb * 32;
        t.dst = (unsigned char*)(F.ws + WS_WD) + ((size_t)e * 1024 + nb * 32) * 1024; }
    return t;
}
__device__ __forceinline__ void expert_weight_copies(Ctx& F, int c_hi, int n_lo, int n_hi) {
    LAS float* scr = (LAS float*)(F.lds + F.wave * 16896);
    constexpr int NI = NEXP * 8 * 64 + NEXP * 8 * 32;
    const int s0 = F.bid < c_hi ? F.bid * n_lo : c_hi * n_lo + (F.bid - c_hi) * n_hi, ns = F.bid < c_hi ? n_lo : n_hi;
    int lane = F.lane; asm volatile("" : "+v"(lane));
    f32x4 va[16], vb[16];
    int it = s0 * 8 + F.wave; const int hi = (s0 + ns) * 8 < NI ? (s0 + ns) * 8 : NI;
    if (it < hi) { const Tr8Item t = tr8_decode(F, it); tr8_load(va, t.W, t.N, t.k0, t.n0, lane); }
    while (it < hi) {
        const int it2 = it + 8, it3 = it2 + 8;
        if (it2 < hi) { const Tr8Item t = tr8_decode(F, it2); tr8_load(vb, t.W, t.N, t.k0, t.n0, lane); }
        { const Tr8Item t = tr8_decode(F, it); tr8_store(va, t.dst, t.k0, WSCALE8, scr, lane); }
        if (it3 < hi) { const Tr8Item t = tr8_decode(F, it3); tr8_load(va, t.W, t.N, t.k0, t.n0, lane); }
        if (it2 < hi) { const Tr8Item t = tr8_decode(F, it2); tr8_store(vb, t.dst, t.k0, WSCALE8, scr, lane); }
        it = it3;
    }
}
__device__ __forceinline__ void prologue_items(Ctx& F, int part) {
    LAS float* scr = (LAS float*)(F.lds + F.wave * 16896);
    const int gw = F.bid * 8 + F.wave, NGW = F.G * 8;
    constexpr int I_IN = 16 * (NP / 32), I_OUT = 16 * 32, I_GU = NEXP * 8 * 64, I_D = NEXP * 8 * 32;
    bf16_t* WinT = (bf16_t*)(F.ws + WS_WIN); bf16_t* WoutT = (bf16_t*)(F.ws + WS_WOUT); unsigned char* WguT = (unsigned char*)(F.ws + WS_WGU); unsigned char* WdT = (unsigned char*)(F.ws + WS_WD);
    const int lo = part ? I_IN + I_OUT : 0, hi = part ? I_IN + I_OUT + I_GU + I_D : I_IN + I_OUT;
    for (int it = lo + gw; it < hi; it += NGW) {
        int r = it; const int l31 = F.lane & 31;
        if (r < I_IN) { const int nb = r % (NP / 32), kb = r / (NP / 32); tr_item(GIN(F, IN_WIN), 3096, kb * 64, map_in(nb * 32 + l31), WinT + (size_t)nb * 32 * 1024, scr, F.lane); continue; } r -= I_IN;
        if (r < I_OUT) { const int nb = r % 32, kb = r / 32; tr_item(GIN(F, IN_WOUT), 1024, kb * 64, nb * 32 + l31, WoutT + (size_t)nb * 32 * 1024, scr, F.lane); continue; } r -= I_OUT;
        if (r < I_GU) { const int e = r / (8 * 64), q = r % (8 * 64), nb = q % 64, kb = q / 64; const int n0 = nb * 32, tile = n0 >> 8, w = n0 & 255;
            const int sc0 = (w < 128) ? tile * 128 + w : 1024 + tile * 128 + (w - 128);
            tr_item8(GIN(F, IN_WGU) + (size_t)e * 1024 * 2048, 2048, kb * 128, sc0 + l31, WguT + ((size_t)e * 2048 + n0) * 1024, WSCALE8, scr, F.lane); continue; } r -= I_GU;
        { const int e = r / (8 * 32), q = r % (8 * 32), nb = q % 32, kb = q / 32;
            tr_item8(GIN(F, IN_WD) + (size_t)e * 1024 * 1024, 1024, kb * 128, nb * 32 + l31, WdT + ((size_t)e * 1024 + nb * 32) * 1024, WSCALE8, scr, F.lane); }
    }
}
__device__ __forceinline__ void ph_prologue(Ctx& F) {
    float* mod = (float*)(F.ws + WS_MOD);
    for (int item = F.bid; item < 192; item += F.G) {
        LAS float* sc = (LAS float*)F.lds;
        for (int i = F.tid; i < 5 * 1024; i += 512) { const int j = i >> 10, k = i & 1023; const float v = (j < 4) ? GIN(F, IN_C)[j * 1024 + k] : GIN(F, IN_CCTX)[k]; sc[i] = silu_f(v); }
        __syncthreads();
        const int nn = F.tid & 31, kq = F.tid >> 5, n = item * 32 + nn;
        float a0 = 0.f, a1 = 0.f, a2 = 0.f, a3 = 0.f, a4 = 0.f;
        const float* wm = GIN(F, IN_WMOD);
#pragma unroll 8
        for (int i = 0; i < 64; ++i) { const int k = kq + 16 * i; const float w = wm[(size_t)k * 6144 + n];
            a0 += sc[k] * w; a1 += sc[1024 + k] * w; a2 += sc[2048 + k] * w; a3 += sc[3072 + k] * w; a4 += sc[4096 + k] * w; }
        LAS float* red = (LAS float*)(F.lds + 20480);
        red[(kq * 5 + 0) * 32 + nn] = a0; red[(kq * 5 + 1) * 32 + nn] = a1; red[(kq * 5 + 2) * 32 + nn] = a2; red[(kq * 5 + 3) * 32 + nn] = a3; red[(kq * 5 + 4) * 32 + nn] = a4;
        __syncthreads();
        if (F.tid < 160) { const int j = F.tid >> 5; float s = GIN(F, IN_BMOD)[n];
            for (int q = 0; q < 16; ++q) s += red[(q * 5 + j) * 32 + nn];
            mod[j * 6144 + n] = s; }
        __syncthreads();
    }
    prologue_items(F, 0);
}
__device__ __forceinline__ void ph_norm1(Ctx& F) {
    const float* mod = (const float*)(F.ws + WS_MOD); bf16_t* H = (bf16_t*)(F.ws + WS_H);
    const int gw = F.bid * 8 + F.wave, NGW = F.G * 8;
    f32x4 nw[4];
#pragma unroll
    for (int q = 0; q < 4; ++q) nw[q] = *(const f32x4*)(GIN(F, IN_NORM1) + 4 * (F.lane + 64 * q));
    constexpr int U = 2;
    for (int r0 = gw * U; r0 < TT; r0 += NGW * U) {
        f32x4 v[U][4];
#pragma unroll
        for (int u = 0; u < U; ++u) { const int r = r0 + u;
            const float* src = (r < TL) ? GIN(F, IN_X) + (size_t)r * DM : GIN(F, IN_CTX) + (size_t)(r - TL) * DM;
#pragma unroll
            for (int q = 0; q < 4; ++q) v[u][q] = ((const f32x4*)src)[F.lane + 64 * q]; }
#pragma unroll
        for (int u = 0; u < U; ++u) { const int r = r0 + u; const int j = (r < TL) ? (r >> 13) : 4;
            const float* sh = mod + j * 6144; const float* scl = sh + 1024;
            float ss = 0.f;
#pragma unroll
            for (int q = 0; q < 4; ++q) ss += (v[u][q].x * v[u][q].x + v[u][q].y * v[u][q].y) + (v[u][q].z * v[u][q].z + v[u][q].w * v[u][q].w);
            const float rstd = rsqrtf(wave_sum(ss) * (1.f / DM) + EPS);
#pragma unroll
            for (int q = 0; q < 4; ++q) { const int idx = 4 * (F.lane + 64 * q);
                const f32x4 s1 = *(const f32x4*)(scl + idx), h1 = *(const f32x4*)(sh + idx);
                const f32x4 o = (v[u][q] * rstd * nw[q]) * (s1 + 1.0f) + h1;
                u32x2 pk; pk.x = pk2(o.x, o.y); pk.y = pk2(o.z, o.w);
                *(u32x2*)(H + (size_t)r * DM + idx) = pk; } }
    }
}

__device__ __forceinline__ void ph_conv_g(Ctx& F) {
    const char* P = (const char*)(F.ws + WS_P); bf16_t* XBC = (bf16_t*)(F.ws + WS_XBC);
    const int ch = (F.tid & 127) * 8, qd = F.tid >> 7;
    f32x2 wgt[9][4];
#pragma unroll
    for (int t = 0; t < 9; ++t) { const f32x4 a = *(const f32x4*)(GIN(F, IN_CONVW) + t * 1024 + ch), b4 = *(const f32x4*)(GIN(F, IN_CONVW) + t * 1024 + ch + 4);
        wgt[t][0] = (f32x2){a.x, a.y}; wgt[t][1] = (f32x2){a.z, a.w}; wgt[t][2] = (f32x2){b4.x, b4.y}; wgt[t][3] = (f32x2){b4.z, b4.w}; }
    f32x2 cb[4]; { const f32x4 a = *(const f32x4*)(GIN(F, IN_CONVB) + ch), b4 = *(const f32x4*)(GIN(F, IN_CONVB) + ch + 4); cb[0] = (f32x2){a.x, a.y}; cb[1] = (f32x2){a.z, a.w}; cb[2] = (f32x2){b4.x, b4.y}; cb[3] = (f32x2){b4.z, b4.w}; }
    for (int item = F.bid; item < 2048 + 64; item += F.G) {
        const bool lat = item < 2048;
        int rowbase, x0, W, y = 0, H = 1;
        if (lat) { const int b = item >> 9, yy = (item >> 2) & 127, qg = item & 3; y = yy; H = 128; W = 64; rowbase = b * SEQ + yy * 64; x0 = (qg * 4 + qd) * 4; }
        else { const int q = item - 2048, b = q >> 4, qg = q & 15; W = CTXL; rowbase = TL + b * CTXL; x0 = (qg * 4 + qd) * 4; }
        f32x2 acc[4][4];
#pragma unroll
        for (int p = 0; p < 4; ++p)
#pragma unroll
            for (int i = 0; i < 4; ++i) acc[p][i] = cb[i];
        u32x4 v[3][6];
#pragma unroll
        for (int dy = 0; dy < 3; ++dy) { const int yy = y + dy - 1; const bool rowok = lat ? (yy >= 0 && yy < H) : (dy == 1);
#pragma unroll
            for (int dx = 0; dx < 6; ++dx) { const int xx = x0 + dx - 1; v[dy][dx] = (u32x4){0u, 0u, 0u, 0u};
                if (rowok && xx >= 0 && xx < W) v[dy][dx] = *(const u32x4*)(P + (unsigned)((rowbase + (dy - 1) * 64 + xx) * NP + CX + ch) * 2u); } }
#pragma unroll
        for (int dy = 0; dy < 3; ++dy)
#pragma unroll
            for (int dx = 0; dx < 6; ++dx) { const u32x4 u = v[dy][dx]; f32x2 f[4];
                f[0] = (f32x2){bflo(u.x), bfhi(u.x)}; f[1] = (f32x2){bflo(u.y), bfhi(u.y)}; f[2] = (f32x2){bflo(u.z), bfhi(u.z)}; f[3] = (f32x2){bflo(u.w), bfhi(u.w)};
#pragma unroll
                for (int p = 0; p < 4; ++p) { const int kx = dx - p;
                    if (kx >= 0 && kx < 3) {
#pragma unroll
                        for (int i = 0; i < 4; ++i) acc[p][i] = __builtin_elementwise_fma(f[i], wgt[dy * 3 + kx][i], acc[p][i]); } } }
#pragma unroll
        for (int p = 0; p < 4; ++p) { u32x4 o; o.x = pk2(silu_f(acc[p][0].x), silu_f(acc[p][0].y)); o.y = pk2(silu_f(acc[p][1].x), silu_f(acc[p][1].y)); o.z = pk2(silu_f(acc[p][2].x), silu_f(acc[p][2].y)); o.w = pk2(silu_f(acc[p][3].x), silu_f(acc[p][3].y));
            *(u32x4*)(XBC + (size_t)(rowbase + x0 + p) * 1024 + ch) = o; }
    }
}

__device__ __forceinline__ int scan_row(int b, int dir, int s) {
    if (s < CTXL) { const int t = dir ? (CTXL - 1 - s) : s; return TL + b * CTXL + t; }
    const int s2 = s - CTXL; const int t = dir ? (SEQ - 1 - s2) : s2; return b * SEQ + t;
}

__device__ __forceinline__ void ph_scan_naive(Ctx& F) {
    const bf16_t* P = (const bf16_t*)(F.ws + WS_P); const bf16_t* XBC = (const bf16_t*)(F.ws + WS_XBC); const float* Gb = (const float*)(F.ws + WS_G);
    bf16_t* OG = (bf16_t*)(F.ws + WS_OG); bf16_t* OS = (bf16_t*)(F.ws + WS_OS);
    constexpr int NSTEP = CTXL + SEQ, BT = 16;
    for (int item = F.bid; item < 96; item += F.G) {
        if (item < 32) {
            const int b = item >> 3, h = (item >> 1) & 3, dir = item & 1;
            LAS float* qs = (LAS float*)F.lds; LAS float* ks = qs + BT * 64; LAS float* as = ks + BT * 64; LAS float* vs = as + BT * 64;
            const int v = F.tid >> 2, d0 = (F.tid & 3) * 16;
            float S[16];
#pragma unroll
            for (int d = 0; d < 16; ++d) S[d] = 0.f;
#pragma unroll 1
            for (int s0 = 0; s0 < NSTEP; s0 += BT) {
                __syncthreads();
#pragma unroll 1
                for (int i = F.tid; i < BT * 64; i += 512) { const int tk = i >> 6, d = i & 63; const int row = scan_row(b, dir, s0 + tk);
                    qs[i] = bf2f(P[(size_t)row * NP + CQ + h * 64 + d]) * 0.125f; ks[i] = bf2f(P[(size_t)row * NP + CK + h * 64 + d]);
                    as[i] = __expf(Gb[((size_t)dir * TT + row) * 256 + h * 64 + d]); }
#pragma unroll 1
                for (int i = F.tid; i < BT * 128; i += 512) { const int tk = i >> 7, vv = i & 127; const int row = scan_row(b, dir, s0 + tk); vs[i] = bf2f(P[(size_t)row * NP + CV + h * 128 + vv]); }
                __syncthreads();
#pragma unroll 1
                for (int tk = 0; tk < BT; ++tk) { const float vt = vs[tk * 128 + v]; float o = 0.f;
#pragma unroll
                    for (int d = 0; d < 16; ++d) { S[d] = as[tk * 64 + d0 + d] * S[d] + ks[tk * 64 + d0 + d] * vt; o += qs[tk * 64 + d0 + d] * S[d]; }
                    o += __shfl_xor(o, 1); o += __shfl_xor(o, 2);
                    const int row = scan_row(b, dir, s0 + tk);
                    if (row < TL && (F.tid & 3) == 0) OG[((size_t)dir * TL + row) * 512 + h * 128 + v] = (bf16_t)f2bf(o); }
            }
        } else {
            const int it = item - 32, b = it >> 4, hh = (it >> 1) & 7, dir = it & 1, g = hh >> 2;
            LAS float* Bs = (LAS float*)F.lds; LAS float* Cs = Bs + BT * 128; LAS float* xs = Cs + BT * 128; LAS float* dts = xs + BT * 64; LAS float* das = dts + BT;
            const int pp = F.tid >> 3, sb = (F.tid & 7) * 16;
            const float Ah = -__expf(GIN(F, IN_ALOG)[dir * 8 + hh]), dtb = GIN(F, IN_DTBIAS)[dir * 8 + hh];
            float S[16];
#pragma unroll
            for (int s = 0; s < 16; ++s) S[s] = 0.f;
#pragma unroll 1
            for (int s0 = 0; s0 < NSTEP; s0 += BT) {
                __syncthreads();
#pragma unroll 1
                for (int i = F.tid; i < BT * 128; i += 512) { const int tk = i >> 7, ss = i & 127; const int row = scan_row(b, dir, s0 + tk);
                    Bs[i] = bf2f(XBC[(size_t)row * 1024 + 512 + g * 128 + ss]); Cs[i] = bf2f(XBC[(size_t)row * 1024 + 768 + g * 128 + ss]); }
#pragma unroll 1
                for (int i = F.tid; i < BT * 64; i += 512) { const int tk = i >> 6, c = i & 63; const int row = scan_row(b, dir, s0 + tk); xs[i] = bf2f(XBC[(size_t)row * 1024 + hh * 64 + c]); }
                if (F.tid < BT) { const int row = scan_row(b, dir, s0 + F.tid);
                    const float dt = softplus_f(bf2f(P[(size_t)row * NP + CDT + hh]) + dtb);
                    dts[F.tid] = dt; das[F.tid] = __expf(dt * Ah); }
                __syncthreads();
#pragma unroll 1
                for (int tk = 0; tk < BT; ++tk) { const float dt = dts[tk], dA = das[tk]; const float xdt = xs[tk * 64 + pp] * dt; float y = 0.f;
#pragma unroll
                    for (int s = 0; s < 16; ++s) { S[s] = dA * S[s] + xdt * Bs[tk * 128 + sb + s]; y += Cs[tk * 128 + sb + s] * S[s]; }
                    y += __shfl_xor(y, 1); y += __shfl_xor(y, 2); y += __shfl_xor(y, 4);
                    const int row = scan_row(b, dir, s0 + tk);
                    if (row < TL && (F.tid & 7) == 0) OS[((size_t)dir * TL + row) * 512 + hh * 64 + pp] = (bf16_t)f2bf(y); }
            }
        }
        __syncthreads();
    }
}


typedef short s16x4 __attribute__((ext_vector_type(4)));
__device__ __forceinline__ f32x4 mfma16(bf16x8 a, bf16x8 b, f32x4 c) { return __builtin_amdgcn_mfma_f32_16x16x32_bf16(a, b, c, 0, 0, 0); }
__device__ __forceinline__ bf16x8 ldfrag(const LAS bf16_t* p) { return *(const LAS bf16x8*)p; }
__device__ __forceinline__ bf16x8 ldfrag_perm(const LAS bf16_t* p) { const s16x4 lo = *(const LAS s16x4*)p, hi = *(const LAS s16x4*)(p + 16); return (bf16x8){lo[0], lo[1], lo[2], lo[3], hi[0], hi[1], hi[2], hi[3]}; }
__device__ __forceinline__ bf16x8 ldfrag_tr(const LAS bf16_t* p, int pitch) {
    const s16x4 lo = __builtin_bit_cast(s16x4, __builtin_amdgcn_ds_read_tr16_b64_v4i16((LAS s16x4*)p));
    const s16x4 hi = __builtin_bit_cast(s16x4, __builtin_amdgcn_ds_read_tr16_b64_v4i16((LAS s16x4*)(p + 4 * pitch)));
    return (bf16x8){lo[0], lo[1], lo[2], lo[3], hi[0], hi[1], hi[2], hi[3]};
}
__device__ __forceinline__ bf16x8 acc2frag(f32x4 t0, f32x4 t1) {
    u32x4 w; w.x = pk2(t0[0], t0[1]); w.y = pk2(t0[2], t0[3]); w.z = pk2(t1[0], t1[1]); w.w = pk2(t1[2], t1[3]);
    return __builtin_bit_cast(bf16x8, w);
}
__device__ __forceinline__ int chunk_rlo(int b, int dir, int seg, int c) {
    if (seg == 0) { const int s0 = 64 * c; return TL + b * CTXL + (dir ? (CTXL - 64 - s0) : s0); }
    const int s2 = 512 * (seg - 1) + 64 * c; return b * SEQ + (dir ? (SEQ - 64 - s2) : s2);
}
constexpr int GP = 72, VP = 136, XP = 264;
constexpr int GL_QT = 0, GL_KT = 9216, GL_KHT = 18432, GL_VN = 27648, GL_PM = 45056, GL_TT = 54272, GL_AD = 56320, GL_GL = 56576, GL_OT = 91392;
constexpr int GLP = 68;
constexpr int SL_CM = 0, SL_BM = 17408, SL_XM = 34816, SL_MM = 68608, SL_AC = 105472, SL_DT = 106496, SL_W = 107520, SL_E = 108544, SL_DA = 109568, SL_YT = 109584;

struct GlaRegs { unsigned q[8], k[8]; u32x4 v[2]; };
__device__ __forceinline__ float logsigmoid2_16(float v) {
    const float t = v * 1.4426950408889634f; return (fminf(t, 0.f) - __builtin_amdgcn_logf(1.f + __builtin_amdgcn_exp2f(-fabsf(t)))) * (1.f / 16.f); }
template <bool OUT> __device__ __forceinline__ void gla_load(GlaRegs& R, const Ctx& F, int rlo, int dir, int h) {
    const char* P = (const char*)(F.ws + WS_P);
#pragma unroll
    for (int u = 0; u < 2; ++u) { const int idx = F.tid + 512 * u, j = idx >> 4, ch = idx & 15, row = dir ? rlo + 63 - j : rlo + j;
        R.v[u] = *(const u32x4*)(P + (unsigned)(row * NP + CV + h * 128 + ch * 8) * 2u); }
#pragma unroll
    for (int k = 0; k < 8; ++k) { const int j = 8 * F.wave + k, row = dir ? rlo + 63 - j : rlo + j;
        if (OUT) R.q[k] = *(const unsigned short*)(P + (unsigned)(row * NP + CQ + h * 64 + F.lane) * 2u);
        R.k[k] = *(const unsigned short*)(P + (unsigned)(row * NP + CK + h * 64 + F.lane) * 2u); }
}
__device__ __forceinline__ u32x4 gla_load_gk(const Ctx& F, int rlo, int dir) {
    const int j = F.tid >> 1, row = dir ? rlo + 63 - j : rlo + j;
    return *(const u32x4*)((const char*)(F.ws + WS_P) + (unsigned)(row * NP + CGK + (F.tid & 1) * 8) * 2u);
}
__device__ __forceinline__ void gla_store_gk(LAS float* GK, const Ctx& F, u32x4 v) {
    LAS float* o = GK + (F.tid >> 1) * 16 + (F.tid & 1) * 8;
    *(LAS f32x4*)o = (f32x4){bflo(v.x), bfhi(v.x), bflo(v.y), bfhi(v.y)}; *(LAS f32x4*)(o + 4) = (f32x4){bflo(v.z), bfhi(v.z), bflo(v.w), bfhi(v.w)};
}
template <bool OUT> __device__ __forceinline__ void gla_item(const Ctx& F, int seq, int seg) {
    const int b = seq >> 3, h = (seq >> 1) & 3, dir = seq & 1;
    const int l = F.lane, g4 = l >> 4, l15 = l & 15, w = F.wave;
    LAS bf16_t* QT = (LAS bf16_t*)(F.lds + GL_QT); LAS bf16_t* KT = (LAS bf16_t*)(F.lds + GL_KT); LAS bf16_t* KHT = (LAS bf16_t*)(F.lds + GL_KHT);
    LAS bf16_t* VN = (LAS bf16_t*)(F.lds + GL_VN); LAS bf16_t* PM = (LAS bf16_t*)(F.lds + GL_PM); LAS float* TTl = (LAS float*)(F.lds + GL_TT); LAS float* AD = (LAS float*)(F.lds + GL_AD);
    bf16_t* OG = (bf16_t*)(F.ws + WS_OG); LAS bf16_t* OT = (LAS bf16_t*)(F.lds + GL_OT);
#define GLA_FLUSH(rl) do { _Pragma("unroll") for (int u = 0; u < 2; ++u) { const int idx = F.tid + 512 * u, i = idx >> 4, ch = idx & 15, row = dir ? (rl) + 63 - i : (rl) + i; \
        *(u32x4*)((char*)OG + (unsigned)((dir * TL + row) * 512 + h * 128 + ch * 8) * 2u) = *(const LAS u32x4*)(OT + i * VP + ch * 8); } } while (0)
    f32x4 S[4];
    if (OUT) { const bf16_t* src = (const bf16_t*)(F.ws + WS_SSG) + ((size_t)seq * 16 + (seg - 1)) * 8192 + w * 1024 + l * 16;
#pragma unroll
        for (int dt = 0; dt < 4; ++dt) S[dt] = ld_bf4(src + dt * 4); }
    else {
#pragma unroll
        for (int dt = 0; dt < 4; ++dt) S[dt] = (f32x4){0.f, 0.f, 0.f, 0.f}; }
    float segsum = 0.f;
    const int nch = (seg == 0) ? 4 : 8;
    LAS float* GLb = (LAS float*)(F.lds + GL_GL);
    bf16x8 Aw; f32x4 gb4;
    { const int dcol = h * 64 + 16 * (w & 3) + l15, kb = 8 * (g4 & 1); float wv[8];
#pragma unroll
      for (int t = 0; t < 8; ++t) { const float x = GIN(F, IN_GKUP)[(dir * 16 + kb + t) * 256 + dcol]; const float hi = __builtin_bit_cast(float, pk2(x, 0.f) << 16); wv[t] = (g4 >= 2) ? (x - hi) : x; }
      u32x4 pw; pw.x = pk2(wv[0], wv[1]); pw.y = pk2(wv[2], wv[3]); pw.z = pk2(wv[4], wv[5]); pw.w = pk2(wv[6], wv[7]); Aw = __builtin_bit_cast(bf16x8, pw);
      gb4 = *(const f32x4*)(GIN(F, IN_GKB) + dir * 256 + h * 64 + 16 * (w & 3) + 4 * g4); }
#define GLA_GKLOAD(dst, cc) do { const int _rl = chunk_rlo(b, dir, seg, (cc)); _Pragma("unroll") for (int jj = 0; jj < 2; ++jj) { const int j = 16 * (2 * (w >> 2) + jj) + l15, row = dir ? _rl + 63 - j : _rl + j; \
        dst[jj] = *(const u32x4*)((const char*)(F.ws + WS_P) + (unsigned)(row * NP + CGK + 8 * (g4 & 1)) * 2u); } } while (0)
#define GLA_GCOMP(src, cc) do { _Pragma("unroll") for (int jj = 0; jj < 2; ++jj) { const f32x4 ga = mfma16(Aw, __builtin_bit_cast(bf16x8, src[jj]), (f32x4){0.f, 0.f, 0.f, 0.f}); \
        f32x4 gv; gv.x = logsigmoid2_16(ga.x + gb4.x); gv.y = logsigmoid2_16(ga.y + gb4.y); gv.z = logsigmoid2_16(ga.z + gb4.z); gv.w = logsigmoid2_16(ga.w + gb4.w); \
        *(LAS f32x4*)(GLb + ((cc) & 1) * (64 * GLP) + (16 * (2 * (w >> 2) + jj) + l15) * GLP + 16 * (w & 3) + 4 * g4) = gv; } } while (0)
    u32x4 gkf[2];
    GLA_GKLOAD(gkf, 0); GLA_GCOMP(gkf, 0); GLA_GKLOAD(gkf, 1);
    GlaRegs R; gla_load<OUT>(R, F, chunk_rlo(b, dir, seg, 0), dir, h);
    LBAR();
#pragma unroll 1
    for (int c = 0; c < nch; ++c) {
        const int rlo = chunk_rlo(b, dir, seg, c);
        if (OUT && c > 0) GLA_FLUSH(chunk_rlo(b, dir, seg, c - 1));
        float cs[8]; { float run = 0.f; const LAS float* gl = GLb + (c & 1) * (64 * GLP) + (8 * w) * GLP + l;
#pragma unroll
            for (int k = 0; k < 8; ++k) { run += gl[k * GLP]; cs[k] = run; }
            TTl[w * 64 + l] = run; }
        LBAR();
        float base = 0.f, tot = 0.f;
#pragma unroll
        for (int q = 0; q < 8; ++q) { const float t = TTl[q * 64 + l]; tot += t; base += (q < w) ? t : 0.f; }
        const float etot = __builtin_amdgcn_exp2f(tot);
        { float kh[8];
#pragma unroll
          for (int k2 = 0; k2 < 8; k2 += 2) { float qv[2], kv[2];
#pragma unroll
              for (int u = 0; u < 2; ++u) { const int k = k2 + u; const float bj = base + cs[k]; const float kf = __builtin_bit_cast(float, R.k[k] << 16);
                  const float ek = __builtin_amdgcn_exp2f(-bj);
                  if (OUT) { qv[u] = __builtin_bit_cast(float, R.q[k] << 16) * 0.125f * __builtin_amdgcn_exp2f(bj); kv[u] = kf * ek; }
                  kh[k] = kf * (etot * ek); }
              if (OUT) { const int j = 8 * w + k2; const unsigned qw = pk2(qv[0], qv[1]), kw = pk2(kv[0], kv[1]);
                  QT[j * GP + l] = (bf16_t)(qw & 0xffffu); QT[(j + 1) * GP + l] = (bf16_t)(qw >> 16); KT[j * GP + l] = (bf16_t)(kw & 0xffffu); KT[(j + 1) * GP + l] = (bf16_t)(kw >> 16); } }
          u32x4 pk; pk.x = pk2(kh[0], kh[1]); pk.y = pk2(kh[2], kh[3]); pk.z = pk2(kh[4], kh[5]); pk.w = pk2(kh[6], kh[7]);
          *(LAS u32x4*)(KHT + l * GP + 8 * w) = pk; }
        if (w == 0) { AD[l] = etot; segsum += tot; }
#pragma unroll
        for (int u = 0; u < 2; ++u) { const int idx = F.tid + 512 * u, j = idx >> 4, ch = idx & 15; *(LAS u32x4*)(VN + j * VP + ch * 8) = R.v[u]; }
        LBAR();
        if (c + 1 < nch) gla_load<OUT>(R, F, chunk_rlo(b, dir, seg, c + 1), dir, h);
        if (c + 1 < nch) { GLA_GCOMP(gkf, c + 1); if (c + 2 < nch) GLA_GKLOAD(gkf, c + 2); }
        if (OUT) {
            const int jt = w & 3;
#pragma unroll
            for (int ii = 0; ii < 2; ++ii) { const int it = 2 * (w >> 2) + ii; f32x4 acc = (f32x4){0.f, 0.f, 0.f, 0.f};
                if (jt <= it) {
#pragma unroll
                    for (int ks = 0; ks < 2; ++ks) acc = mfma16(ldfrag(KT + (16 * jt + l15) * GP + 32 * ks + 8 * g4), ldfrag(QT + (16 * it + l15) * GP + 32 * ks + 8 * g4), acc); }
                const int i = 16 * it + l15, j0 = 16 * jt + 4 * g4;
                float p0 = (j0 + 0 <= i) ? acc[0] : 0.f, p1 = (j0 + 1 <= i) ? acc[1] : 0.f, p2 = (j0 + 2 <= i) ? acc[2] : 0.f, p3 = (j0 + 3 <= i) ? acc[3] : 0.f;
                u32x2 pk; pk.x = pk2(p0, p1); pk.y = pk2(p2, p3);
                *(LAS u32x2*)(PM + i * GP + j0) = pk; }
            LBAR();
        }
        bf16x8 Bv[2];
#pragma unroll
        for (int ks = 0; ks < 2; ++ks) Bv[ks] = ldfrag_tr(VN + (32 * ks + 8 * g4 + (l15 >> 2)) * VP + 16 * w + 4 * (l & 3), VP);
        if (OUT) {
            bf16x8 Bs[2];
#pragma unroll
            for (int ks = 0; ks < 2; ++ks) Bs[ks] = acc2frag(S[2 * ks], S[2 * ks + 1]);
#pragma unroll
            for (int it = 0; it < 4; ++it) { f32x4 acc = (f32x4){0.f, 0.f, 0.f, 0.f};
#pragma unroll
                for (int ks = 0; ks < 2; ++ks) acc = mfma16(ldfrag(PM + (16 * it + l15) * GP + 32 * ks + 8 * g4), Bv[ks], acc);
#pragma unroll
                for (int ks = 0; ks < 2; ++ks) acc = mfma16(ldfrag_perm(QT + (16 * it + l15) * GP + 32 * ks + 4 * g4), Bs[ks], acc);
                { const unsigned w01 = pk2(acc[0], acc[1]), w23 = pk2(acc[2], acc[3]); LAS bf16_t* op = OT + (16 * it + 4 * g4) * VP + 16 * w + l15;
                  op[0] = (bf16_t)(w01 & 0xffffu); op[VP] = (bf16_t)(w01 >> 16); op[2 * VP] = (bf16_t)(w23 & 0xffffu); op[3 * VP] = (bf16_t)(w23 >> 16); } }
        }
#pragma unroll
        for (int dt = 0; dt < 4; ++dt) { const f32x4 av = *(const LAS f32x4*)(AD + 16 * dt + 4 * g4); S[dt] = S[dt] * av;
#pragma unroll
            for (int ks = 0; ks < 2; ++ks) S[dt] = mfma16(ldfrag(KHT + (16 * dt + l15) * GP + 32 * ks + 8 * g4), Bv[ks], S[dt]); }
        LBAR();
    }
    if (OUT) { GLA_FLUSH(chunk_rlo(b, dir, seg, nch - 1)); LBAR(); }
#undef GLA_FLUSH
#undef GLA_GKLOAD
#undef GLA_GCOMP
    if (!OUT) { bf16_t* dst = (bf16_t*)(F.ws + WS_USG) + ((size_t)seq * 17 + seg) * 8192 + w * 1024 + l * 16;
#pragma unroll
        for (int dt = 0; dt < 4; ++dt) st_bf4(dst + dt * 4, S[dt]);
        if (w == 0) ((float*)(F.ws + WS_ASG))[((size_t)seq * 17 + seg) * 64 + l] = segsum; }
}

struct SsdRegs { u32x4 c[2], bm[2], x[4]; unsigned dtraw; };
template <bool OUT> __device__ __forceinline__ void ssd_load1(SsdRegs& R, const Ctx& F, int rlo, int dir, int g) {
    const char* P = (const char*)(F.ws + WS_P); const char* XBC = (const char*)(F.ws + WS_XBC);
#pragma unroll
    for (int u = 0; u < 2; ++u) { const int idx = F.tid + 512 * u, j = idx >> 4, ch = idx & 15, row = dir ? rlo + 63 - j : rlo + j;
        R.bm[u] = *(const u32x4*)(XBC + (unsigned)(row * 1024 + 512 + g * 128 + ch * 8) * 2u); }
    R.dtraw = 0u;
    if (F.wave < 4) { const int row = dir ? rlo + 63 - F.lane : rlo + F.lane; R.dtraw = *(const unsigned short*)(P + (unsigned)(row * NP + CDT + g * 4 + F.wave) * 2u); }
}
template <bool OUT> __device__ __forceinline__ void ssd_load2(SsdRegs& R, const Ctx& F, int rlo, int dir, int g) {
    const char* XBC = (const char*)(F.ws + WS_XBC);
    if (OUT) {
#pragma unroll
        for (int u = 0; u < 2; ++u) { const int idx = F.tid + 512 * u, j = idx >> 4, ch = idx & 15, row = dir ? rlo + 63 - j : rlo + j;
            R.c[u] = *(const u32x4*)(XBC + (unsigned)(row * 1024 + 768 + g * 128 + ch * 8) * 2u); } }
#pragma unroll
    for (int u = 0; u < 4; ++u) { const int idx = F.tid + 512 * u, j = idx >> 5, ch = idx & 31, row = dir ? rlo + 63 - j : rlo + j;
        R.x[u] = *(const u32x4*)(XBC + (unsigned)(row * 1024 + g * 256 + ch * 8) * 2u); }
}
template <bool OUT> __device__ __forceinline__ void ssd_item(const Ctx& F, int sg, int seg) {
    const int b = sg >> 2, g = (sg >> 1) & 1, dir = sg & 1;
    const int l = F.lane, g4 = l >> 4, l15 = l & 15, w = F.wave, r = w >> 1, ph = w & 1;
    LAS bf16_t* CM = (LAS bf16_t*)(F.lds + SL_CM); LAS bf16_t* BM = (LAS bf16_t*)(F.lds + SL_BM); LAS bf16_t* XM = (LAS bf16_t*)(F.lds + SL_XM); LAS bf16_t* MM = (LAS bf16_t*)(F.lds + SL_MM);
    LAS float* AC = (LAS float*)(F.lds + SL_AC); LAS float* DTl = (LAS float*)(F.lds + SL_DT); LAS float* Wl = (LAS float*)(F.lds + SL_W); LAS float* El = (LAS float*)(F.lds + SL_E); LAS float* DAl = (LAS float*)(F.lds + SL_DA);
    bf16_t* OS = (bf16_t*)(F.ws + WS_OS); LAS bf16_t* YT = (LAS bf16_t*)(F.lds + SL_YT);
#define SSD_FLUSH(rl) do { _Pragma("unroll") for (int u = 0; u < 4; ++u) { const int idx = F.tid + 512 * u, i = idx >> 5, ch = idx & 31, row = dir ? (rl) + 63 - i : (rl) + i; \
        *(u32x4*)((char*)OS + (unsigned)((dir * TL + row) * 512 + g * 256 + ch * 8) * 2u) = *(const LAS u32x4*)(YT + i * XP + ch * 8); } } while (0)
    f32x4 ST[8][2];
    if (OUT) { const bf16_t* src = (const bf16_t*)(F.ws + WS_SSS) + ((size_t)sg * 16 + (seg - 1)) * 32768 + w * 4096 + l * 64;
#pragma unroll
        for (int st = 0; st < 8; ++st)
#pragma unroll
            for (int nt = 0; nt < 2; ++nt) ST[st][nt] = ld_bf4(src + (st * 2 + nt) * 4); }
    else {
#pragma unroll
        for (int st = 0; st < 8; ++st)
#pragma unroll
            for (int nt = 0; nt < 2; ++nt) ST[st][nt] = (f32x4){0.f, 0.f, 0.f, 0.f}; }
    const int hh4 = (w < 4) ? (g * 4 + w) : 0;
    const float Ah = -__expf(GIN(F, IN_ALOG)[dir * 8 + hh4]) * 1.4426950408889634f, dtb = GIN(F, IN_DTBIAS)[dir * 8 + hh4];
    float segsum = 0.f;
    const int nch = (seg == 0) ? 4 : 8;
    SsdRegs R; ssd_load1<OUT>(R, F, chunk_rlo(b, dir, seg, 0), dir, g); ssd_load2<OUT>(R, F, chunk_rlo(b, dir, seg, 0), dir, g);
#pragma unroll 1
    for (int c = 0; c < nch; ++c) {
        const int rlo = chunk_rlo(b, dir, seg, c);
        if (OUT && c > 0) SSD_FLUSH(chunk_rlo(b, dir, seg, c - 1));
#pragma unroll
        for (int u = 0; u < 2; ++u) { const int idx = F.tid + 512 * u, j = idx >> 4, ch = idx & 15;
            if (OUT) *(LAS u32x4*)(CM + j * VP + ch * 8) = R.c[u];
            *(LAS u32x4*)(BM + j * VP + ch * 8) = R.bm[u]; }
#pragma unroll
        for (int u = 0; u < 4; ++u) { const int idx = F.tid + 512 * u, j = idx >> 5, ch = idx & 31; *(LAS u32x4*)(XM + j * XP + ch * 8) = R.x[u]; }
        if (w < 4) { const float dtx = __builtin_bit_cast(float, R.dtraw << 16) + dtb;
            const float dt = fmaxf(dtx, 0.f) + 0.6931471805599453f * __builtin_amdgcn_logf(1.f + __builtin_amdgcn_exp2f(-fabsf(dtx) * 1.4426950408889634f)); float a = dt * Ah;
#pragma unroll
            for (int off = 1; off < 64; off <<= 1) { const float t = __shfl_up(a, off); if (l >= off) a += t; }
            const float alast = __shfl(a, 63);
            AC[w * 64 + l] = a; DTl[w * 64 + l] = dt; Wl[w * 64 + l] = __builtin_amdgcn_exp2f(alast - a) * dt; El[w * 64 + l] = __builtin_amdgcn_exp2f(a);
            if (l == 0) DAl[w] = __builtin_amdgcn_exp2f(alast);
            segsum += alast; }
        LBAR();
        if (c + 1 < nch) ssd_load1<OUT>(R, F, chunk_rlo(b, dir, seg, c + 1), dir, g);
        if (OUT) {
            const int jt = w & 3;
#pragma unroll
            for (int ii = 0; ii < 2; ++ii) { const int it = 2 * (w >> 2) + ii; f32x4 acc = (f32x4){0.f, 0.f, 0.f, 0.f};
                if (jt <= it) {
#pragma unroll
                    for (int ks = 0; ks < 4; ++ks) acc = mfma16(ldfrag(BM + (16 * jt + l15) * VP + 32 * ks + 8 * g4), ldfrag(CM + (16 * it + l15) * VP + 32 * ks + 8 * g4), acc); }
                const int i = 16 * it + l15, j0 = 16 * jt + 4 * g4;
#pragma unroll
                for (int rr = 0; rr < 4; ++rr) { const float ai = AC[rr * 64 + i]; const f32x4 aj = *(const LAS f32x4*)(AC + rr * 64 + j0), dj = *(const LAS f32x4*)(DTl + rr * 64 + j0);
                    float m[4];
#pragma unroll
                    for (int q = 0; q < 4; ++q) m[q] = (j0 + q <= i) ? acc[q] * __builtin_amdgcn_exp2f(fminf(ai - aj[q], 0.f)) * dj[q] : 0.f;
                    u32x2 pk; pk.x = pk2(m[0], m[1]); pk.y = pk2(m[2], m[3]);
                    *(LAS u32x2*)(MM + (rr * 64 + i) * GP + j0) = pk; } }
            LBAR();
        }
        const int p0 = 64 * r + 32 * ph;
        if (OUT) {
#pragma unroll
            for (int nt = 0; nt < 2; ++nt) {
                f32x4 ay[4];
#pragma unroll
                for (int it = 0; it < 4; ++it) ay[it] = (f32x4){0.f, 0.f, 0.f, 0.f};
                bf16x8 Ac[4], An[4];
#pragma unroll
                for (int it = 0; it < 4; ++it) Ac[it] = ldfrag_perm(CM + (16 * it + l15) * VP + 4 * g4);
#pragma unroll
                for (int ks = 0; ks < 4; ++ks) {
                    if (ks < 3) {
#pragma unroll
                        for (int it = 0; it < 4; ++it) An[it] = ldfrag_perm(CM + (16 * it + l15) * VP + 32 * (ks + 1) + 4 * g4); }
                    else {
#pragma unroll
                        for (int it = 0; it < 4; ++it) An[it] = ldfrag(MM + (r * 64 + 16 * it + l15) * GP + 8 * g4); }
                    const bf16x8 Bst = acc2frag(ST[2 * ks][nt], ST[2 * ks + 1][nt]);
#pragma unroll
                    for (int it = 0; it < 4; ++it) ay[it] = mfma16(Ac[it], Bst, ay[it]);
                    __builtin_amdgcn_sched_barrier(0);
#pragma unroll
                    for (int it = 0; it < 4; ++it) Ac[it] = An[it]; }
                bf16x8 Bx0 = ldfrag_tr(XM + (8 * g4 + (l15 >> 2)) * XP + p0 + 16 * nt + 4 * (l & 3), XP);
                const bf16x8 Bx1 = ldfrag_tr(XM + (32 + 8 * g4 + (l15 >> 2)) * XP + p0 + 16 * nt + 4 * (l & 3), XP);
#pragma unroll
                for (int it = 0; it < 4; ++it) { const f32x4 ev = *(const LAS f32x4*)(El + r * 64 + 16 * it + 4 * g4); ay[it] = ay[it] * ev; }
#pragma unroll
                for (int it = 0; it < 4; ++it) An[it] = ldfrag(MM + (r * 64 + 16 * it + l15) * GP + 32 + 8 * g4);
#pragma unroll
                for (int it = 0; it < 4; ++it) ay[it] = mfma16(Ac[it], Bx0, ay[it]);
                __builtin_amdgcn_sched_barrier(0);
#pragma unroll
                for (int it = 0; it < 4; ++it) ay[it] = mfma16(An[it], Bx1, ay[it]);
#pragma unroll
                for (int it = 0; it < 4; ++it) { const unsigned w01 = pk2(ay[it][0], ay[it][1]), w23 = pk2(ay[it][2], ay[it][3]); LAS bf16_t* yp = YT + (16 * it + 4 * g4) * XP + p0 + 16 * nt + l15;
                    yp[0] = (bf16_t)(w01 & 0xffffu); yp[XP] = (bf16_t)(w01 >> 16); yp[2 * XP] = (bf16_t)(w23 & 0xffffu); yp[3 * XP] = (bf16_t)(w23 >> 16); }
                __builtin_amdgcn_sched_barrier(0);
            }
        }
        if (c + 1 < nch) ssd_load2<OUT>(R, F, chunk_rlo(b, dir, seg, c + 1), dir, g);
        { const float dA = DAl[r];
          bf16x8 Bx[2][2];
#pragma unroll
          for (int ks = 0; ks < 2; ++ks)
#pragma unroll
              for (int nt = 0; nt < 2; ++nt) Bx[ks][nt] = ldfrag_tr(XM + (32 * ks + 8 * g4 + (l15 >> 2)) * XP + p0 + 16 * nt + 4 * (l & 3), XP);
          bf16x8 Af[2]; Af[0] = ldfrag_tr(BM + (8 * g4 + (l15 >> 2)) * VP + 4 * (l & 3), VP); Af[1] = ldfrag_tr(BM + (32 + 8 * g4 + (l15 >> 2)) * VP + 4 * (l & 3), VP);
          bf16x8 Bw[2][2];
#pragma unroll
          for (int ks = 0; ks < 2; ++ks) { const f32x4 w0 = *(const LAS f32x4*)(Wl + r * 64 + 32 * ks + 8 * g4), w1 = *(const LAS f32x4*)(Wl + r * 64 + 32 * ks + 8 * g4 + 4);
#pragma unroll
              for (int nt = 0; nt < 2; ++nt) { const u32x4 xv = __builtin_bit_cast(u32x4, Bx[ks][nt]); u32x4 o;
                  o.x = pk2(bflo(xv.x) * w0[0], bfhi(xv.x) * w0[1]); o.y = pk2(bflo(xv.y) * w0[2], bfhi(xv.y) * w0[3]);
                  o.z = pk2(bflo(xv.z) * w1[0], bfhi(xv.z) * w1[1]); o.w = pk2(bflo(xv.w) * w1[2], bfhi(xv.w) * w1[3]);
                  Bw[ks][nt] = __builtin_bit_cast(bf16x8, o); } }
#pragma unroll
          for (int st = 0; st < 8; ++st) { ST[st][0] = ST[st][0] * dA; ST[st][1] = ST[st][1] * dA;
              bf16x8 Ag[2]; if (st < 7) { Ag[0] = ldfrag_tr(BM + (8 * g4 + (l15 >> 2)) * VP + 16 * (st + 1) + 4 * (l & 3), VP); Ag[1] = ldfrag_tr(BM + (32 + 8 * g4 + (l15 >> 2)) * VP + 16 * (st + 1) + 4 * (l & 3), VP); }
              else { Ag[0] = Af[0]; Ag[1] = Af[1]; }
#pragma unroll
              for (int ks = 0; ks < 2; ++ks) { ST[st][0] = mfma16(Af[ks], Bw[ks][0], ST[st][0]); ST[st][1] = mfma16(Af[ks], Bw[ks][1], ST[st][1]); }
              __builtin_amdgcn_sched_barrier(0);
              Af[0] = Ag[0]; Af[1] = Ag[1]; } }
        LBAR();
    }
    if (OUT) { SSD_FLUSH(chunk_rlo(b, dir, seg, nch - 1)); LBAR(); }
#undef SSD_FLUSH
    if (!OUT) { bf16_t* dst = (bf16_t*)(F.ws + WS_USS) + ((size_t)sg * 17 + seg) * 32768 + w * 4096 + l * 64;
#pragma unroll
        for (int st = 0; st < 8; ++st)
#pragma unroll
            for (int nt = 0; nt < 2; ++nt) st_bf4(dst + (st * 2 + nt) * 4, ST[st][nt]);
        if (w < 4 && l == 0) ((float*)(F.ws + WS_ASS))[((size_t)sg * 17 + seg) * 4 + w] = segsum; }
}

__device__ __forceinline__ void ph_scan_a(Ctx& F) {
    for (int item = F.bid; item < 240 + 480 + 16 + 32; item += F.G) {
        if (item < 240) ssd_item<false>(F, item / 15, 1 + item % 15);
        else if (item < 720) { const int q = item - 240; gla_item<false>(F, q / 15, 1 + q % 15); }
        else if (item < 736) ssd_item<false>(F, item - 720, 0);
        else gla_item<false>(F, item - 736, 0);
    }
}
__device__ __forceinline__ void ph_scan_b(Ctx& F) {
    const int gt = F.bid * 512 + F.tid, NT = F.G * 512;
    for (int it = gt; it < 32 * 2048 + 16 * 8192; it += NT) {
        if (it < 32 * 2048) {
            const int seq = it >> 11, e4 = it & 2047, e = e4 * 4, lane = (e >> 4) & 63, dt = (e >> 2) & 3, d0 = 16 * dt + 4 * (lane >> 4);
            const bf16_t* U = (const bf16_t*)(F.ws + WS_USG) + (size_t)seq * 17 * 8192 + e; const float* A = (const float*)(F.ws + WS_ASG) + (size_t)seq * 17 * 64 + d0;
            bf16_t* O = (bf16_t*)(F.ws + WS_SSG) + (size_t)seq * 16 * 8192 + e;
            f32x4 S = ld_bf4(U); st_bf4(O, S);
#pragma unroll 1
            for (int m = 1; m < 16; ++m) { const f32x4 u = ld_bf4(U + (size_t)m * 8192); const f32x4 a = *(const f32x4*)(A + m * 64);
                S.x = __builtin_amdgcn_exp2f(a.x) * S.x + u.x; S.y = __builtin_amdgcn_exp2f(a.y) * S.y + u.y; S.z = __builtin_amdgcn_exp2f(a.z) * S.z + u.z; S.w = __builtin_amdgcn_exp2f(a.w) * S.w + u.w;
                st_bf4(O + (size_t)m * 8192, S); }
        } else {
            const int q = it - 32 * 2048, sg = q >> 13, e4 = q & 8191, e = e4 * 4, r = (e >> 12) >> 1;
            const bf16_t* U = (const bf16_t*)(F.ws + WS_USS) + (size_t)sg * 17 * 32768 + e; const float* A = (const float*)(F.ws + WS_ASS) + (size_t)sg * 17 * 4 + r;
            bf16_t* O = (bf16_t*)(F.ws + WS_SSS) + (size_t)sg * 16 * 32768 + e;
            f32x4 S = ld_bf4(U); st_bf4(O, S);
#pragma unroll 1
            for (int m = 1; m < 16; ++m) { const f32x4 u = ld_bf4(U + (size_t)m * 32768); const float a = __builtin_amdgcn_exp2f(A[m * 4]);
                S = S * a + u; st_bf4(O + (size_t)m * 32768, S); }
        }
    }
}
__device__ __forceinline__ void combine_gla_block(const Ctx& F, int b, int h, int seg) {
    const char* OG = (const char*)(F.ws + WS_OG); const char* P = (const char*)(F.ws + WS_P); char* Y = (char*)(F.ws + WS_Y);
    int l = F.lane; asm volatile("" : "+v"(l));
    const int sub = l >> 4, c8 = (l & 15) * 8, row0 = b * SEQ + 512 * (seg - 1);
    float nw[8]; { const f32x4 n0 = *(const f32x4*)(GIN(F, IN_GLANORM) + c8), n1 = *(const f32x4*)(GIN(F, IN_GLANORM) + c8 + 4); nw[0] = n0.x; nw[1] = n0.y; nw[2] = n0.z; nw[3] = n0.w; nw[4] = n1.x; nw[5] = n1.y; nw[6] = n1.z; nw[7] = n1.w; }
    constexpr int U = 4;
    for (int t0 = F.wave * 4 * U; t0 < 512; t0 += 8 * 4 * U) {
        u32x4 a[U], c[U], g[U];
#pragma unroll
        for (int u = 0; u < U; ++u) { const int row = row0 + t0 + 4 * u + sub;
            a[u] = *(const u32x4*)(OG + (unsigned)(row * 512 + h * 128 + c8) * 2u); c[u] = *(const u32x4*)(OG + (unsigned)((TL + row) * 512 + h * 128 + c8) * 2u);
            g[u] = *(const u32x4*)(P + (unsigned)(row * NP + CG + h * 128 + c8) * 2u); }
#pragma unroll
        for (int u = 0; u < U; ++u) { const int row = row0 + t0 + 4 * u + sub;
            float o[8], gt[8];
            o[0] = bflo(a[u].x) + bflo(c[u].x); o[1] = bfhi(a[u].x) + bfhi(c[u].x); o[2] = bflo(a[u].y) + bflo(c[u].y); o[3] = bfhi(a[u].y) + bfhi(c[u].y);
            o[4] = bflo(a[u].z) + bflo(c[u].z); o[5] = bfhi(a[u].z) + bfhi(c[u].z); o[6] = bflo(a[u].w) + bflo(c[u].w); o[7] = bfhi(a[u].w) + bfhi(c[u].w);
            gt[0] = bflo(g[u].x); gt[1] = bfhi(g[u].x); gt[2] = bflo(g[u].y); gt[3] = bfhi(g[u].y); gt[4] = bflo(g[u].z); gt[5] = bfhi(g[u].z); gt[6] = bflo(g[u].w); gt[7] = bfhi(g[u].w);
            float ss = 0.f;
#pragma unroll
            for (int i = 0; i < 8; ++i) ss += o[i] * o[i];
            ss += __shfl_xor(ss, 1); ss += __shfl_xor(ss, 2); ss += __shfl_xor(ss, 4); ss += __shfl_xor(ss, 8);
            const float rstd = rsqrtf(ss * (1.f / 128.f) + EPS);
#pragma unroll
            for (int i = 0; i < 8; ++i) o[i] = o[i] * rstd * nw[i] * silu_f(gt[i]);
            u32x4 w; w.x = pk2(o[0], o[1]); w.y = pk2(o[2], o[3]); w.z = pk2(o[4], o[5]); w.w = pk2(o[6], o[7]);
            *(u32x4*)(Y + (unsigned)(row * 1024 + h * 128 + c8) * 2u) = w; }
    }
}
__device__ __forceinline__ void combine_ssd_block(const Ctx& F, int b, int g, int seg) {
    const char* OS = (const char*)(F.ws + WS_OS); const char* P = (const char*)(F.ws + WS_P); const char* XBC = (const char*)(F.ws + WS_XBC); char* Y = (char*)(F.ws + WS_Y);
    int l = F.lane; asm volatile("" : "+v"(l));
    const int sub = l >> 5, c0 = g * 256 + (l & 31) * 8, row0 = b * SEQ + 512 * (seg - 1);
    float nw[8]; { const f32x4 n0 = *(const f32x4*)(GIN(F, IN_SSDNORM) + c0), n1 = *(const f32x4*)(GIN(F, IN_SSDNORM) + c0 + 4); nw[0] = n0.x; nw[1] = n0.y; nw[2] = n0.z; nw[3] = n0.w; nw[4] = n1.x; nw[5] = n1.y; nw[6] = n1.z; nw[7] = n1.w; }
    const float Dh = GIN(F, IN_SSDD)[c0 >> 6];
    constexpr int U = 4;
    for (int t0 = F.wave * 2 * U; t0 < 512; t0 += 8 * 2 * U) {
        u32x4 a[U], c[U], z[U], x[U];
#pragma unroll
        for (int u = 0; u < U; ++u) { const int row = row0 + t0 + 2 * u + sub;
            a[u] = *(const u32x4*)(OS + (unsigned)(row * 512 + c0) * 2u); c[u] = *(const u32x4*)(OS + (unsigned)((TL + row) * 512 + c0) * 2u);
            z[u] = *(const u32x4*)(P + (unsigned)(row * NP + CZ + c0) * 2u); x[u] = *(const u32x4*)(XBC + (unsigned)(row * 1024 + c0) * 2u); }
#pragma unroll
        for (int u = 0; u < U; ++u) { const int row = row0 + t0 + 2 * u + sub;
            float v[8];
#define SSDV(i, A, C, X, Z) v[i] = (A + C + Dh * X) * silu_f(Z)
            SSDV(0, bflo(a[u].x), bflo(c[u].x), bflo(x[u].x), bflo(z[u].x)); SSDV(1, bfhi(a[u].x), bfhi(c[u].x), bfhi(x[u].x), bfhi(z[u].x));
            SSDV(2, bflo(a[u].y), bflo(c[u].y), bflo(x[u].y), bflo(z[u].y)); SSDV(3, bfhi(a[u].y), bfhi(c[u].y), bfhi(x[u].y), bfhi(z[u].y));
            SSDV(4, bflo(a[u].z), bflo(c[u].z), bflo(x[u].z), bflo(z[u].z)); SSDV(5, bfhi(a[u].z), bfhi(c[u].z), bfhi(x[u].z), bfhi(z[u].z));
            SSDV(6, bflo(a[u].w), bflo(c[u].w), bflo(x[u].w), bflo(z[u].w)); SSDV(7, bfhi(a[u].w), bfhi(c[u].w), bfhi(x[u].w), bfhi(z[u].w));
#undef SSDV
            float ss = 0.f;
#pragma unroll
            for (int i = 0; i < 8; ++i) ss += v[i] * v[i];
            ss += __shfl_xor(ss, 1); ss += __shfl_xor(ss, 2); ss += __shfl_xor(ss, 4); ss += __shfl_xor(ss, 8); ss += __shfl_xor(ss, 16);
            const float rstd = rsqrtf(ss * (1.f / 256.f) + EPS);
            u32x4 w; w.x = pk2(v[0] * rstd * nw[0], v[1] * rstd * nw[1]); w.y = pk2(v[2] * rstd * nw[2], v[3] * rstd * nw[3]); w.z = pk2(v[4] * rstd * nw[4], v[5] * rstd * nw[5]); w.w = pk2(v[6] * rstd * nw[6], v[7] * rstd * nw[7]);
            *(u32x4*)(Y + (unsigned)(row * 1024 + 512 + c0) * 2u) = w; }
    }
}
__device__ __forceinline__ void ph_scan_c(Ctx& F) {
    const bool deal = (F.G == 256);
    const int first = deal ? (F.bid < 128 ? F.bid : 128 + 2 * (F.bid - 128)) : F.bid;
    const int count = deal ? (F.bid < 128 ? 1 : 2) : (384 - F.bid + F.G - 1) / F.G;
    const int step = deal ? 1 : F.G;
#pragma unroll 1
    for (int k2 = 0; k2 < 2 * count; ++k2) {
        const int pit = first + (k2 >> 1) * step, d = k2 & 1;
        { GAS unsigned char* g = (GAS unsigned char*)F.ws; asm volatile("" : "+s"(g)); F.ws = (unsigned char*)g; }
        if (pit < 128) { const int seg = 1 + (pit & 15); ssd_item<true>(F, (pit >> 4) * 2 + d, d ? 17 - seg : seg); }
        else { const int seg = 1 + ((pit - 128) & 15); gla_item<true>(F, ((pit - 128) >> 4) * 2 + d, d ? 17 - seg : seg); }
        if (d) {
            asm volatile("s_waitcnt vmcnt(0)" ::: "memory"); __syncthreads();
            if (pit < 128) combine_ssd_block(F, pit >> 5, (pit >> 4) & 1, 1 + (pit & 15));
            else combine_gla_block(F, (pit - 128) >> 6, ((pit - 128) >> 4) & 3, 1 + ((pit - 128) & 15));
        }
    }
}

#define UNP(dst, w0, w1) dst[0] = bflo(w0.x); dst[1] = bfhi(w0.x); dst[2] = bflo(w0.y); dst[3] = bfhi(w0.y); dst[4] = bflo(w0.z); dst[5] = bfhi(w0.z); dst[6] = bflo(w0.w); dst[7] = bfhi(w0.w); \
        dst[8] = bflo(w1.x); dst[9] = bfhi(w1.x); dst[10] = bflo(w1.y); dst[11] = bfhi(w1.y); dst[12] = bflo(w1.z); dst[13] = bfhi(w1.z); dst[14] = bflo(w1.w); dst[15] = bfhi(w1.w)
__device__ __forceinline__ void ph_combine(Ctx& F) {
    const bf16_t* P = (const bf16_t*)(F.ws + WS_P); const bf16_t* XBC = (const bf16_t*)(F.ws + WS_XBC);
    const bf16_t* OG = (const bf16_t*)(F.ws + WS_OG); const bf16_t* OS = (const bf16_t*)(F.ws + WS_OS); bf16_t* Y = (bf16_t*)(F.ws + WS_Y);
    const int gw = F.bid * 8 + F.wave, NGW = F.G * 8, l = F.lane;
    const bool gla = l < 32; const int c0 = gla ? 16 * l : 16 * (l - 32);
    float nwv[16]; { const float* nw = gla ? GIN(F, IN_GLANORM) + (c0 & 127) : GIN(F, IN_SSDNORM) + c0;
#pragma unroll
        for (int i = 0; i < 16; ++i) nwv[i] = nw[i]; }
    const float Dh = GIN(F, IN_SSDD)[c0 >> 6];
    constexpr int U = 4;
    for (int r0 = gw * U; r0 < TL; r0 += NGW * U) {
        u32x4 a0[U], a1[U], b0[U], b1[U], g0[U], g1[U], x0[U], x1[U];
#pragma unroll
        for (int u = 0; u < U; ++u) { const int r = r0 + u;
            const bf16_t* o0 = (gla ? OG : OS) + (size_t)r * 512 + c0; const bf16_t* o1 = o0 + (size_t)TL * 512;
            const bf16_t* gz = P + (size_t)r * NP + (gla ? CG : CZ) + c0; const bf16_t* xp = XBC + (size_t)r * 1024 + c0;
            a0[u] = *(const u32x4*)o0; a1[u] = *(const u32x4*)(o0 + 8); b0[u] = *(const u32x4*)o1; b1[u] = *(const u32x4*)(o1 + 8); g0[u] = *(const u32x4*)gz; g1[u] = *(const u32x4*)(gz + 8);
            x0[u] = (u32x4){0u, 0u, 0u, 0u}; x1[u] = x0[u];
            if (!gla) { x0[u] = *(const u32x4*)xp; x1[u] = *(const u32x4*)(xp + 8); } }
#pragma unroll
        for (int u = 0; u < U; ++u) { const int r = r0 + u;
            float v[16], gt[16], t0[16], t1[16], xv[16]; UNP(t0, a0[u], a1[u]); UNP(t1, b0[u], b1[u]); UNP(gt, g0[u], g1[u]); UNP(xv, x0[u], x1[u]);
#pragma unroll
            for (int i = 0; i < 16; ++i) { const float sg = silu_f(gt[i]); v[i] = gla ? (t0[i] + t1[i]) : (t0[i] + t1[i] + Dh * xv[i]) * sg; gt[i] = sg; }
            float ss = 0.f;
#pragma unroll
            for (int i = 0; i < 16; ++i) ss += v[i] * v[i];
            ss += __shfl_xor(ss, 1); ss += __shfl_xor(ss, 2); ss += __shfl_xor(ss, 4);
            const float s8 = __shfl_xor(ss, 8); if (!gla) ss += s8;
            const float rstd = rsqrtf(ss * (gla ? (1.f / 128.f) : (1.f / 256.f)) + EPS);
            float o[16];
#pragma unroll
            for (int i = 0; i < 16; ++i) { float y = v[i] * rstd * nwv[i]; if (gla) y *= gt[i]; o[i] = y; }
            u32x4 w0, w1; w0.x = pk2(o[0], o[1]); w0.y = pk2(o[2], o[3]); w0.z = pk2(o[4], o[5]); w0.w = pk2(o[6], o[7]); w1.x = pk2(o[8], o[9]); w1.y = pk2(o[10], o[11]); w1.z = pk2(o[12], o[13]); w1.w = pk2(o[14], o[15]);
            bf16_t* yp = Y + (size_t)r * 1024 + (gla ? 0 : 512) + c0;
            *(u32x4*)yp = w0; *(u32x4*)(yp + 8) = w1; }
    }
}

constexpr int WRP = 1032;
__device__ __forceinline__ void ph_router(Ctx& F) {
    const float* mod = (const float*)(F.ws + WS_MOD); unsigned char* H2 = (unsigned char*)(F.ws + WS_H);
    unsigned* ctl = (unsigned*)(F.ws + WS_CTL);
    int* tok_e = (int*)(F.ws + WS_TOKE); int* tok_p = (int*)(F.ws + WS_TOKP); float* tok_g = (float*)(F.ws + WS_TOKG); int* rowtok = (int*)(F.ws + WS_ROWTOK);
    LAS bf16_t* WTh = (LAS bf16_t*)F.lds;
    LAS bf16_t* WTl = WTh + 32 * WRP;
    static_assert(2 * 32 * WRP * 2 <= MISC_OFF, "split router weights fit below the MISC tables");
    LAS int* lcnt = (LAS int*)(F.lds + MISC_OFF);
    LAS int* gbase = lcnt + 32;
    LAS int* rec_e = gbase + 32;
    LAS int* rec_p = rec_e + 512;
    LAS float* biasl = (LAS float*)(rec_p + 512);
    LAS float* rsl = biasl + 32;
    LAS float* wpl = rsl + 128;
    LAS float* shl = wpl + 1024;
    const int l = F.lane, i16 = l & 15, kk = l >> 4, w = F.wave;
    if (F.bid == 0) { for (int i = F.tid; i < 256; i += 512) ((unsigned*)(H2 + (size_t)ZROW * DM))[i] = 0u; }
    int cur_b = -1;
    for (int tile = F.bid; tile < TL / 128; tile += F.G) {
        const int b = (tile * 128) >> 13;
        if (b != cur_b) {
            cur_b = b;
            __syncthreads();
            const float* sh = mod + b * 6144 + 3 * 1024; const float* scl = sh + 1024;
            for (int k = F.tid; k < 1024; k += 512) { wpl[k] = GIN(F, IN_NORM2)[k] * (1.f + scl[k]); shl[k] = sh[k]; }
            if (F.tid < 32) lcnt[F.tid] = 0;
            __syncthreads();
            { float ba = 0.f;
#pragma unroll 16
              for (int j = 0; j < 64; ++j) { const int i = F.tid + 512 * j, k = i >> 5, e = i & 31; const float wr = GIN(F, IN_WR)[i]; const float wv = wr * wpl[k]; ba += shl[k] * wr;
                const unsigned hb = pk2(wv, 0.f) & 0xffffu; const float hi = __builtin_bit_cast(float, hb << 16);
                WTh[e * WRP + k] = (bf16_t)hb; WTl[e * WRP + k] = (bf16_t)(pk2(wv - hi, 0.f) & 0xffffu); }
              LAS float* red = (LAS float*)(rec_e);
              red[(F.tid >> 5) * 32 + (F.tid & 31)] = ba; }
            __syncthreads();
            if (F.tid < 32) { float a = GIN(F, IN_BR)[F.tid];
#pragma unroll
                for (int q = 0; q < 16; ++q) a += ((LAS float*)rec_e)[q * 32 + F.tid];
                biasl[F.tid] = a; }
            __syncthreads();
        }
        const int row = tile * 128 + w * 16 + i16;
        const bf16_t* X1 = (const bf16_t*)(F.ws + WS_X1);
        const bf16_t* xr = X1 + (size_t)row * DM + 8 * kk;
        const LAS bf16_t* wh0 = WTh + i16 * WRP + 8 * kk; const LAS bf16_t* wl0 = WTl + i16 * WRP + 8 * kk;
        f32x4 a0 = (f32x4){0.f, 0.f, 0.f, 0.f}, a1 = a0; float ss = 0.f;
#pragma unroll 1
        for (int qh = 0; qh < 32; qh += 16) {
            u32x4 xq[16];
#pragma unroll
            for (int q = 0; q < 16; ++q) xq[q] = *(const u32x4*)(xr + 32 * (qh + q));
#pragma unroll
            for (int q = 0; q < 16; ++q) { const u32x4 xb = xq[q]; const bf16x8 xa = __builtin_bit_cast(bf16x8, xb); const int qq = qh + q;
                const bf16x8 h0 = *(const LAS bf16x8*)(wh0 + 32 * qq), h1 = *(const LAS bf16x8*)(wh0 + 16 * WRP + 32 * qq), l0 = *(const LAS bf16x8*)(wl0 + 32 * qq), l1 = *(const LAS bf16x8*)(wl0 + 16 * WRP + 32 * qq);
                { const float x0 = bflo(xb.x), x1v = bfhi(xb.x), x2 = bflo(xb.y), x3 = bfhi(xb.y), x4 = bflo(xb.z), x5 = bfhi(xb.z), x6 = bflo(xb.w), x7 = bfhi(xb.w);
                  ss += (x0 * x0 + x1v * x1v) + (x2 * x2 + x3 * x3) + (x4 * x4 + x5 * x5) + (x6 * x6 + x7 * x7); }
                a0 = __builtin_amdgcn_mfma_f32_16x16x32_bf16(xa, h0, a0, 0, 0, 0); a1 = __builtin_amdgcn_mfma_f32_16x16x32_bf16(xa, h1, a1, 0, 0, 0);
                a0 = __builtin_amdgcn_mfma_f32_16x16x32_bf16(xa, l0, a0, 0, 0, 0); a1 = __builtin_amdgcn_mfma_f32_16x16x32_bf16(xa, l1, a1, 0, 0, 0); }
        }
        ss += __shfl_xor(ss, 16); ss += __shfl_xor(ss, 32);
        const float rstd_i = rsqrtf(ss * (1.f / DM) + EPS);
        if (kk == 0) rsl[w * 16 + i16] = rstd_i;
        LDS_WAIT(); asm volatile("" ::: "memory");
        const f32x4 rs4 = *(const LAS f32x4*)(rsl + w * 16 + 4 * kk);
        const float bz0 = biasl[i16], bz1 = biasl[16 + i16];
        float v0[4], v1[4];
#pragma unroll
        for (int r = 0; r < 4; ++r) { v0[r] = a0[r] * rs4[r] + bz0; v1[r] = a1[r] * rs4[r] + bz1; }
        int ei[4][4]; float ev[4][4];
#pragma unroll
        for (int k = 0; k < 4; ++k)
#pragma unroll
            for (int r = 0; r < 4; ++r) { float bv = v0[r]; int bi = i16; if (v1[r] > bv) { bv = v1[r]; bi = 16 + i16; }
#pragma unroll
                for (int o = 1; o < 16; o <<= 1) { const float ov = __shfl_xor(bv, o); const int oi = __shfl_xor(bi, o); if (ov > bv || (ov == bv && oi < bi)) { bv = ov; bi = oi; } }
                ei[k][r] = bi; ev[k][r] = bv; if (bi == i16) v0[r] = -3.3e38f; if (bi == 16 + i16) v1[r] = -3.3e38f; }
        if (i16 == 0) {
#pragma unroll
            for (int r = 0; r < 4; ++r) { const int tl = w * 16 + 4 * kk + r, rr = tile * 128 + tl;
                const float e1 = __expf(ev[1][r] - ev[0][r]), e2 = __expf(ev[2][r] - ev[0][r]), e3 = __expf(ev[3][r] - ev[0][r]); const float inv = 1.f / (1.f + e1 + e2 + e3);
                const float gts[4] = {inv, e1 * inv, e2 * inv, e3 * inv};
#pragma unroll
                for (int k = 0; k < 4; ++k) { const int lp = __hip_atomic_fetch_add(lcnt + ei[k][r], 1, __ATOMIC_RELAXED, __HIP_MEMORY_SCOPE_WORKGROUP);
                    rec_e[tl * 4 + k] = ei[k][r]; rec_p[tl * 4 + k] = lp; tok_g[(size_t)rr * 4 + k] = gts[k]; } }
        }
        __syncthreads();
        if (F.tid < 32) gbase[F.tid] = (int)__hip_atomic_fetch_add(ctl + CW_CNT + 64 * F.tid, (unsigned)lcnt[F.tid], __ATOMIC_RELAXED, __HIP_MEMORY_SCOPE_AGENT);
        { f32x4 wp[4], s4[4];
#pragma unroll
          for (int j = 0; j < 4; ++j) { wp[j] = *(const LAS f32x4*)(wpl + 16 * l + 4 * j) * HSCALE8; s4[j] = *(const LAS f32x4*)(shl + 16 * l + 4 * j) * HSCALE8; }
#pragma unroll 1
          for (int t0 = 0; t0 < 16; t0 += 8) {
              u32x4 xa[8], xb[8];
#pragma unroll
              for (int t = 0; t < 8; ++t) { const bf16_t* xp = X1 + (size_t)(tile * 128 + w * 16 + t0 + t) * DM + 16 * l; xa[t] = *(const u32x4*)xp; xb[t] = *(const u32x4*)(xp + 8); }
#pragma unroll
              for (int t = 0; t < 8; ++t) { const float rs = rsl[w * 16 + t0 + t];
                  const f32x4 v0 = (f32x4){bflo(xa[t].x), bfhi(xa[t].x), bflo(xa[t].y), bfhi(xa[t].y)} * rs * wp[0] + s4[0], v1 = (f32x4){bflo(xa[t].z), bfhi(xa[t].z), bflo(xa[t].w), bfhi(xa[t].w)} * rs * wp[1] + s4[1];
                  const f32x4 v2 = (f32x4){bflo(xb[t].x), bfhi(xb[t].x), bflo(xb[t].y), bfhi(xb[t].y)} * rs * wp[2] + s4[2], v3 = (f32x4){bflo(xb[t].z), bfhi(xb[t].z), bflo(xb[t].w), bfhi(xb[t].w)} * rs * wp[3] + s4[3];
                  u32x4 o; o.x = pg8::pk4_fp8(v0.x, v0.y, v0.z, v0.w); o.y = pg8::pk4_fp8(v1.x, v1.y, v1.z, v1.w); o.z = pg8::pk4_fp8(v2.x, v2.y, v2.z, v2.w); o.w = pg8::pk4_fp8(v3.x, v3.y, v3.z, v3.w);
                  *(u32x4*)(H2 + (size_t)(tile * 128 + w * 16 + t0 + t) * DM + 16 * l) = o; } } }
        __syncthreads();
        { const int tl = F.tid >> 2, r = tile * 128 + tl; const int e = rec_e[F.tid], pos = gbase[e] + rec_p[F.tid];
          tok_e[(size_t)r * 4 + (F.tid & 3)] = e; tok_p[(size_t)r * 4 + (F.tid & 3)] = pos; rowtok[(size_t)e * TL + pos] = r; }
        __syncthreads();
        if (F.tid < 32) lcnt[F.tid] = 0;
        __syncthreads();
    }
}

__device__ __forceinline__ void moe_tables(Ctx& F, LAS int*& cn, LAS int*& tb) {
    const unsigned* ctl = (const unsigned*)(F.ws + WS_CTL);
    cn = (LAS int*)(F.lds + MISC_OFF); tb = cn + 32;
    __syncthreads();
    if (F.tid < 32) cn[F.tid] = (int)__hip_atomic_load(ctl + CW_CNT + 64 * F.tid, __ATOMIC_RELAXED, __HIP_MEMORY_SCOPE_AGENT);
    __syncthreads();
    if (F.tid == 0) { int s = 0; for (int e = 0; e < 32; ++e) { tb[e] = s; s += (cn[e] + 255) >> 8; } tb[32] = s; }
    __syncthreads();
}

__device__ __forceinline__ void ph_final(Ctx& F, float* dst) {
    LAS int* cn; LAS int* tb; moe_tables(F, cn, tb);
    const float* mod = (const float*)(F.ws + WS_MOD); const unsigned char* YP = (const unsigned char*)(F.ws + WS_YP);
    const int* tok_e = (const int*)(F.ws + WS_TOKE); const int* tok_p = (const int*)(F.ws + WS_TOKP); const float* tok_g = (const float*)(F.ws + WS_TOKG);
    const int gw = F.bid * 8 + F.wave, NGW = F.G * 8;
    f32x4 fn[4];
#pragma unroll
    for (int q = 0; q < 4; ++q) fn[q] = *(const f32x4*)(GIN(F, IN_FNORM) + 4 * (F.lane + 64 * q));
    constexpr int U = 2;
    int4 ne[U], np[U]; f32x4 ng[U];
#pragma unroll
    for (int u = 0; u < U; ++u) { const int r = gw * U + u; ne[u] = *(const int4*)(tok_e + (size_t)r * 4); np[u] = *(const int4*)(tok_p + (size_t)r * 4); ng[u] = *(const f32x4*)(tok_g + (size_t)r * 4); }
    for (int r0 = gw * U; r0 < TL; r0 += NGW * U) {
        const unsigned char* yr[U][4]; float gt[U][4];
#pragma unroll
        for (int u = 0; u < U; ++u) { const int4 e4 = ne[u], p4 = np[u]; const f32x4 g4 = ng[u];
            yr[u][0] = YP + ((size_t)tb[e4.x] * 256 + p4.x) * DM; yr[u][1] = YP + ((size_t)tb[e4.y] * 256 + p4.y) * DM; yr[u][2] = YP + ((size_t)tb[e4.z] * 256 + p4.z) * DM; yr[u][3] = YP + ((size_t)tb[e4.w] * 256 + p4.w) * DM;
            gt[u][0] = g4.x * (1.0f / PSCALE8); gt[u][1] = g4.y * (1.0f / PSCALE8); gt[u][2] = g4.z * (1.0f / PSCALE8); gt[u][3] = g4.w * (1.0f / PSCALE8); }
        unsigned yw[U][4][4]; f32x4 xv[U][4];
        if (r0 + NGW * U < TL) {
#pragma unroll
            for (int u = 0; u < U; ++u) { const int r = r0 + NGW * U + u; ne[u] = *(const int4*)(tok_e + (size_t)r * 4); np[u] = *(const int4*)(tok_p + (size_t)r * 4); ng[u] = *(const f32x4*)(tok_g + (size_t)r * 4); } }
#pragma unroll
        for (int u = 0; u < U; ++u) {
#pragma unroll
            for (int k = 0; k < 4; ++k)
#pragma unroll
                for (int q = 0; q < 4; ++q) yw[u][k][q] = *(const unsigned*)(yr[u][k] + 4 * (F.lane + 64 * q));
#pragma unroll
            for (int q = 0; q < 4; ++q) { const u32x2 xb = ((const u32x2*)((const bf16_t*)(F.ws + WS_X1) + (size_t)(r0 + u) * DM))[F.lane + 64 * q]; xv[u][q] = (f32x4){bflo(xb.x), bfhi(xb.x), bflo(xb.y), bfhi(xb.y)}; } }
#pragma unroll
        for (int u = 0; u < U; ++u) { const int r = r0 + u; const int b = r >> 13; const float* g2 = mod + b * 6144 + 5 * 1024;
            f32x4 v[4]; float ss = 0.f;
#pragma unroll
            for (int q = 0; q < 4; ++q) { f32x4 m = (f32x4){0.f, 0.f, 0.f, 0.f};
#pragma unroll
                for (int k = 0; k < 4; ++k) { const unsigned w = yw[u][k][q]; const f32x2 lo = __builtin_amdgcn_cvt_pk_f32_fp8((int)w, false), hi = __builtin_amdgcn_cvt_pk_f32_fp8((int)w, true); m += (f32x4){lo.x, lo.y, hi.x, hi.y} * gt[u][k]; }
                v[q] = xv[u][q] + *(const f32x4*)(g2 + 4 * (F.lane + 64 * q)) * m;
                ss += (v[q].x * v[q].x + v[q].y * v[q].y) + (v[q].z * v[q].z + v[q].w * v[q].w); }
            const float rstd = rsqrtf(wave_sum(ss) * (1.f / DM) + EPS);
#pragma unroll
            for (int q = 0; q < 4; ++q) ((f32x4*)(dst + (size_t)r * DM))[F.lane + 64 * q] = v[q] * rstd * fn[q]; }
    }
}

constexpr int NPHASE = 13;
__global__ void __launch_bounds__(512, 2) mega(Params p) {
    extern __shared__ __attribute__((aligned(16))) unsigned char lds_raw[];
    Ctx F;
    F.lds = (LAS unsigned char*)lds_raw; F.tid = threadIdx.x; F.lane = F.tid & 63; F.wave = __builtin_amdgcn_readfirstlane(F.tid >> 6); F.bid = blockIdx.x; F.G = gridDim.x;
    F.in = p.in; F.out = (float*)(GAS float*)p.out; F.ws = (unsigned char*)(GAS unsigned char*)p.ws;
    const int lo = p.ph_lo, hi = p.ph_hi;
#ifndef PH_MASK
#define PH_MASK 0x1fff
#endif
#define IN(k) (((PH_MASK >> (k)) & 1) && lo <= (k) && (k) < hi)
#ifndef PH_REP
#define PH_REP 0
#endif
#ifndef XBAR_EXTRA
#define XBAR_EXTRA 0
#endif
#define REPS(k) (1 + ((PH_REP >> (k)) & 1))
#define RUN(k, ...) do { if (IN(k)) { if (REPS(k) > 1) { const int _rep = 0; __VA_ARGS__; __syncthreads(); } { const int _rep = REPS(k) - 1; __VA_ARGS__; } } } while (0)
#define RUN1(k, ...) do { if (IN(k)) { __VA_ARGS__; } } while (0)
#if MK_FUSED
    volatile LAS unsigned* bst = (volatile LAS unsigned*)(F.lds + LDS_BYTES - 64);
    if (F.tid < 16) bst[F.tid] = 0u;
    __syncthreads();
    XcdBarrier bar = xcd_barrier_post((unsigned*)(F.ws + WS_CTL) + CW_BAR, bst);
#define SEAM(k) do { if (IN(k) && IN((k) + 1)) { xcd_barrier(bar); } } while (0)
#else
#define SEAM(k) do { } while (0)
#endif
    RUN(0, ph_prologue(F)); SEAM(0);
    RUN(1, ph_norm1(F)); SEAM(1);
#if MK_FUSED
    for (int _x = 0; _x < XBAR_EXTRA; ++_x) xcd_barrier(bar);
#endif
    RUN1(2, {
        constexpr int NSETS = (NEXP * 8 * 64 + NEXP * 8 * 32) / 8, NTILE = (TT / 256) * (NP / 256), CPT = 4;
        const int c_hi = NTILE % F.G == 0 ? F.G : NTILE % F.G;
        const int n_lo = (NSETS - CPT * (F.G - c_hi) + F.G - 1) / F.G < 0 ? 0 : (NSETS - CPT * (F.G - c_hi) + F.G - 1) / F.G, n_hi = n_lo + CPT;
        const int grp = (F.bid >> 3) & 7, cut = __builtin_amdgcn_readfirstlane(grp == 7 ? (1 << 20) : grp);
        _Pragma("unroll 1") for (int part = 0; part < 2; ++part) {
            if (part) { __syncthreads(); expert_weight_copies(F, c_hi, n_lo, n_hi); __syncthreads(); }
            const pg8::DenseOrder S{TT / 256, NP / 256, F.G, F.bid, (const char*)(F.ws + WS_WIN), 2048u, 1, part ? cut : 0, part ? (1 << 20) : cut};
            const pg8::EpiBf16 E{(bf16_t*)(F.ws + WS_P), NP, nullptr, 0, 1.0f};
            pg8::gemm_phase<pg8::EpiBf16, pg8::DenseOrder, true>(F.lds, (const bf16_t*)(F.ws + WS_H), S, E);
        }
    }); SEAM(2);
    RUN(3, ph_conv_g(F)); SEAM(3);
#if MK_NAIVE_SCAN
    RUN(4, ph_scan_naive(F)); SEAM(4); SEAM(5);
#else
    RUN(4, ph_scan_a(F)); SEAM(4);
    RUN(5, ph_scan_b(F)); SEAM(5);
    RUN(6, ph_scan_c(F));
#endif
    SEAM(6);
    RUN1(8, {
        pg8::DenseOrder S{TL / 256, DM / 256, F.G, F.bid, (const char*)(F.ws + WS_WOUT), 2048u, REPS(8)};
        pg8::EpiResGate E{GIN(F, IN_X), (bf16_t*)(F.ws + WS_X1), (const float*)(F.ws + WS_MOD)};
        pg8::gemm_phase<pg8::EpiResGate, pg8::DenseOrder, true>(F.lds, (const bf16_t*)(F.ws + WS_Y), S, E);
    }); SEAM(8);
    RUN(9, ph_router(F)); SEAM(9);
#if MK_FUSED
    RUN1(10, {
        LAS int* cn; LAS int* tb; moe_tables(F, cn, tb);
        const int nMt = __builtin_amdgcn_readfirstlane(tb[32]);
        unsigned* sb1 = (unsigned*)(F.ws + WS_CTL) + CW_SB; unsigned* sb2 = sb1 + 2048;
        int a1;
        {   pg8::MoeOrder<true> S{nMt, 8, F.G, F.bid, (const char*)(F.ws + WS_WGU), 2048, tb, cn, (const int*)(F.ws + WS_ROWTOK), 1024u, 0};
            pg8::EpiSwiglu E{(unsigned char*)(F.ws + WS_ACT), GIN(F, IN_BGU), 1.0f / (HSCALE8 * WSCALE8), ASCALE8, (LAS float*)(F.lds + MISC_OFF + 2048)};
            a1 = (S.trips() * 3) / 4; a1 = a1 < 1 ? 1 : a1;
            ArriveSync Y{&bar, sb1, a1, false};
            pg8::gemm_phase<pg8::EpiSwiglu, pg8::MoeOrder<true>, true, true, ArriveSync>(F.lds, (const bf16_t*)(F.ws + WS_H), S, E, &Y);
            if (F.tid == 0) { if (!Y.done) sb_arrive(bar, sb1); sb_arrive(bar, sb2); }
        }
        if (IN(11)) {
            if (F.tid == 0) sb_wait(bar, sb1);
            __syncthreads();
            pg8::MoeOrder<false> S{nMt, 4, F.G, F.bid, (const char*)(F.ws + WS_WD), 1024, tb, cn, nullptr, 1024u, 8};
            pg8::EpiFp8 E{(unsigned char*)(F.ws + WS_YP), DM, GIN(F, IN_BD), 1024, 1.0f / (ASCALE8 * WSCALE8), PSCALE8, (LAS float*)(F.lds + MISC_OFF + 2048)};
            WaitSync<pg8::MoeOrder<false>> Y{&bar, sb2, a1, false, &S, 8};
            pg8::gemm_phase<pg8::EpiFp8, pg8::MoeOrder<false>, true, true, WaitSync<pg8::MoeOrder<false>>>(F.lds, (const bf16_t*)(F.ws + WS_ACT), S, E, &Y);
        }
    }); SEAM(11);
#else
    RUN1(10, {
        LAS int* cn; LAS int* tb; moe_tables(F, cn, tb);
        pg8::MoeOrder<true> S{__builtin_amdgcn_readfirstlane(tb[32]), 8, F.G, F.bid, (const char*)(F.ws + WS_WGU), 2048, tb, cn, (const int*)(F.ws + WS_ROWTOK), 1024u, 0};
        pg8::EpiSwiglu E{(unsigned char*)(F.ws + WS_ACT), GIN(F, IN_BGU), 1.0f / (HSCALE8 * WSCALE8), ASCALE8, (LAS float*)(F.lds + MISC_OFF + 2048)};
        pg8::gemm_phase<pg8::EpiSwiglu, pg8::MoeOrder<true>, true, true>(F.lds, (const bf16_t*)(F.ws + WS_H), S, E);
    });
    RUN1(11, {
        LAS int* cn; LAS int* tb; moe_tables(F, cn, tb);
        pg8::MoeOrder<false> S{__builtin_amdgcn_readfirstlane(tb[32]), 4, F.G, F.bid, (const char*)(F.ws + WS_WD), 1024, tb, cn, nullptr, 1024u, 0};
        pg8::EpiFp8 E{(unsigned char*)(F.ws + WS_YP), DM, GIN(F, IN_BD), 1024, 1.0f / (ASCALE8 * WSCALE8), PSCALE8, (LAS float*)(F.lds + MISC_OFF + 2048)};
        pg8::gemm_phase<pg8::EpiFp8, pg8::MoeOrder<false>, true, true>(F.lds, (const bf16_t*)(F.ws + WS_ACT), S, E);
    });
#endif
    RUN(12, ph_final(F, (_rep + 1 < REPS(12)) ? (float*)(F.ws + WS_ACT) : F.out));
#undef IN
#undef SEAM
#undef RUN
#undef RUN1
}

extern "C" void kernel_launch(void* const* d_in, const int* in_sizes, int n_in, void* d_out, int out_size, void* d_ws, size_t ws_size, hipStream_t stream) {
    static int grid = 0;
    if (grid == 0) {
        if (n_in != 26 || out_size != TL * DM || ws_size < WS_END) { fprintf(stderr, "kernel_launch: unexpected problem (n_in %d, out %d, ws %zu)\n", n_in, out_size, ws_size); grid = -1; return; }
        int dev = 0, cus = 0, per_cu = 0;
        if (hipGetDevice(&dev) != hipSuccess || hipDeviceGetAttribute(&cus, hipDeviceAttributeMultiprocessorCount, dev) != hipSuccess) { grid = -1; return; }
        if (hipFuncSetAttribute((const void*)mega, hipFuncAttributeMaxDynamicSharedMemorySize, LDS_BYTES) != hipSuccess) { fprintf(stderr, "kernel_launch: hipFuncSetAttribute failed\n"); grid = -1; return; }
        if (hipOccupancyMaxActiveBlocksPerMultiprocessor(&per_cu, (const void*)mega, 512, LDS_BYTES) != hipSuccess || per_cu < 1) { fprintf(stderr, "kernel_launch: occupancy query says %d\n", per_cu); per_cu = 1; }
        (void)hipGetLastError();
        grid = cus;
    }
    if (grid < 0) return;
    (void)hipMemsetAsync((char*)d_ws + WS_CTL, 0, CTL_ZERO, stream);
    Params a{};
    for (int i = 0; i < 26; ++i) a.in[i] = (const float*)d_in[i];
    a.out = (float*)d_out; a.ws = (unsigned char*)d_ws;
#if MK_FUSED
    a.ph_lo = 0; a.ph_hi = NPHASE;
    hipLaunchKernelGGL(mega, dim3(grid), dim3(512), LDS_BYTES, stream, a);
#else
    for (int ph = 0; ph < NPHASE; ++ph) {
        a.ph_lo = ph; a.ph_hi = ph + 1;
        hipLaunchKernelGGL(mega, dim3(grid), dim3(512), LDS_BYTES, stream, a);
    }
#endif
}
```

```cpp
#include <hip/hip_runtime.h>
#include <hip/hip_cooperative_groups.h>
#include <cstdio>
#include <cstdint>
namespace cg = cooperative_groups;

#ifndef MK_FUSED
#define MK_FUSED 1
#endif
#ifndef MK_NAIVE_SCAN
#define MK_NAIVE_SCAN 0
#endif

#define LAS __attribute__((address_space(3)))
#define GAS __attribute__((address_space(1)))
typedef unsigned short bf16_t;
typedef short bf16x8 __attribute__((ext_vector_type(8)));
typedef float f32x4 __attribute__((ext_vector_type(4)));
typedef float f32x2 __attribute__((ext_vector_type(2)));
typedef unsigned u32x4 __attribute__((ext_vector_type(4)));
typedef unsigned u32x2 __attribute__((ext_vector_type(2)));

constexpr int NB = 4, SEQ = 8192, CTXL = 256, DM = 1024;
constexpr int TL = NB * SEQ;
constexpr int TCX = NB * CTXL;
constexpr int TT = TL + TCX;
constexpr int NP = 3328;
constexpr int CQ = 0, CK = 256, CV = 512, CG = 1024, CZ = 1536, CX = 2048, CGK = 3072, CDT = 3088;
constexpr int NEXP = 32, DFF = 1024;
#define OUTPROJ_FP8 1
constexpr float YSCALE8 = 8.0f;
constexpr float EPS = 1e-6f;
constexpr int MAXTILES = 544;
constexpr int ZROW = TL;

constexpr size_t MiB = 1u << 20;
constexpr size_t WS_CTL = 0, CTL_BYTES = 1 * MiB;
constexpr size_t WS_MOD = 1 * MiB;
constexpr size_t WS_WIN = 2 * MiB;
constexpr size_t WS_WOUT = 9 * MiB;
constexpr size_t WS_WGU = 11 * MiB;
constexpr size_t WS_WD = 139 * MiB;
constexpr size_t WS_TOKE = 203 * MiB;
constexpr size_t WS_TOKP = WS_TOKE + 512 * 1024;
constexpr size_t WS_TOKG = WS_TOKP + 512 * 1024;
constexpr size_t WS_ROWTOK = 205 * MiB;
constexpr size_t WS_H = 209 * MiB;
constexpr size_t WS_P = 276 * MiB;
constexpr size_t WS_XBC = 491 * MiB;
constexpr size_t WS_G = 557 * MiB;
constexpr size_t WS_OG = 623 * MiB;
constexpr size_t WS_OS = 687 * MiB;
constexpr size_t WS_Y = 751 * MiB;
constexpr size_t WS_ACT = 276 * MiB;
constexpr size_t WS_YP = 548 * MiB;
constexpr size_t WS_USG = 820 * MiB;
constexpr size_t WS_SSG = 837 * MiB;
constexpr size_t WS_USS = 853 * MiB;
constexpr size_t WS_SSS = 887 * MiB;
constexpr size_t WS_ASG = 919 * MiB;
constexpr size_t WS_ASS = 920 * MiB;
constexpr size_t WS_X1 = WS_OS;
constexpr size_t WS_END = 921 * MiB;
static_assert(WS_YP + (size_t)MAXTILES * 256 * 1024 <= WS_X1, "x1 buffer clear of the fp8 Yp overlay");
static_assert(WS_P + (size_t)TT * NP * 2 <= WS_XBC && WS_XBC + (size_t)TT * 1024 * 2 <= WS_G && WS_G + (size_t)2 * TT * 256 * 4 <= WS_OG, "ws map");
static_assert(WS_ACT + (size_t)MAXTILES * 256 * 2048 <= WS_YP && WS_YP + (size_t)MAXTILES * 256 * 2048 <= WS_END, "ws map 2");
static_assert(WS_H + (size_t)(TT + 256) * 2048 <= WS_P, "ws map 3");
constexpr int CW_CNT = 1024;
constexpr int CW_BAR = 8192;
constexpr int CW_SB = 12288;
constexpr size_t CTL_ZERO = 114688;
static_assert((CW_BAR + 3456) <= CW_SB && (CW_SB + 16384) * 4 <= (int)CTL_ZERO && (CW_CNT + 64 * 32) * 4 <= (int)CTL_ZERO, "control words inside the per-call memset");

constexpr int RING_BYTES = 131072;
constexpr int MISC_OFF = 132096;
constexpr int LDS_BYTES = 147456;

struct Params { const float* in[26]; float* out; unsigned char* ws; int ph_lo, ph_hi; };

__device__ __forceinline__ unsigned f2bf(float f) { unsigned u = __builtin_bit_cast(unsigned, f); return (u + 0x7fffu + ((u >> 16) & 1u)) >> 16; }
typedef __bf16 bf16x2_t __attribute__((ext_vector_type(2)));
__device__ __forceinline__ unsigned pk2(float lo, float hi) { const f32x2 v = {lo, hi}; const bf16x2_t b = __builtin_convertvector(v, bf16x2_t); return __builtin_bit_cast(unsigned, b); }
__device__ __forceinline__ unsigned pk2(float lo, float hi);
__device__ __forceinline__ float bflo(unsigned w);
__device__ __forceinline__ float bfhi(unsigned w);
__device__ __forceinline__ f32x4 ld_bf4(const bf16_t* p) { const u32x2 w = *(const u32x2*)p; return (f32x4){bflo(w.x), bfhi(w.x), bflo(w.y), bfhi(w.y)}; }
__device__ __forceinline__ void st_bf4(bf16_t* p, f32x4 v) { u32x2 w; w.x = pk2(v.x, v.y); w.y = pk2(v.z, v.w); *(u32x2*)p = w; }
__device__ __forceinline__ float bf2f(unsigned short h) { return __builtin_bit_cast(float, (unsigned)h << 16); }
__device__ __forceinline__ float bflo(unsigned w) { return __builtin_bit_cast(float, w << 16); }
__device__ __forceinline__ float bfhi(unsigned w) { return __builtin_bit_cast(float, w & 0xffff0000u); }
__device__ __forceinline__ float wave_sum(float v) {
#pragma unroll
    for (int o = 1; o < 64; o <<= 1) v += __shfl_xor(v, o);
    return v;
}
__device__ __forceinline__ float silu_f(float v) { return v * __builtin_amdgcn_rcpf(1.f + __builtin_amdgcn_exp2f(-1.4426950408889634f * v)); }
__device__ __forceinline__ float sigmoid_f(float v) { return 1.f / (1.f + __expf(-v)); }
__device__ __forceinline__ float softplus_f(float v) { return fmaxf(v, 0.f) + log1pf(__expf(-fabsf(v))); }
__device__ __forceinline__ float logsigmoid_f(float v) { return fminf(v, 0.f) - log1pf(__expf(-fabsf(v))); }
#define LDS_WAIT() asm volatile("s_waitcnt lgkmcnt(0)" ::: "memory")
#define LBAR() asm volatile("s_waitcnt lgkmcnt(0)\n\ts_barrier" ::: "memory")

namespace pg8 {
constexpr int BM = 256, BK = 64, HALF = 128, HTB = HALF * BK * 2, STAGE_BYTES = 8 * HTB, NXCD = 8, WGM = 8;
constexpr int KD = 1024;
typedef int i32x4 __attribute__((ext_vector_type(4)));
typedef int i32x8 __attribute__((ext_vector_type(8)));
#ifndef PG8_XORSWZ
#define PG8_XORSWZ 1
#endif
#if PG8_XORSWZ
__host__ __device__ __forceinline__ int lds_byte(int r, int c) { return r * 128 + ((((c >> 3) ^ (r >> 1)) & 7) << 4) + (c & 7) * 2; }
__host__ __device__ __forceinline__ void stage_rc(int b, int& R, int& C) { R = b >> 7; C = ((((b >> 4) ^ (R >> 1)) & 7) << 3); }
#else
__host__ __device__ __forceinline__ int lds_byte(int r, int c) { const int st = (r >> 4) * 2 + (c >> 5), rr = r & 15, cc = c & 31, ob = rr * 64 + cc * 2; return st * 1024 + (ob ^ (((ob >> 9) & 1) << 5)); }
__host__ __device__ __forceinline__ void stage_rc(int b, int& R, int& C) { const int st = b / 1024, sb = b % 1024, swz = sb ^ (((sb >> 9) & 1) << 5); R = (st >> 1) * 16 + swz / 64; C = (st & 1) * 32 + (swz % 64) / 2; }
#endif
__host__ __device__ __forceinline__ int perm32(int rho) { const int n = rho >> 4, i = rho & 15; return 8 * (i >> 2) + 4 * n + (i & 3); }

struct Unit { int pm, pn, e, mt; };

__device__ __forceinline__ void tile_of(int L, int nM, int nN, int& pm, int& pn) {
    const int nwg = nM * nN; int wgid = L;
    { const int q = nwg / NXCD, r = nwg % NXCD, xcd = wgid % NXCD, off = wgid / NXCD; wgid = (xcd < r ? xcd * (q + 1) : r * (q + 1) + (xcd - r) * q) + off; }
    const int nig = WGM * nN, gid = wgid / nig, fm = gid * WGM, gsz = (nM - fm) < WGM ? (nM - fm) : WGM;
    pm = fm + ((wgid % nig) % gsz); pn = (wgid % nig) / gsz;
}
template <bool NARROW_> struct DenseOrderT {
    static constexpr bool GATHER = false, NARROW = NARROW_;
    int nM, nN, G, c; const char* Bt; unsigned rowb; int dup; int i0 = 0, i1 = 1 << 20;
    __device__ __forceinline__ bool next(int i, Unit& u) const { i += i0; const long L = (long)i * G + c; if (i >= i1 || L >= (long)nM * nN * dup) return false; tile_of((int)L, nM, nN * dup, u.pm, u.pn); u.pn %= nN; u.e = 0; u.mt = u.pm; return true; }
    __device__ __forceinline__ const char* bbase(const Unit& u) const { return Bt + (size_t)u.pn * BM * rowb; }
    __device__ __forceinline__ unsigned arow(const Unit& u, int rl) const { return 0u; }
};
typedef DenseOrderT<false> DenseOrder;
template <bool GATHER_> struct MoeOrder {
    static constexpr bool GATHER = GATHER_, NARROW = false;
    int nMt, nN, G, c; const char* Bt; int brows; const LAS int* tb; const LAS int* cn; const int* rowtok; unsigned rowb; int rot;
    __device__ __forceinline__ void chunk(int& nxc, int& rank, int& m0, int& nMx) const {
        const int NC = G < NXCD ? G : NXCD, x = c % NC; nxc = (G - x + NC - 1) / NC; rank = c / NC;
        const int qm = nMt / NC, rm = nMt % NC; nMx = qm + (x < rm ? 1 : 0); m0 = x * qm + (x < rm ? x : rm);
    }
    __device__ __forceinline__ int trips() const { int nxc, rank, m0, nMx; chunk(nxc, rank, m0, nMx); return (nMx * nN + nxc - 1) / nxc; }
    __device__ __forceinline__ bool next(int i, Unit& u) const {
        int nxc, rank, m0, nMx; chunk(nxc, rank, m0, nMx);
        rank = (rank + nxc - (nMx * rot) % nxc) % nxc;
        const int off = i * nxc + rank; if (off >= nMx * nN) return false;
        const int nig = WGM * nN, gid = off / nig, fm = gid * WGM, gsz = (nMx - fm) < WGM ? (nMx - fm) : WGM;
        u.pm = m0 + fm + ((off % nig) % gsz); u.pn = (off % nig) / gsz;
        int e = 0;
#pragma unroll
        for (int q = 1; q < NEXP; ++q) e += (tb[q] <= u.pm) ? 1 : 0;
        e = __builtin_amdgcn_readfirstlane(e); u.e = e; u.mt = u.pm - __builtin_amdgcn_readfirstlane(tb[e]); return true;
    }
    __device__ __forceinline__ int last_trip_of(int pm, int nNp) const {
        int nxc, rank, m0, nMx; chunk(nxc, rank, m0, nMx);
        const int loc = pm - m0, gid = loc / WGM, fm = gid * WGM, gsz = (nMx - fm) < WGM ? (nMx - fm) : WGM;
        return (gid * (WGM * nNp) + (nNp - 1) * gsz + (loc - fm)) / nxc;
    }
    __device__ __forceinline__ const char* bbase(const Unit& u) const { return Bt + (size_t)(u.e * brows + u.pn * BM) * rowb; }
    __device__ __forceinline__ unsigned arow(const Unit& u, int rl) const {
        const int pos = u.mt * BM + rl; const int lim = __builtin_amdgcn_readfirstlane(cn[u.e]); int tok = ZROW; if (pos < lim) tok = rowtok[u.e * TL + pos]; return (unsigned)tok;
    }
};
struct NoSync { static constexpr bool ARRIVE = false, WAIT = false; };

__device__ __forceinline__ unsigned cvt_pk_bf16(float lo, float hi) { return pk2(lo, hi); }

struct EpiBf16 {
    static constexpr bool PERM = true, LDSBIAS = false;
    bf16_t* O; int ldc; const float* bias; int bstride; float scale; int narrow_pn = -1;
    __device__ __forceinline__ void operator()(const f32x4 (&acc)[2][2][4][2], const Unit& u, int wr, int wc, int fr, int fq) const {
        const bool nar = (u.pn == narrow_pn); if (nar && wc != 0) return;
        const int row0 = u.pm * BM + wr * 64 + fr; const int col0 = u.pn * BM + wc * 32 + 8 * fq;
        f32x4 bv[2][2];
#pragma unroll
        for (int bj = 0; bj < 2; ++bj)
#pragma unroll
            for (int n = 0; n < 2; ++n) bv[bj][n] = bias ? *(const f32x4*)(bias + (size_t)u.e * bstride + col0 + bj * HALF + 4 * n) : (f32x4){0.f, 0.f, 0.f, 0.f};
#pragma unroll
        for (int ai = 0; ai < 2; ++ai)
#pragma unroll
            for (int m = 0; m < 4; ++m) { bf16_t* rowp = O + (size_t)(row0 + ai * HALF + m * 16) * ldc + col0;
#pragma unroll
                for (int bj = 0; bj < 2; ++bj) { if (nar && bj) continue; const f32x4 v0 = acc[ai][bj][m][0] * scale + bv[bj][0], v1 = acc[ai][bj][m][1] * scale + bv[bj][1];
                    u32x4 w; w.x = cvt_pk_bf16(v0[0], v0[1]); w.y = cvt_pk_bf16(v0[2], v0[3]); w.z = cvt_pk_bf16(v1[0], v1[1]); w.w = cvt_pk_bf16(v1[2], v1[3]);
                    *(u32x4*)(rowp + bj * HALF) = w; } }
    }
};
__device__ __forceinline__ float clamp448(float v) { return __builtin_amdgcn_fmed3f(v, -448.f, 448.f); }
__device__ __forceinline__ unsigned pk4_fp8(float a, float b, float c, float d) {
    int w = 0; w = __builtin_amdgcn_cvt_pk_fp8_f32(clamp448(a), clamp448(b), w, false); w = __builtin_amdgcn_cvt_pk_fp8_f32(clamp448(c), clamp448(d), w, true); return (unsigned)w; }
__device__ __forceinline__ unsigned pk4_fp8_nc(float a, float b, float c, float d) {
    int w = 0; w = __builtin_amdgcn_cvt_pk_fp8_f32(a, b, w, false); w = __builtin_amdgcn_cvt_pk_fp8_f32(c, d, w, true); return (unsigned)w; }
struct EpiFp8 {
    static constexpr bool PERM = true;
    static constexpr bool LDSBIAS = true;
    unsigned char* O; int ldc; const float* bias; int bstride; float scale, oscale; LAS float* biasl;
    __device__ __forceinline__ const char* bias_src(const Unit& u, int lane) const { return (const char*)(bias + (size_t)u.e * bstride + u.pn * BM) + (unsigned)(16 * lane); }
    __device__ __forceinline__ void operator()(const f32x4 (&acc)[2][2][4][2], const Unit& u, int wr, int wc, int fr, int fq) const {
        const int row0 = u.pm * BM + wr * 64 + fr; const int col0 = u.pn * BM + wc * 32 + 8 * fq;
        f32x4 bv[2][2];
#pragma unroll
        for (int bj = 0; bj < 2; ++bj)
#pragma unroll
            for (int n = 0; n < 2; ++n) bv[bj][n] = *(const LAS f32x4*)(biasl + wc * 32 + 8 * fq + bj * HALF + 4 * n) * oscale;
        const float so = scale * oscale;
#pragma unroll
        for (int ai = 0; ai < 2; ++ai)
#pragma unroll
            for (int m = 0; m < 4; ++m) { unsigned char* rowp = O + (size_t)(row0 + ai * HALF + m * 16) * ldc + col0;
#pragma unroll
                for (int bj = 0; bj < 2; ++bj) { const f32x4 v0 = acc[ai][bj][m][0] * so + bv[bj][0], v1 = acc[ai][bj][m][1] * so + bv[bj][1];
                    u32x2 w; w.x = pk4_fp8(v0[0], v0[1], v0[2], v0[3]); w.y = pk4_fp8(v1[0], v1[1], v1[2], v1[3]);
                    *(u32x2*)(rowp + bj * HALF) = w; } }
    }
};
struct EpiSwiglu {
    static constexpr bool PERM = true;
    static constexpr bool LDSBIAS = true;
    unsigned char* O; const float* bias; float scale, oscale; LAS float* biasl;
    __device__ __forceinline__ const char* bias_src(const Unit& u, int lane) const { return (const char*)(bias + (size_t)u.e * 2048 + u.pn * HALF) + (unsigned)((lane >> 5) * 4096 + 16 * (lane & 31)); }
    __device__ __forceinline__ void operator()(const f32x4 (&acc)[2][2][4][2], const Unit& u, int wr, int wc, int fr, int fq) const {
        const int row0 = u.pm * BM + wr * 64 + fr; const int ff0 = u.pn * HALF + wc * 32 + 8 * fq;
        f32x4 bg[2], bu[2];
#pragma unroll
        for (int n = 0; n < 2; ++n) { bg[n] = *(const LAS f32x4*)(biasl + wc * 32 + 8 * fq + 4 * n); bu[n] = *(const LAS f32x4*)(biasl + HALF + wc * 32 + 8 * fq + 4 * n); }
        const f32x4 os4 = (f32x4){oscale, oscale, oscale, oscale};
#pragma unroll
        for (int ai = 0; ai < 2; ++ai)
#pragma unroll
            for (int m = 0; m < 4; ++m) { unsigned char* rowp = O + (size_t)(row0 + ai * HALF + m * 16) * DFF + ff0;
                float r[8];
#pragma unroll
                for (int n = 0; n < 2; ++n) {
                    f32x4 g = acc[ai][0][m][n] * scale + bg[n]; f32x4 up = acc[ai][1][m][n] * scale + bu[n];
                    g.x = fminf(g.x, 7.f); g.y = fminf(g.y, 7.f); g.z = fminf(g.z, 7.f); g.w = fminf(g.w, 7.f);
                    up.x = __builtin_amdgcn_fmed3f(up.x, -7.f, 7.f); up.y = __builtin_amdgcn_fmed3f(up.y, -7.f, 7.f); up.z = __builtin_amdgcn_fmed3f(up.z, -7.f, 7.f); up.w = __builtin_amdgcn_fmed3f(up.w, -7.f, 7.f);
                    const f32x4 tz = g * -2.4554669595930157f;
                    f32x4 d; d.x = __builtin_amdgcn_exp2f(tz.x); d.y = __builtin_amdgcn_exp2f(tz.y); d.z = __builtin_amdgcn_exp2f(tz.z); d.w = __builtin_amdgcn_exp2f(tz.w);
                    d = d + 1.0f;
                    f32x4 rc; rc.x = __builtin_amdgcn_rcpf(d.x); rc.y = __builtin_amdgcn_rcpf(d.y); rc.z = __builtin_amdgcn_rcpf(d.z); rc.w = __builtin_amdgcn_rcpf(d.w);
                    const f32x4 o = (up * os4 + os4) * (g * rc);
                    r[4 * n] = o.x; r[4 * n + 1] = o.y; r[4 * n + 2] = o.z; r[4 * n + 3] = o.w; }
                u32x2 w; w.x = pk4_fp8_nc(r[0], r[1], r[2], r[3]); w.y = pk4_fp8_nc(r[4], r[5], r[6], r[7]);
                *(u32x2*)rowp = w; }
    }
};
struct EpiResGate {
    static constexpr bool PERM = false, LDSBIAS = false;
    const float* x; bf16_t* out; const float* mod;
    float ascale;
    float* ssq;
    __device__ __forceinline__ void operator()(const f32x4 (&acc)[2][2][4][2], const Unit& u, int wr, int wc, int fr, int fq) const {
        const int row0 = u.pm * BM + wr * 64 + fr, col0 = u.pn * BM + wc * 32 + 4 * fq;
        const float* g1 = mod + (size_t)((u.pm * BM) >> 13) * 6144 + 2048;
        f32x4 gv[2][2];
#pragma unroll
        for (int bj = 0; bj < 2; ++bj)
#pragma unroll
            for (int n = 0; n < 2; ++n) gv[bj][n] = *(const f32x4*)(g1 + col0 + bj * HALF + n * 16);
#pragma unroll
        for (int ai = 0; ai < 2; ++ai) {
            f32x4 xv[4][2][2];
#pragma unroll
            for (int m = 0; m < 4; ++m) { const size_t off = (size_t)(row0 + ai * HALF + m * 16) * DM + col0;
#pragma unroll
                for (int bj = 0; bj < 2; ++bj)
#pragma unroll
                    for (int n = 0; n < 2; ++n) xv[m][bj][n] = *(const f32x4*)(x + off + bj * HALF + n * 16); }
#pragma unroll
            for (int m = 0; m < 4; ++m) { const size_t off = (size_t)(row0 + ai * HALF + m * 16) * DM + col0; float ss = 0.f;
#pragma unroll
                for (int bj = 0; bj < 2; ++bj)
#pragma unroll
                    for (int n = 0; n < 2; ++n) {
                        const f32x4 o = xv[m][bj][n] + gv[bj][n] * (acc[ai][bj][m][n] * ascale); u32x2 w; w.x = cvt_pk_bf16(o[0], o[1]); w.y = cvt_pk_bf16(o[2], o[3]);
                        *(u32x2*)(out + off + bj * HALF + n * 16) = w;
                        const float r0 = __builtin_bit_cast(float, w.x << 16), r1 = __builtin_bit_cast(float, w.x & 0xffff0000u), r2 = __builtin_bit_cast(float, w.y << 16), r3 = __builtin_bit_cast(float, w.y & 0xffff0000u);
                        ss += (r0 * r0 + r1 * r1) + (r2 * r2 + r3 * r3); }
                ss += __shfl_xor(ss, 16); ss += __shfl_xor(ss, 32);
                if (fq == 0) ssq[(size_t)(row0 + ai * HALF + m * 16) * 16 + u.pn * 4 + wc] = ss; } }
    }
};

template <class Epi, class Sched, bool ALIGN_EPI, bool FP8 = false, class Sync = NoSync>
__device__ __forceinline__ void gemm_phase(LAS unsigned char* lds, const bf16_t* Aglob, const Sched& S, const Epi& E, Sync* Y = nullptr) {
    const int tid = threadIdx.x, wid = __builtin_amdgcn_readfirstlane(tid >> 6), lane = tid & 63, wr = wid >> 2, wc = wid & 3, fr = lane & 15, fq = lane >> 4;
    constexpr int nt = FP8 ? KD / (2 * BK) : KD / BK;
    constexpr unsigned ROWB = FP8 ? KD : KD * 2; constexpr int RSH = FP8 ? 10 : 11;
    unsigned voffA[2], voffB[2];
#pragma unroll
    for (int i = 0; i < 2; ++i) { int R, C; stage_rc(tid * 16 + i * 8192, R, C); const int Rb = Epi::PERM ? ((R & ~31) + perm32(R & 31)) : R;
        voffA[i] = (unsigned)R * ROWB + (unsigned)C * 2u; voffB[i] = (unsigned)Rb * ROWB + (unsigned)C * 2u; }
    constexpr size_t kstep = (size_t)(BK * 2);
    constexpr size_t hstep = (size_t)HALF * ROWB;
    constexpr size_t tstep = 2 * hstep;
    const unsigned ldsw = (unsigned)wid * 1024u;
    const int aoff = lds_byte(wr * 64 + fr, fq * 8), boff = lds_byte(wc * 32 + fr, fq * 8);
    const int aoff1 = lds_byte(wr * 64 + fr, 32 + fq * 8), boff1 = lds_byte(wc * 32 + fr, 32 + fq * 8);
    const char* Ab = (const char*)Aglob;
#define PG8_SA(b, h) (((b) * 2 + (h)) * HTB)
#define PG8_SB(b, h) ((4 + (b) * 2 + (h)) * HTB)
#define PG8_STAGE_B(bufoff, gbase) do { _Pragma("unroll") for (int _i = 0; _i < 2; ++_i) \
        __builtin_amdgcn_global_load_lds((const unsigned*)((const char*)(gbase) + voffB[_i]), (LAS unsigned*)(lds + (bufoff) + ldsw + _i * 8192), 16, 0, 0); } while (0)
#define PG8_STAGE_A(bufoff, pa, tk, h, kb) do { _Pragma("unroll") for (int _i = 0; _i < 2; ++_i) { \
        const char* _src = Sched::GATHER ? (Ab + (kb) + (size_t)((((tk)[_i] >> (16 * (h))) & 0xffffu) * ROWB + (voffA[_i] & 127u))) : ((pa) + (size_t)(h) * hstep + (kb) + voffA[_i]); \
        __builtin_amdgcn_global_load_lds((const unsigned*)_src, (LAS unsigned*)(lds + (bufoff) + ldsw + _i * 8192), 16, 0, 0); } } while (0)
#define PG8_LD8(p0, p1) __builtin_shufflevector(*(const LAS i32x4*)(p0), *(const LAS i32x4*)(p1), 0, 1, 2, 3, 4, 5, 6, 7)
#define PG8_LDA(dst, b, h) do { _Pragma("unroll") for (int m = 0; m < 4; ++m) dst[m] = PG8_LD8(lds + PG8_SA(b, h) + aoff + m * 2048, lds + PG8_SA(b, h) + aoff1 + m * 2048); } while (0)
#define PG8_LDB(dst, b, h) do { _Pragma("unroll") for (int n = 0; n < 2; ++n) dst[n] = PG8_LD8(lds + PG8_SB(b, h) + boff + n * 2048, lds + PG8_SB(b, h) + boff1 + n * 2048); } while (0)
#define PG8_LO(x) __builtin_bit_cast(bf16x8, __builtin_shufflevector(x, x, 0, 1, 2, 3))
#define PG8_HI(x) __builtin_bit_cast(bf16x8, __builtin_shufflevector(x, x, 4, 5, 6, 7))
#define PG8_MMA(ai, bj, At, Bt) do { __builtin_amdgcn_s_setprio(1); _Pragma("unroll") for (int m = 0; m < 4; ++m) _Pragma("unroll") for (int n = 0; n < 2; ++n) { \
        if constexpr (FP8) asm volatile("v_mfma_scale_f32_16x16x128_f8f6f4 %0, %1, %2, %0, %3, %3 op_sel_hi:[0,0,0]" : "+v"(acc[ai][bj][m][n]) : "v"(Bt[n]), "v"(At[m]), "v"(sc127)); \
        else { acc[ai][bj][m][n] = __builtin_amdgcn_mfma_f32_16x16x32_bf16(PG8_LO(Bt[n]), PG8_LO(At[m]), acc[ai][bj][m][n], 0, 0, 0); \
               acc[ai][bj][m][n] = __builtin_amdgcn_mfma_f32_16x16x32_bf16(PG8_HI(Bt[n]), PG8_HI(At[m]), acc[ai][bj][m][n], 0, 0, 0); } } \
        __builtin_amdgcn_s_setprio(0); } while (0)
#define PG8_WAIT_V(n) asm volatile("s_waitcnt vmcnt(" #n ")" ::: "memory")
#define PG8_WAIT_L(n) asm volatile("s_waitcnt lgkmcnt(" #n ")" ::: "memory")
#define PG8_BAR __builtin_amdgcn_s_barrier()
#define PG8_SCHED __builtin_amdgcn_sched_barrier(0)
#define PG8_TOKS(dst, u) do { if constexpr (Sched::GATHER) { _Pragma("unroll") for (int _i = 0; _i < 2; ++_i) { const int _R = (int)(voffA[_i] >> RSH); \
        dst[_i] = S.arow(u, _R) | (S.arow(u, HALF + _R) << 16); } } } while (0)
    Unit cur, nxt; int ui = 0;
    if (!S.next(0, cur)) return;
    if constexpr (Sync::WAIT) { if (!Y->done && Y->need(cur)) { if (tid == 0) Y->wait(); __builtin_amdgcn_s_barrier(); Y->done = true; } }
    unsigned sc127 = 0u; if constexpr (FP8) asm volatile("v_mov_b32 %0, 0x7f7f7f7f" : "=v"(sc127));
    f32x4 acc[2][2][4][2];
#pragma unroll
    for (int a = 0; a < 2; ++a)
#pragma unroll
        for (int b = 0; b < 2; ++b)
#pragma unroll
            for (int m = 0; m < 4; ++m)
#pragma unroll
                for (int n = 0; n < 2; ++n) acc[a][b][m][n] = (f32x4){0.f, 0.f, 0.f, 0.f};
    i32x8 At[4], B0[2], B1[2];
    unsigned tokC[2] = {0u, 0u}, tokN[2] = {0u, 0u};
    PG8_TOKS(tokC, cur);
    const char* cA = Ab + (size_t)cur.pm * tstep;
    const char* cB = S.bbase(cur);
    PG8_STAGE_B(PG8_SB(0, 0), cB); PG8_STAGE_B(PG8_SB(0, 1), cB + hstep); PG8_STAGE_A(PG8_SA(0, 0), cA, tokC, 0, 0); PG8_STAGE_A(PG8_SA(0, 1), cA, tokC, 1, 0);
    if (wr == 1) PG8_BAR;
    PG8_WAIT_V(2); PG8_BAR;
    PG8_STAGE_B(PG8_SB(1, 0), cB + kstep); PG8_STAGE_A(PG8_SA(1, 0), cA, tokC, 0, kstep); PG8_STAGE_B(PG8_SB(1, 1), cB + hstep + kstep);
    PG8_WAIT_V(6); PG8_BAR;
    for (;;) {
        const bool has_next = S.next(ui + 1, nxt);
        if constexpr (Sync::WAIT) { if (has_next && !Y->done && Y->need(nxt)) { if (tid == 0) Y->wait(); PG8_BAR; Y->done = true; } }
        const char* nA = has_next ? Ab + (size_t)nxt.pm * tstep : cA; const char* nB = has_next ? S.bbase(nxt) : cB;
#pragma unroll 1
        for (int t = 0; t < nt; t += 2) {
            const bool last = (t == nt - 2);
            if constexpr (Epi::LDSBIAS) { if (last && wid == 0) __builtin_amdgcn_global_load_lds((const unsigned*)E.bias_src(cur, lane), (LAS unsigned*)E.biasl, 16, 0, 0); }
            if (last) { if (has_next) { PG8_TOKS(tokN, nxt); } else { tokN[0] = tokC[0]; tokN[1] = tokC[1]; } }
            const size_t k1 = (size_t)(t + 1) * kstep;
            const size_t k2 = last ? 0 : (size_t)(t + 2) * kstep, k3 = k2 + kstep;
            const char* a2 = last ? nA : cA;
            const char* b2 = last ? nB : cB + (size_t)(t + 2) * kstep; const char* b3 = b2 + kstep;
            PG8_LDB(B0, 0, 0); PG8_LDB(B1, 0, 1); PG8_SCHED; PG8_LDA(At, 0, 0); PG8_STAGE_A(PG8_SA(1, 1), cA, tokC, 1, k1);
            PG8_WAIT_V(8); PG8_WAIT_L(0); PG8_BAR; PG8_MMA(0, 0, At, B0); PG8_MMA(0, 1, At, B1); PG8_BAR; PG8_SCHED;
            if (last) { tokC[0] = tokN[0]; tokC[1] = tokN[1]; }
            PG8_LDA(At, 0, 1); PG8_STAGE_B(PG8_SB(0, 0), b2); PG8_STAGE_B(PG8_SB(0, 1), b2 + hstep); PG8_STAGE_A(PG8_SA(0, 0), a2, tokC, 0, k2);
            PG8_WAIT_V(8); PG8_WAIT_L(0); PG8_BAR; PG8_MMA(1, 0, At, B0); PG8_MMA(1, 1, At, B1); PG8_BAR; PG8_SCHED;
            PG8_LDB(B0, 1, 0); PG8_LDB(B1, 1, 1); PG8_SCHED; PG8_LDA(At, 1, 0); PG8_STAGE_A(PG8_SA(0, 1), a2, tokC, 1, k2);
            PG8_WAIT_V(8); PG8_WAIT_L(0); PG8_BAR; PG8_MMA(0, 0, At, B0); PG8_MMA(0, 1, At, B1); PG8_BAR; PG8_SCHED;
            PG8_LDA(At, 1, 1); PG8_STAGE_B(PG8_SB(1, 0), b3); PG8_STAGE_B(PG8_SB(1, 1), b3 + hstep); PG8_STAGE_A(PG8_SA(1, 0), a2, tokC, 0, k3);
            PG8_WAIT_V(8); PG8_WAIT_L(0); PG8_BAR; PG8_MMA(1, 0, At, B0); PG8_MMA(1, 1, At, B1); PG8_BAR; PG8_SCHED;
        }
        if constexpr (ALIGN_EPI) { if (wr == 0) PG8_BAR; }
        if constexpr (Sync::ARRIVE) { static_assert(ALIGN_EPI, "aligned epilogue"); if (ui == Y->a1) { PG8_WAIT_V(0); PG8_BAR; if (tid == 0) Y->arrive(); Y->done = true; } }
        if constexpr (FP8) asm volatile("s_nop 15\n\ts_nop 15" ::: "memory");
        E(acc, cur, wr, wc, fr, fq);
        if (!has_next) break;
#pragma unroll
        for (int a = 0; a < 2; ++a)
#pragma unroll
            for (int b = 0; b < 2; ++b)
#pragma unroll
                for (int m = 0; m < 4; ++m)
#pragma unroll
                    for (int n = 0; n < 2; ++n) acc[a][b][m][n] = (f32x4){0.f, 0.f, 0.f, 0.f};
        cur = nxt; cA = nA; cB = nB; ++ui;
        if constexpr (ALIGN_EPI) { if (wr == 1) PG8_BAR; }
    }
    PG8_WAIT_V(0);
    if constexpr (!ALIGN_EPI) { if (wr == 0) PG8_BAR; }
    PG8_BAR;
#undef PG8_SA
#undef PG8_SB
#undef PG8_STAGE_A
#undef PG8_STAGE_B
#undef PG8_LDA
#undef PG8_LDB
#undef PG8_MMA
#undef PG8_LD8
#undef PG8_LO
#undef PG8_HI
#undef PG8_WAIT_V
#undef PG8_WAIT_L
#undef PG8_BAR
#undef PG8_SCHED
#undef PG8_TOKS
}
}

#define XB_TMO      128
#define XB_XCNT(j)  (256  + 64 * (j))
#define XB_XSUB(j)  (1280 + 64 * (j))
#define XB_XGEN(j)  (2304 + 64 * (j))
#define XB_TOP      3328
#define XB_TOPGEN   3392
#define XCD_BAR_WORDS 3456
#define XB_SPIN_CAP (1u << 18)

__device__ __forceinline__ unsigned xb_ld(unsigned* p)              { return __hip_atomic_load(p, __ATOMIC_RELAXED, __HIP_MEMORY_SCOPE_AGENT); }
__device__ __forceinline__ unsigned xb_add(unsigned* p, unsigned v) { return __hip_atomic_fetch_add(p, v, __ATOMIC_RELAXED, __HIP_MEMORY_SCOPE_AGENT); }
__device__ __forceinline__ unsigned xb_xcc_id() { return (unsigned)__builtin_amdgcn_s_getreg((3 << 11) | 20) & 0xFu; }
#define XB_SPIN(cond, bar) do { unsigned _sp = 0; while (cond) { __builtin_amdgcn_s_sleep(1); \
    if ((++_sp & 255u) == 0u) { if (xb_ld(&(bar)[XB_TMO])) break; if (_sp > XB_SPIN_CAP) { atomicAdd(&(bar)[XB_TMO], 1u); break; } } } } while (0)

struct XcdBarrier {
    unsigned* bar; unsigned x;
    volatile LAS unsigned* st;
};

__device__ __forceinline__ XcdBarrier xcd_barrier_post(unsigned* bar, volatile LAS unsigned* st) {
    XcdBarrier b; b.bar = bar; b.x = xb_xcc_id(); b.st = st;
    if (threadIdx.x == 0) (void)xb_add(&bar[XB_XCNT(b.x)], 1u);
    return b;
}
__device__ __forceinline__ void xcd_barrier_complete(unsigned* bar, unsigned x, unsigned& nloc, unsigned& nx) {
    const unsigned G = gridDim.x * gridDim.y * gridDim.z;
    unsigned sum, cnt, mine, sp = 0u;
    for (;;) {
        sum = 0u; cnt = 0u; mine = 0u;
#pragma unroll
        for (unsigned j = 0; j < 16; ++j) { const unsigned c = xb_ld(&bar[XB_XCNT(j)]); sum += c; cnt += (c > 0u) ? 1u : 0u; mine = (j == x) ? c : mine; }
        if (sum == G) break;
        __builtin_amdgcn_s_sleep(1);
        if ((++sp & 255u) == 0u) { if (xb_ld(&bar[XB_TMO])) break; if (sp > XB_SPIN_CAP) { atomicAdd(&bar[XB_TMO], 1u); break; } }
    }
    nloc = mine > 0u ? mine : 1u; nx = cnt > 0u ? cnt : 1u;
}

__device__ __forceinline__ void xcd_barrier(const XcdBarrier& b) {
    asm volatile("s_waitcnt vmcnt(0)" ::: "memory");
    __syncthreads();
    if (threadIdx.x == 0) {
        unsigned* bar = b.bar;
        __builtin_amdgcn_s_waitcnt(0);
        unsigned nloc = b.st[0], nx = b.st[1];
        if (nloc == 0u) { xcd_barrier_complete(bar, b.x, nloc, nx); b.st[0] = nloc; b.st[1] = nx; }
        const unsigned old = xb_add(&bar[XB_XSUB(b.x)], 1u);
        const unsigned gen = old / nloc;
        if (old + 1u == (gen + 1u) * nloc) {
            __builtin_amdgcn_fence(__ATOMIC_RELEASE, "agent");
            asm volatile("s_waitcnt vmcnt(0)" ::: "memory");
            const unsigned og = xb_add(&bar[XB_TOP], 1u);
            const unsigned tg = og / nx;
            if (og + 1u == (tg + 1u) * nx) xb_add(&bar[XB_TOPGEN], 1u);
            else XB_SPIN(xb_ld(&bar[XB_TOPGEN]) == tg, bar);
            __builtin_amdgcn_fence(__ATOMIC_ACQUIRE, "agent");
            xb_add(&bar[XB_XGEN(b.x)], 1u);
            asm volatile("s_waitcnt vmcnt(0)" ::: "memory");
        } else {
            XB_SPIN(xb_ld(&bar[XB_XGEN(b.x)]) == gen, bar);
            __builtin_amdgcn_fence(__ATOMIC_ACQUIRE, "agent");
            asm volatile("s_waitcnt vmcnt(0)" ::: "memory");
        }
    }
    __syncthreads();
}

#define SB_XSUB(j)  (64 * (j))
#define SB_TOP      1024
#define SB_FLAG     1088
__device__ __forceinline__ void sb_arrive(const XcdBarrier& b, unsigned* sb) {
    unsigned nloc = b.st[0], nx = b.st[1];
    if (nloc == 0u) { xcd_barrier_complete(b.bar, b.x, nloc, nx); b.st[0] = nloc; b.st[1] = nx; }
    const unsigned old = xb_add(&sb[SB_XSUB(b.x)], 1u);
    if (old + 1u == nloc) {
        __builtin_amdgcn_fence(__ATOMIC_RELEASE, "agent");
        asm volatile("s_waitcnt vmcnt(0)" ::: "memory");
        const unsigned og = xb_add(&sb[SB_TOP], 1u);
        if (og + 1u == nx) xb_add(&sb[SB_FLAG], 1u);
    }
}
__device__ __forceinline__ void sb_wait(const XcdBarrier& b, unsigned* sb) {
    XB_SPIN(xb_ld(&sb[SB_FLAG]) == 0u, b.bar);
    __builtin_amdgcn_fence(__ATOMIC_ACQUIRE, "agent");
    asm volatile("s_waitcnt vmcnt(0)" ::: "memory");
}
struct ArriveSync {
    static constexpr bool ARRIVE = true, WAIT = false;
    const XcdBarrier* b; unsigned* sb; int a1; bool done;
    __device__ __forceinline__ void arrive() const { sb_arrive(*b, sb); }
};
template <class Sched> struct WaitSync {
    static constexpr bool ARRIVE = false, WAIT = true;
    const XcdBarrier* b; unsigned* sb; int a1; bool done; const Sched* S; int nNp;
    __device__ __forceinline__ bool need(const pg8::Unit& u) const { return S->last_trip_of(u.pm, nNp) >= a1; }
    __device__ __forceinline__ void wait() const { sb_wait(*b, sb); }
};

struct Ctx {
    LAS unsigned char* lds; int tid, lane, wave, bid, G;
    const float* const* in; float* out; unsigned char* ws;
};
#define GIN(F, i) ((const float*)(const GAS float*)(F).in[i])
#define IN_X 0
#define IN_C 1
#define IN_CTX 2
#define IN_CCTX 3
#define IN_WMOD 4
#define IN_BMOD 5
#define IN_NORM1 6
#define IN_WIN 7
#define IN_GKUP 8
#define IN_GKB 9
#define IN_GLANORM 10
#define IN_CONVW 11
#define IN_CONVB 12
#define IN_DTBIAS 13
#define IN_ALOG 14
#define IN_SSDD 15
#define IN_SSDNORM 16
#define IN_WOUT 17
#define IN_NORM2 18
#define IN_WR 19
#define IN_BR 20
#define IN_WGU 21
#define IN_BGU 22
#define IN_WD 23
#define IN_BD 24
#define IN_FNORM 25

__device__ __forceinline__ int map_in(int n) {
    if (n < 1536) return n;
    if (n < 3072) return n + 16;
    if (n < 3088) return n - 1536;
    if (n < 3096) return n;
    return -1;
}
__device__ __forceinline__ void tr_item(const float* W, int N, int k0, int sc, bf16_t* WT, LAS float* scr, int lane) {
#pragma unroll 8
    for (int i = 0; i < 32; ++i) { const int kk = 2 * i + (lane >> 5); scr[kk * 33 + (lane & 31)] = (sc >= 0) ? W[(size_t)(k0 + kk) * N + sc] : 0.f; }
    LDS_WAIT(); asm volatile("" ::: "memory");
    const int c = lane & 7;
#pragma unroll
    for (int j = 0; j < 4; ++j) { const int n = (lane >> 3) + 8 * j; const LAS float* s = scr + (8 * c) * 33 + n;
        u32x4 o; o.x = pk2(s[0 * 33], s[1 * 33]); o.y = pk2(s[2 * 33], s[3 * 33]); o.z = pk2(s[4 * 33], s[5 * 33]); o.w = pk2(s[6 * 33], s[7 * 33]);
        *(u32x4*)(WT + (size_t)n * 1024 + k0 + 8 * c) = o; }
    LDS_WAIT(); asm volatile("" ::: "memory");
}

__device__ __forceinline__ void tr_item8(const float* W, int N, int k0, int sc, unsigned char* WT8, float wscale, LAS float* scr, int lane) {
#pragma unroll 16
    for (int i = 0; i < 64; ++i) { const int kk = 2 * i + (lane >> 5); scr[kk * 33 + (lane & 31)] = W[(size_t)(k0 + kk) * N + sc] * wscale; }
    LDS_WAIT(); asm volatile("" ::: "memory");
    const int c = lane & 7;
#pragma unroll
    for (int j = 0; j < 4; ++j) { const int n = (lane >> 3) + 8 * j; const LAS float* p = scr + (16 * c) * 33 + n;
        u32x4 o; o.x = pg8::pk4_fp8(p[0 * 33], p[1 * 33], p[2 * 33], p[3 * 33]); o.y = pg8::pk4_fp8(p[4 * 33], p[5 * 33], p[6 * 33], p[7 * 33]);
        o.z = pg8::pk4_fp8(p[8 * 33], p[9 * 33], p[10 * 33], p[11 * 33]); o.w = pg8::pk4_fp8(p[12 * 33], p[13 * 33], p[14 * 33], p[15 * 33]);
        *(u32x4*)(WT8 + (size_t)n * 1024 + k0 + 16 * c) = o; }
    LDS_WAIT(); asm volatile("" ::: "memory");
}
constexpr float WSCALE8 = 1024.f, HSCALE8 = 16.f, ASCALE8 = 4.f, PSCALE8 = 32.f;

__device__ __forceinline__ void tr8_load(f32x4 (&v)[16], const float* W, int N, int k0, int n0, int lane) {
    const float* p = W + (size_t)(k0 + 16 * (lane >> 3)) * N + n0 + 4 * (lane & 7);
#pragma unroll
    for (int i = 0; i < 16; ++i) v[i] = *(const f32x4*)(p + (size_t)i * N);
}
__device__ __forceinline__ void tr8_store(const f32x4 (&v)[16], unsigned char* WT8, int k0, float wscale, LAS float* scr, int lane) {
    (void)scr;
    unsigned char* d = WT8 + (size_t)(4 * (lane & 7)) * 1024 + k0 + 16 * (lane >> 3);
#pragma unroll
    for (int j = 0; j < 4; ++j) { u32x4 o;
        o.x = pg8::pk4_fp8(v[0][j] * wscale, v[1][j] * wscale, v[2][j] * wscale, v[3][j] * wscale); o.y = pg8::pk4_fp8(v[4][j] * wscale, v[5][j] * wscale, v[6][j] * wscale, v[7][j] * wscale);
        o.z = pg8::pk4_fp8(v[8][j] * wscale, v[9][j] * wscale, v[10][j] * wscale, v[11][j] * wscale); o.w = pg8::pk4_fp8(v[12][j] * wscale, v[13][j] * wscale, v[14][j] * wscale, v[15][j] * wscale);
        *(u32x4*)(d + (size_t)j * 1024) = o; }
}
struct Tr8Item { const float* W; int N, k0, n0; unsigned char* dst; };
__device__ __forceinline__ Tr8Item tr8_decode(const Ctx& F, int r) {
    constexpr int I_GU = NEXP * 8 * 64;
    Tr8Item t;
    if (r < I_GU) { const int e = r / (8 * 64), q = r % (8 * 64), nb = q % 64, kb = q / 64; const int n0 = nb * 32, tile = n0 >> 8, w = n0 & 255;
        t.W = GIN(F, IN_WGU) + (size_t)e * 1024 * 2048; t.N = 2048; t.k0 = kb * 128; t.n0 = (w < 128) ? tile * 128 + w : 1024 + tile * 128 + (w - 128);
        t.dst = (unsigned char*)(F.ws + WS_WGU) + ((size_t)e * 2048 + n0) * 1024; }
    else { r -= I_GU; const int e = r / (8 * 32), q = r % (8 * 32), nb = q % 32, kb = q / 32;
        t.W = GIN(F, IN_WD) + (size_t)e * 1024 * 1024; t.N = 1024; t.k0 = kb * 128; t.n0 = nb * 32;
        t.dst = (unsigned char*)(F.ws + WS_WD) + ((size_t)e * 1024 + nb * 32) * 1024; }
    return t;
}
__device__ __forceinline__ void expert_weight_copies(Ctx& F, int c_hi, int n_lo, int n_hi) {
    LAS float* scr = (LAS float*)(F.lds + F.wave * 16896);
    constexpr int NI = NEXP * 8 * 64 + NEXP * 8 * 32;
    const int oct = F.bid >> 3, j8 = F.bid & 7, o_hi = (c_hi + 7) >> 3;
    const int ns = oct < o_hi ? n_lo : n_hi, S0 = oct < o_hi ? oct * 8 * n_lo : o_hi * 8 * n_lo + (oct - o_hi) * 8 * n_hi;
    int lane = F.lane; asm volatile("" : "+v"(lane));
    f32x4 va[16], vb[16];
    int it = (S0 + j8) * 8 + F.wave; const int hi = (S0 + 8 * ns) * 8 < NI ? (S0 + 8 * ns) * 8 : NI;
    if (it < hi) { const Tr8Item t = tr8_decode(F, it); tr8_load(va, t.W, t.N, t.k0, t.n0, lane); }
    while (it < hi) {
        const int it2 = it + 64, it3 = it2 + 64;
        if (it2 < hi) { const Tr8Item t = tr8_decode(F, it2); tr8_load(vb, t.W, t.N, t.k0, t.n0, lane); }
        { const Tr8Item t = tr8_decode(F, it); tr8_store(va, t.dst, t.k0, WSCALE8, scr, lane); }
        if (it3 < hi) { const Tr8Item t = tr8_decode(F, it3); tr8_load(va, t.W, t.N, t.k0, t.n0, lane); }
        if (it2 < hi) { const Tr8Item t = tr8_decode(F, it2); tr8_store(vb, t.dst, t.k0, WSCALE8, scr, lane); }
        it = it3;
    }
}
__device__ __forceinline__ void prologue_items(Ctx& F, int part) {
    LAS float* scr = (LAS float*)(F.lds + F.wave * 16896);
    const int gw = F.bid * 8 + F.wave, NGW = F.G * 8;
    constexpr int I_IN = 16 * (NP / 32), I_OUT = 8 * 32, I_GU = NEXP * 8 * 64, I_D = NEXP * 8 * 32;
    bf16_t* WinT = (bf16_t*)(F.ws + WS_WIN); bf16_t* WoutT = (bf16_t*)(F.ws + WS_WOUT); unsigned char* WguT = (unsigned char*)(F.ws + WS_WGU); unsigned char* WdT = (unsigned char*)(F.ws + WS_WD);
    const int lo = part ? I_IN + I_OUT : 0, hi = part ? I_IN + I_OUT + I_GU + I_D : I_IN + I_OUT;
    for (int it = lo + gw; it < hi; it += NGW) {
        int r = it; const int l31 = F.lane & 31;
        if (r < I_IN) { const int nb = r % (NP / 32), kb = r / (NP / 32); tr_item(GIN(F, IN_WIN), 3096, kb * 64, map_in(nb * 32 + l31), WinT + (size_t)nb * 32 * 1024, scr, F.lane); continue; } r -= I_IN;
        if (r < I_OUT) { const int nb = r % 32, kb = r / 32; tr_item8(GIN(F, IN_WOUT), 1024, kb * 128, nb * 32 + l31, (unsigned char*)WoutT + (size_t)nb * 32 * 1024, WSCALE8, scr, F.lane); continue; } r -= I_OUT;
        if (r < I_GU) { const int e = r / (8 * 64), q = r % (8 * 64), nb = q % 64, kb = q / 64; const int n0 = nb * 32, tile = n0 >> 8, w = n0 & 255;
            const int sc0 = (w < 128) ? tile * 128 + w : 1024 + tile * 128 + (w - 128);
            tr_item8(GIN(F, IN_WGU) + (size_t)e * 1024 * 2048, 2048, kb * 128, sc0 + l31, WguT + ((size_t)e * 2048 + n0) * 1024, WSCALE8, scr, F.lane); continue; } r -= I_GU;
        { const int e = r / (8 * 32), q = r % (8 * 32), nb = q % 32, kb = q / 32;
            tr_item8(GIN(F, IN_WD) + (size_t)e * 1024 * 1024, 1024, kb * 128, nb * 32 + l31, WdT + ((size_t)e * 1024 + nb * 32) * 1024, WSCALE8, scr, F.lane); }
    }
}
__device__ __forceinline__ void ph_prologue(Ctx& F, int stage = 3) {
    float* mod = (float*)(F.ws + WS_MOD);
    for (int item = F.bid; item < ((stage & 1) ? 192 : 0); item += F.G) {
        LAS float* sc = (LAS float*)F.lds;
        for (int i = F.tid; i < 5 * 1024; i += 512) { const int j = i >> 10, k = i & 1023; const float v = (j < 4) ? GIN(F, IN_C)[j * 1024 + k] : GIN(F, IN_CCTX)[k]; sc[i] = silu_f(v); }
        __syncthreads();
        const int nn = F.tid & 31, kq = F.tid >> 5, n = item * 32 + nn;
        float a0 = 0.f, a1 = 0.f, a2 = 0.f, a3 = 0.f, a4 = 0.f;
        const float* wm = GIN(F, IN_WMOD);
#pragma unroll 8
        for (int i = 0; i < 64; ++i) { const int k = kq + 16 * i; const float w = wm[(size_t)k * 6144 + n];
            a0 += sc[k] * w; a1 += sc[1024 + k] * w; a2 += sc[2048 + k] * w; a3 += sc[3072 + k] * w; a4 += sc[4096 + k] * w; }
        LAS float* red = (LAS float*)(F.lds + 20480);
        red[(kq * 5 + 0) * 32 + nn] = a0; red[(kq * 5 + 1) * 32 + nn] = a1; red[(kq * 5 + 2) * 32 + nn] = a2; red[(kq * 5 + 3) * 32 + nn] = a3; red[(kq * 5 + 4) * 32 + nn] = a4;
        __syncthreads();
        if (F.tid < 160) { const int j = F.tid >> 5; float s = GIN(F, IN_BMOD)[n];
            for (int q = 0; q < 16; ++q) s += red[(q * 5 + j) * 32 + nn];
            mod[j * 6144 + n] = s; }
        __syncthreads();
    }
    if (stage & 2) prologue_items(F, 0);
}
__device__ __forceinline__ void ph_norm1(Ctx& F) {
    const float* mod = (const float*)(F.ws + WS_MOD); bf16_t* H = (bf16_t*)(F.ws + WS_H);
    const int gw = F.bid * 8 + F.wave, NGW = F.G * 8;
    f32x4 nw[4];
#pragma unroll
    for (int q = 0; q < 4; ++q) nw[q] = *(const f32x4*)(GIN(F, IN_NORM1) + 4 * (F.lane + 64 * q));
    constexpr int U = 2;
    for (int r0 = gw * U; r0 < TT; r0 += NGW * U) {
        f32x4 v[U][4];
#pragma unroll
        for (int u = 0; u < U; ++u) { const int r = r0 + u;
            const float* src = (r < TL) ? GIN(F, IN_X) + (size_t)r * DM : GIN(F, IN_CTX) + (size_t)(r - TL) * DM;
#pragma unroll
            for (int q = 0; q < 4; ++q) v[u][q] = ((const f32x4*)src)[F.lane + 64 * q]; }
#pragma unroll
        for (int u = 0; u < U; ++u) { const int r = r0 + u; const int j = (r < TL) ? (r >> 13) : 4;
            const float* sh = mod + j * 6144; const float* scl = sh + 1024;
            float ss = 0.f;
#pragma unroll
            for (int q = 0; q < 4; ++q) ss += (v[u][q].x * v[u][q].x + v[u][q].y * v[u][q].y) + (v[u][q].z * v[u][q].z + v[u][q].w * v[u][q].w);
            const float rstd = rsqrtf(wave_sum(ss) * (1.f / DM) + EPS);
#pragma unroll
            for (int q = 0; q < 4; ++q) { const int idx = 4 * (F.lane + 64 * q);
                const f32x4 s1 = *(const f32x4*)(scl + idx), h1 = *(const f32x4*)(sh + idx);
                const f32x4 o = (v[u][q] * rstd * nw[q]) * (s1 + 1.0f) + h1;
                u32x2 pk; pk.x = pk2(o.x, o.y); pk.y = pk2(o.z, o.w);
                *(u32x2*)(H + (size_t)r * DM + idx) = pk; } }
    }
}

__device__ __forceinline__ void ph_conv_g(Ctx& F) {
    const char* P = (const char*)(F.ws + WS_P); bf16_t* XBC = (bf16_t*)(F.ws + WS_XBC);
    const int ch = (F.tid & 127) * 8, qd = F.tid >> 7;
    f32x2 wgt[9][4];
#pragma unroll
    for (int t = 0; t < 9; ++t) { const f32x4 a = *(const f32x4*)(GIN(F, IN_CONVW) + t * 1024 + ch), b4 = *(const f32x4*)(GIN(F, IN_CONVW) + t * 1024 + ch + 4);
        wgt[t][0] = (f32x2){a.x, a.y}; wgt[t][1] = (f32x2){a.z, a.w}; wgt[t][2] = (f32x2){b4.x, b4.y}; wgt[t][3] = (f32x2){b4.z, b4.w}; }
    f32x2 cb[4]; { const f32x4 a = *(const f32x4*)(GIN(F, IN_CONVB) + ch), b4 = *(const f32x4*)(GIN(F, IN_CONVB) + ch + 4); cb[0] = (f32x2){a.x, a.y}; cb[1] = (f32x2){a.z, a.w}; cb[2] = (f32x2){b4.x, b4.y}; cb[3] = (f32x2){b4.z, b4.w}; }
    const int NC = F.G < 8 ? F.G : 8, cx = F.bid % NC, crank = F.bid / NC, cnx = (F.G - cx + NC - 1) / NC;
    const int lat_lo = (2048 * cx) / NC, lat_n = (2048 * (cx + 1)) / NC - lat_lo, ctx_lo = (64 * cx) / NC, ctx_n = (64 * (cx + 1)) / NC - ctx_lo;
    for (int slot = crank; slot < lat_n + ctx_n; slot += cnx) {
        const int item = slot < lat_n ? lat_lo + slot : 2048 + ctx_lo + (slot - lat_n);
        const bool lat = item < 2048;
        int rowbase, x0, W, y = 0, H = 1;
        if (lat) { const int b = item >> 9, yy = (item >> 2) & 127, qg = item & 3; y = yy; H = 128; W = 64; rowbase = b * SEQ + yy * 64; x0 = (qg * 4 + qd) * 4; }
        else { const int q = item - 2048, b = q >> 4, qg = q & 15; W = CTXL; rowbase = TL + b * CTXL; x0 = (qg * 4 + qd) * 4; }
        f32x2 acc[4][4];
#pragma unroll
        for (int p = 0; p < 4; ++p)
#pragma unroll
            for (int i = 0; i < 4; ++i) acc[p][i] = cb[i];
        u32x4 v[3][6];
#pragma unroll
        for (int dy = 0; dy < 3; ++dy) { const int yy = y + dy - 1; const bool rowok = lat ? (yy >= 0 && yy < H) : (dy == 1);
#pragma unroll
            for (int dx = 0; dx < 6; ++dx) { const int xx = x0 + dx - 1; v[dy][dx] = (u32x4){0u, 0u, 0u, 0u};
                if (rowok && xx >= 0 && xx < W) v[dy][dx] = *(const u32x4*)(P + (unsigned)((rowbase + (dy - 1) * 64 + xx) * NP + CX + ch) * 2u); } }
#pragma unroll
        for (int dy = 0; dy < 3; ++dy)
#pragma unroll
            for (int dx = 0; dx < 6; ++dx) { const u32x4 u = v[dy][dx]; f32x2 f[4];
                f[0] = (f32x2){bflo(u.x), bfhi(u.x)}; f[1] = (f32x2){bflo(u.y), bfhi(u.y)}; f[2] = (f32x2){bflo(u.z), bfhi(u.z)}; f[3] = (f32x2){bflo(u.w), bfhi(u.w)};
#pragma unroll
                for (int p = 0; p < 4; ++p) { const int kx = dx - p;
                    if (kx >= 0 && kx < 3) {
#pragma unroll
                        for (int i = 0; i < 4; ++i) acc[p][i] = __builtin_elementwise_fma(f[i], wgt[dy * 3 + kx][i], acc[p][i]); } } }
#pragma unroll
        for (int p = 0; p < 4; ++p) { u32x4 o; o.x = pk2(silu_f(acc[p][0].x), silu_f(acc[p][0].y)); o.y = pk2(silu_f(acc[p][1].x), silu_f(acc[p][1].y)); o.z = pk2(silu_f(acc[p][2].x), silu_f(acc[p][2].y)); o.w = pk2(silu_f(acc[p][3].x), silu_f(acc[p][3].y));
            *(u32x4*)(XBC + (size_t)(rowbase + x0 + p) * 1024 + ch) = o; }
    }
}

__device__ __forceinline__ int scan_row(int b, int dir, int s) {
    if (s < CTXL) { const int t = dir ? (CTXL - 1 - s) : s; return TL + b * CTXL + t; }
    const int s2 = s - CTXL; const int t = dir ? (SEQ - 1 - s2) : s2; return b * SEQ + t;
}

__device__ __forceinline__ void ph_scan_naive(Ctx& F) {
    const bf16_t* P = (const bf16_t*)(F.ws + WS_P); const bf16_t* XBC = (const bf16_t*)(F.ws + WS_XBC); const float* Gb = (const float*)(F.ws + WS_G);
    bf16_t* OG = (bf16_t*)(F.ws + WS_OG); bf16_t* OS = (bf16_t*)(F.ws + WS_OS);
    constexpr int NSTEP = CTXL + SEQ, BT = 16;
    for (int item = F.bid; item < 96; item += F.G) {
        if (item < 32) {
            const int b = item >> 3, h = (item >> 1) & 3, dir = item & 1;
            LAS float* qs = (LAS float*)F.lds; LAS float* ks = qs + BT * 64; LAS float* as = ks + BT * 64; LAS float* vs = as + BT * 64;
            const int v = F.tid >> 2, d0 = (F.tid & 3) * 16;
            float S[16];
#pragma unroll
            for (int d = 0; d < 16; ++d) S[d] = 0.f;
#pragma unroll 1
            for (int s0 = 0; s0 < NSTEP; s0 += BT) {
                __syncthreads();
#pragma unroll 1
                for (int i = F.tid; i < BT * 64; i += 512) { const int tk = i >> 6, d = i & 63; const int row = scan_row(b, dir, s0 + tk);
                    qs[i] = bf2f(P[(size_t)row * NP + CQ + h * 64 + d]) * 0.125f; ks[i] = bf2f(P[(size_t)row * NP + CK + h * 64 + d]);
                    as[i] = __expf(Gb[((size_t)dir * TT + row) * 256 + h * 64 + d]); }
#pragma unroll 1
                for (int i = F.tid; i < BT * 128; i += 512) { const int tk = i >> 7, vv = i & 127; const int row = scan_row(b, dir, s0 + tk); vs[i] = bf2f(P[(size_t)row * NP + CV + h * 128 + vv]); }
                __syncthreads();
#pragma unroll 1
                for (int tk = 0; tk < BT; ++tk) { const float vt = vs[tk * 128 + v]; float o = 0.f;
#pragma unroll
                    for (int d = 0; d < 16; ++d) { S[d] = as[tk * 64 + d0 + d] * S[d] + ks[tk * 64 + d0 + d] * vt; o += qs[tk * 64 + d0 + d] * S[d]; }
                    o += __shfl_xor(o, 1); o += __shfl_xor(o, 2);
                    const int row = scan_row(b, dir, s0 + tk);
                    if (row < TL && (F.tid & 3) == 0) OG[((size_t)dir * TL + row) * 512 + h * 128 + v] = (bf16_t)f2bf(o); }
            }
        } else {
            const int it = item - 32, b = it >> 4, hh = (it >> 1) & 7, dir = it & 1, g = hh >> 2;
            LAS float* Bs = (LAS float*)F.lds; LAS float* Cs = Bs + BT * 128; LAS float* xs = Cs + BT * 128; LAS float* dts = xs + BT * 64; LAS float* das = dts + BT;
            const int pp = F.tid >> 3, sb = (F.tid & 7) * 16;
            const float Ah = -__expf(GIN(F, IN_ALOG)[dir * 8 + hh]), dtb = GIN(F, IN_DTBIAS)[dir * 8 + hh];
            float S[16];
#pragma unroll
            for (int s = 0; s < 16; ++s) S[s] = 0.f;
#pragma unroll 1
            for (int s0 = 0; s0 < NSTEP; s0 += BT) {
                __syncthreads();
#pragma unroll 1
                for (int i = F.tid; i < BT * 128; i += 512) { const int tk = i >> 7, ss = i & 127; const int row = scan_row(b, dir, s0 + tk);
                    Bs[i] = bf2f(XBC[(size_t)row * 1024 + 512 + g * 128 + ss]); Cs[i] = bf2f(XBC[(size_t)row * 1024 + 768 + g * 128 + ss]); }
#pragma unroll 1
                for (int i = F.tid; i < BT * 64; i += 512) { const int tk = i >> 6, c = i & 63; const int row = scan_row(b, dir, s0 + tk); xs[i] = bf2f(XBC[(size_t)row * 1024 + hh * 64 + c]); }
                if (F.tid < BT) { const int row = scan_row(b, dir, s0 + F.tid);
                    const float dt = softplus_f(bf2f(P[(size_t)row * NP + CDT + hh]) + dtb);
                    dts[F.tid] = dt; das[F.tid] = __expf(dt * Ah); }
                __syncthreads();
#pragma unroll 1
                for (int tk = 0; tk < BT; ++tk) { const float dt = dts[tk], dA = das[tk]; const float xdt = xs[tk * 64 + pp] * dt; float y = 0.f;
#pragma unroll
                    for (int s = 0; s < 16; ++s) { S[s] = dA * S[s] + xdt * Bs[tk * 128 + sb + s]; y += Cs[tk * 128 + sb + s] * S[s]; }
                    y += __shfl_xor(y, 1); y += __shfl_xor(y, 2); y += __shfl_xor(y, 4);
                    const int row = scan_row(b, dir, s0 + tk);
                    if (row < TL && (F.tid & 7) == 0) OS[((size_t)dir * TL + row) * 512 + hh * 64 + pp] = (bf16_t)f2bf(y); }
            }
        }
        __syncthreads();
    }
}


typedef short s16x4 __attribute__((ext_vector_type(4)));
__device__ __forceinline__ f32x4 mfma16(bf16x8 a, bf16x8 b, f32x4 c) { return __builtin_amdgcn_mfma_f32_16x16x32_bf16(a, b, c, 0, 0, 0); }
__device__ __forceinline__ bf16x8 ldfrag(const LAS bf16_t* p) { return *(const LAS bf16x8*)p; }
__device__ __forceinline__ bf16x8 ldfrag_perm(const LAS bf16_t* p) { const s16x4 lo = *(const LAS s16x4*)p, hi = *(const LAS s16x4*)(p + 16); return (bf16x8){lo[0], lo[1], lo[2], lo[3], hi[0], hi[1], hi[2], hi[3]}; }
__device__ __forceinline__ bf16x8 ldfrag_tr(const LAS bf16_t* p, int pitch) {
    const s16x4 lo = __builtin_bit_cast(s16x4, __builtin_amdgcn_ds_read_tr16_b64_v4i16((LAS s16x4*)p));
    const s16x4 hi = __builtin_bit_cast(s16x4, __builtin_amdgcn_ds_read_tr16_b64_v4i16((LAS s16x4*)(p + 4 * pitch)));
    return (bf16x8){lo[0], lo[1], lo[2], lo[3], hi[0], hi[1], hi[2], hi[3]};
}
__device__ __forceinline__ bf16x8 acc2frag(f32x4 t0, f32x4 t1) {
    u32x4 w; w.x = pk2(t0[0], t0[1]); w.y = pk2(t0[2], t0[3]); w.z = pk2(t1[0], t1[1]); w.w = pk2(t1[2], t1[3]);
    return __builtin_bit_cast(bf16x8, w);
}
__device__ __forceinline__ int chunk_rlo(int b, int dir, int seg, int c) {
    if (seg == 0) { const int s0 = 64 * c; return TL + b * CTXL + (dir ? (CTXL - 64 - s0) : s0); }
    const int s2 = 512 * (seg - 1) + 64 * c; return b * SEQ + (dir ? (SEQ - 64 - s2) : s2);
}
constexpr int GP = 72, VP = 136, XP = 264;
constexpr int GL_QT = 0, GL_KT = 9216, GL_KHT = 18432, GL_VN = 27648, GL_PM = 45056, GL_TT = 54272, GL_AD = 56320, GL_GL = 56576, GL_OT = 91392;
constexpr int GLP = 68;
constexpr int GL_B2 = 91392, GL_AD2 = 136448;
static_assert(GL_VN + 17408 == GL_PM && GL_B2 >= GL_GL + 2 * 64 * GLP * 4 && GL_B2 + GL_PM <= GL_AD2 && GL_AD2 + 256 <= LDS_BYTES - 64, "GLA double-buffer map");
constexpr int SL_CM = 0, SL_BM = 17408, SL_XM = 34816, SL_MM = 68608, SL_AC = 105472, SL_DT = 106496, SL_W = 107520, SL_E = 108544, SL_DA = 109568, SL_YT = 109584;

struct GlaRegs { unsigned q[8], k[8]; u32x4 v[2]; };
__device__ __forceinline__ float logsigmoid2_16(float v) {
    const float t = v * 1.4426950408889634f; return (fminf(t, 0.f) - __builtin_amdgcn_logf(1.f + __builtin_amdgcn_exp2f(-fabsf(t)))) * (1.f / 16.f); }
template <bool OUT> __device__ __forceinline__ void gla_load(GlaRegs& R, const Ctx& F, int rlo, int dir, int h) {
    const char* P = (const char*)(F.ws + WS_P);
#pragma unroll
    for (int u = 0; u < 2; ++u) { const int idx = F.tid + 512 * u, j = idx >> 4, ch = idx & 15, row = dir ? rlo + 63 - j : rlo + j;
        R.v[u] = *(const u32x4*)(P + (unsigned)(row * NP + CV + h * 128 + ch * 8) * 2u); }
#pragma unroll
    for (int k = 0; k < 8; ++k) { const int j = 8 * F.wave + k, row = dir ? rlo + 63 - j : rlo + j;
        if (OUT) R.q[k] = *(const unsigned short*)(P + (unsigned)(row * NP + CQ + h * 64 + F.lane) * 2u);
        R.k[k] = *(const unsigned short*)(P + (unsigned)(row * NP + CK + h * 64 + F.lane) * 2u); }
}
__device__ __forceinline__ u32x4 gla_load_gk(const Ctx& F, int rlo, int dir) {
    const int j = F.tid >> 1, row = dir ? rlo + 63 - j : rlo + j;
    return *(const u32x4*)((const char*)(F.ws + WS_P) + (unsigned)(row * NP + CGK + (F.tid & 1) * 8) * 2u);
}
__device__ __forceinline__ void gla_store_gk(LAS float* GK, const Ctx& F, u32x4 v) {
    LAS float* o = GK + (F.tid >> 1) * 16 + (F.tid & 1) * 8;
    *(LAS f32x4*)o = (f32x4){bflo(v.x), bfhi(v.x), bflo(v.y), bfhi(v.y)}; *(LAS f32x4*)(o + 4) = (f32x4){bflo(v.z), bfhi(v.z), bflo(v.w), bfhi(v.w)};
}
template <bool OUT> __device__ __forceinline__ void gla_item(const Ctx& F, int seq, int seg) {
    const int b = seq >> 3, h = (seq >> 1) & 3, dir = seq & 1;
    const int l = F.lane, g4 = l >> 4, l15 = l & 15, w = F.wave;
    LAS bf16_t* QT0 = (LAS bf16_t*)(F.lds + GL_QT); LAS bf16_t* KT0 = (LAS bf16_t*)(F.lds + GL_KT); LAS bf16_t* KHT0 = (LAS bf16_t*)(F.lds + GL_KHT);
    LAS bf16_t* VN0 = (LAS bf16_t*)(F.lds + GL_VN); LAS bf16_t* PM = (LAS bf16_t*)(F.lds + GL_PM); LAS float* TTl = (LAS float*)(F.lds + GL_TT); LAS float* AD0 = (LAS float*)(F.lds + GL_AD);
    bf16_t* OG = (bf16_t*)(F.ws + WS_OG); LAS bf16_t* OT = (LAS bf16_t*)(F.lds + GL_OT);
#define GLA_FLUSH(rl) do { _Pragma("unroll") for (int u = 0; u < 2; ++u) { const int idx = F.tid + 512 * u, i = idx >> 4, ch = idx & 15, row = dir ? (rl) + 63 - i : (rl) + i; \
        *(u32x4*)((char*)OG + (unsigned)((dir * TL + row) * 512 + h * 128 + ch * 8) * 2u) = *(const LAS u32x4*)(OT + i * VP + ch * 8); } } while (0)
    f32x4 S[4];
    if (OUT) { const bf16_t* src = (const bf16_t*)(F.ws + WS_SSG) + ((size_t)seq * 16 + (seg - 1)) * 8192 + w * 1024 + l * 16;
#pragma unroll
        for (int dt = 0; dt < 4; ++dt) S[dt] = ld_bf4(src + dt * 4); }
    else {
#pragma unroll
        for (int dt = 0; dt < 4; ++dt) S[dt] = (f32x4){0.f, 0.f, 0.f, 0.f}; }
    float segsum = 0.f;
    const int nch = (seg == 0) ? 4 : 8;
    LAS float* GLb = (LAS float*)(F.lds + GL_GL);
    bf16x8 Aw; f32x4 gb4;
    { const int dcol = h * 64 + 16 * (w & 3) + l15, kb = 8 * (g4 & 1); float wv[8];
#pragma unroll
      for (int t = 0; t < 8; ++t) { const float x = GIN(F, IN_GKUP)[(dir * 16 + kb + t) * 256 + dcol]; const float hi = __builtin_bit_cast(float, pk2(x, 0.f) << 16); wv[t] = (g4 >= 2) ? (x - hi) : x; }
      u32x4 pw; pw.x = pk2(wv[0], wv[1]); pw.y = pk2(wv[2], wv[3]); pw.z = pk2(wv[4], wv[5]); pw.w = pk2(wv[6], wv[7]); Aw = __builtin_bit_cast(bf16x8, pw);
      gb4 = *(const f32x4*)(GIN(F, IN_GKB) + dir * 256 + h * 64 + 16 * (w & 3) + 4 * g4); }
#define GLA_GKLOAD(dst, cc) do { const int _rl = chunk_rlo(b, dir, seg, (cc)); _Pragma("unroll") for (int jj = 0; jj < 2; ++jj) { const int j = 16 * (2 * (w >> 2) + jj) + l15, row = dir ? _rl + 63 - j : _rl + j; \
        dst[jj] = *(const u32x4*)((const char*)(F.ws + WS_P) + (unsigned)(row * NP + CGK + 8 * (g4 & 1)) * 2u); } } while (0)
#define GLA_GCOMP(src, cc) do { _Pragma("unroll") for (int jj = 0; jj < 2; ++jj) { const f32x4 ga = mfma16(Aw, __builtin_bit_cast(bf16x8, src[jj]), (f32x4){0.f, 0.f, 0.f, 0.f}); \
        f32x4 gv; gv.x = logsigmoid2_16(ga.x + gb4.x); gv.y = logsigmoid2_16(ga.y + gb4.y); gv.z = logsigmoid2_16(ga.z + gb4.z); gv.w = logsigmoid2_16(ga.w + gb4.w); \
        *(LAS f32x4*)(GLb + ((cc) & 1) * (64 * GLP) + (16 * (2 * (w >> 2) + jj) + l15) * GLP + 16 * (w & 3) + 4 * g4) = gv; } } while (0)
    u32x4 gkf[2];
    GLA_GKLOAD(gkf, 0); GLA_GCOMP(gkf, 0); GLA_GKLOAD(gkf, 1);
    GlaRegs R; gla_load<OUT>(R, F, chunk_rlo(b, dir, seg, 0), dir, h);
    LBAR();
#pragma unroll 1
    for (int c = 0; c < nch; ++c) {
        const int rlo = chunk_rlo(b, dir, seg, c);
        const int pb = OUT ? (c & 1) : 0;
        LAS bf16_t* QT = QT0 + pb * (GL_B2 / 2); LAS bf16_t* KT = KT0 + pb * (GL_B2 / 2); LAS bf16_t* KHT = KHT0 + pb * (GL_B2 / 2); LAS bf16_t* VN = VN0 + pb * (GL_B2 / 2);
        LAS float* AD = AD0 + pb * ((GL_AD2 - GL_AD) / 4);
        float cs[8]; { float run = 0.f; const LAS float* gl = GLb + (c & 1) * (64 * GLP) + (8 * w) * GLP + l;
#pragma unroll
            for (int k = 0; k < 8; ++k) { run += gl[k * GLP]; cs[k] = run; }
            TTl[w * 64 + l] = run; }
        LBAR();
        float base = 0.f, tot = 0.f;
#pragma unroll
        for (int q = 0; q < 8; ++q) { const float t = TTl[q * 64 + l]; tot += t; base += (q < w) ? t : 0.f; }
        const float etot = __builtin_amdgcn_exp2f(tot);
        { float kh[8];
#pragma unroll
          for (int k2 = 0; k2 < 8; k2 += 2) { float qv[2], kv[2];
#pragma unroll
              for (int u = 0; u < 2; ++u) { const int k = k2 + u; const float bj = base + cs[k]; const float kf = __builtin_bit_cast(float, R.k[k] << 16);
                  const float ek = __builtin_amdgcn_exp2f(-bj);
                  if (OUT) { qv[u] = __builtin_bit_cast(float, R.q[k] << 16) * 0.125f * __builtin_amdgcn_exp2f(bj); kv[u] = kf * ek; }
                  kh[k] = kf * (etot * ek); }
              if (OUT) { const int j = 8 * w + k2; const unsigned qw = pk2(qv[0], qv[1]), kw = pk2(kv[0], kv[1]);
                  QT[j * GP + l] = (bf16_t)(qw & 0xffffu); QT[(j + 1) * GP + l] = (bf16_t)(qw >> 16); KT[j * GP + l] = (bf16_t)(kw & 0xffffu); KT[(j + 1) * GP + l] = (bf16_t)(kw >> 16); } }
          u32x4 pk; pk.x = pk2(kh[0], kh[1]); pk.y = pk2(kh[2], kh[3]); pk.z = pk2(kh[4], kh[5]); pk.w = pk2(kh[6], kh[7]);
          *(LAS u32x4*)(KHT + l * GP + 8 * w) = pk; }
        if (w == 0) { AD[l] = etot; segsum += tot; }
#pragma unroll
        for (int u = 0; u < 2; ++u) { const int idx = F.tid + 512 * u, j = idx >> 4, ch = idx & 15; *(LAS u32x4*)(VN + j * VP + ch * 8) = R.v[u]; }
        LBAR();
        if (c + 1 < nch) gla_load<OUT>(R, F, chunk_rlo(b, dir, seg, c + 1), dir, h);
        if (c + 1 < nch) { GLA_GCOMP(gkf, c + 1); if (c + 2 < nch) GLA_GKLOAD(gkf, c + 2); }
        if (OUT) {
            const int jt = w & 3;
#pragma unroll
            for (int ii = 0; ii < 2; ++ii) { const int it = 2 * (w >> 2) + ii; f32x4 acc = (f32x4){0.f, 0.f, 0.f, 0.f};
                if (jt <= it) {
#pragma unroll
                    for (int ks = 0; ks < 2; ++ks) acc = mfma16(ldfrag(KT + (16 * jt + l15) * GP + 32 * ks + 8 * g4), ldfrag(QT + (16 * it + l15) * GP + 32 * ks + 8 * g4), acc); }
                const int i = 16 * it + l15, j0 = 16 * jt + 4 * g4;
                float p0 = (j0 + 0 <= i) ? acc[0] : 0.f, p1 = (j0 + 1 <= i) ? acc[1] : 0.f, p2 = (j0 + 2 <= i) ? acc[2] : 0.f, p3 = (j0 + 3 <= i) ? acc[3] : 0.f;
                u32x2 pk; pk.x = pk2(p0, p1); pk.y = pk2(p2, p3);
                *(LAS u32x2*)(PM + i * GP + j0) = pk; }
            LBAR();
        }
        bf16x8 Bv[2];
#pragma unroll
        for (int ks = 0; ks < 2; ++ks) Bv[ks] = ldfrag_tr(VN + (32 * ks + 8 * g4 + (l15 >> 2)) * VP + 16 * w + 4 * (l & 3), VP);
        if (OUT) {
            bf16x8 Bs[2];
#pragma unroll
            for (int ks = 0; ks < 2; ++ks) Bs[ks] = acc2frag(S[2 * ks], S[2 * ks + 1]);
#pragma unroll
            for (int it = 0; it < 4; ++it) { f32x4 acc = (f32x4){0.f, 0.f, 0.f, 0.f};
#pragma unroll
                for (int ks = 0; ks < 2; ++ks) acc = mfma16(Bv[ks], ldfrag(PM + (16 * it + l15) * GP + 32 * ks + 8 * g4), acc);
#pragma unroll
                for (int ks = 0; ks < 2; ++ks) acc = mfma16(Bs[ks], ldfrag_perm(QT + (16 * it + l15) * GP + 32 * ks + 4 * g4), acc);
                { const int i = 16 * it + l15, row = dir ? rlo + 63 - i : rlo + i; u32x2 ow; ow.x = pk2(acc[0], acc[1]); ow.y = pk2(acc[2], acc[3]);
                  *(u32x2*)((char*)OG + (unsigned)((dir * TL + row) * 512 + h * 128 + 16 * w + 4 * g4) * 2u) = ow; } }
        }
#pragma unroll
        for (int dt = 0; dt < 4; ++dt) { const f32x4 av = *(const LAS f32x4*)(AD + 16 * dt + 4 * g4); S[dt] = S[dt] * av;
#pragma unroll
            for (int ks = 0; ks < 2; ++ks) S[dt] = mfma16(ldfrag(KHT + (16 * dt + l15) * GP + 32 * ks + 8 * g4), Bv[ks], S[dt]); }
        if (!OUT) LBAR();
    }
    if (OUT) LBAR();
#undef GLA_FLUSH
#undef GLA_GKLOAD
#undef GLA_GCOMP
    if (!OUT) { bf16_t* dst = (bf16_t*)(F.ws + WS_USG) + ((size_t)seq * 17 + seg) * 8192 + w * 1024 + l * 16;
#pragma unroll
        for (int dt = 0; dt < 4; ++dt) st_bf4(dst + dt * 4, S[dt]);
        if (w == 0) ((float*)(F.ws + WS_ASG))[((size_t)seq * 17 + seg) * 64 + l] = segsum; }
}

constexpr int GB_KHTF = 0, GB_KHTR = 9216, GB_VN = 18432, GB_TTF = 35840, GB_TTR = 37888, GB_AD = 39936, GB_GLF = 40192, GB_GLR = 75008;
static_assert(GB_GLR + 2 * 64 * GLP * 4 <= MISC_OFF, "fused phase-A GLA tiles fit the LDS");
__device__ __forceinline__ void gla_item_a2(const Ctx& F, int bh, int blk) {
    const int b = bh >> 2, h = bh & 3;
    const int l = F.lane, g4 = l >> 4, l15 = l & 15, w = F.wave;
    const bool ctx = blk < 0;
    const int row0 = ctx ? TL + b * CTXL : b * SEQ + 512 * blk, nch = ctx ? 4 : 8;
    LAS bf16_t* KHTf = (LAS bf16_t*)(F.lds + GB_KHTF); LAS bf16_t* KHTr = (LAS bf16_t*)(F.lds + GB_KHTR); LAS bf16_t* VN = (LAS bf16_t*)(F.lds + GB_VN);
    LAS float* TTf = (LAS float*)(F.lds + GB_TTF); LAS float* TTr = (LAS float*)(F.lds + GB_TTR); LAS float* AD = (LAS float*)(F.lds + GB_AD);
    LAS float* GLf = (LAS float*)(F.lds + GB_GLF); LAS float* GLr = (LAS float*)(F.lds + GB_GLR);
    const char* P = (const char*)(F.ws + WS_P);
    f32x4 Sf[4], Sr[4];
#pragma unroll
    for (int dt = 0; dt < 4; ++dt) { Sf[dt] = (f32x4){0.f, 0.f, 0.f, 0.f}; Sr[dt] = Sf[dt]; }
    float sumf = 0.f, sumr = 0.f, Pr = 0.f;
    bf16x8 Aw[2]; f32x4 gb4[2];
#pragma unroll
    for (int dir = 0; dir < 2; ++dir) { const int dcol = h * 64 + 16 * (w & 3) + l15, kb = 8 * (g4 & 1); float wv[8];
#pragma unroll
      for (int t = 0; t < 8; ++t) { const float x = GIN(F, IN_GKUP)[(dir * 16 + kb + t) * 256 + dcol]; const float hi = __builtin_bit_cast(float, pk2(x, 0.f) << 16); wv[t] = (g4 >= 2) ? (x - hi) : x; }
      u32x4 pw; pw.x = pk2(wv[0], wv[1]); pw.y = pk2(wv[2], wv[3]); pw.z = pk2(wv[4], wv[5]); pw.w = pk2(wv[6], wv[7]); Aw[dir] = __builtin_bit_cast(bf16x8, pw);
      gb4[dir] = *(const f32x4*)(GIN(F, IN_GKB) + dir * 256 + h * 64 + 16 * (w & 3) + 4 * g4); }
#define GB_GKLOAD(dst, cc) do { _Pragma("unroll") for (int jj = 0; jj < 2; ++jj) { const int row = row0 + 64 * (cc) + 16 * (2 * (w >> 2) + jj) + l15; \
        dst[jj] = *(const u32x4*)(P + (unsigned)(row * NP + CGK + 8 * (g4 & 1)) * 2u); } } while (0)
#define GB_GCOMP(src, cc) do { _Pragma("unroll") for (int jj = 0; jj < 2; ++jj) { _Pragma("unroll") for (int dir = 0; dir < 2; ++dir) { \
        const f32x4 ga = mfma16(Aw[dir], __builtin_bit_cast(bf16x8, src[jj]), (f32x4){0.f, 0.f, 0.f, 0.f}); \
        f32x4 gv; gv.x = logsigmoid2_16(ga.x + gb4[dir].x); gv.y = logsigmoid2_16(ga.y + gb4[dir].y); gv.z = logsigmoid2_16(ga.z + gb4[dir].z); gv.w = logsigmoid2_16(ga.w + gb4[dir].w); \
        *(LAS f32x4*)((dir ? GLr : GLf) + ((cc) & 1) * (64 * GLP) + (16 * (2 * (w >> 2) + jj) + l15) * GLP + 16 * (w & 3) + 4 * g4) = gv; } } } while (0)
#define GB_LOAD(cc) do { _Pragma("unroll") for (int u = 0; u < 2; ++u) { const int idx = F.tid + 512 * u, j = idx >> 4, ch = idx & 15, row = row0 + 64 * (cc) + j; \
        Rv[u] = *(const u32x4*)(P + (unsigned)(row * NP + CV + h * 128 + ch * 8) * 2u); } \
        _Pragma("unroll") for (int k = 0; k < 8; ++k) { const int row = row0 + 64 * (cc) + 8 * w + k; Rk[k] = *(const unsigned short*)(P + (unsigned)(row * NP + CK + h * 64 + l) * 2u); } } while (0)
    u32x4 gkf[2]; unsigned Rk[8]; u32x4 Rv[2];
    GB_GKLOAD(gkf, 0); GB_GCOMP(gkf, 0); GB_GKLOAD(gkf, 1);
    GB_LOAD(0);
    LBAR();
#pragma unroll 1
    for (int c = 0; c < nch; ++c) {
        float csf[8], exr[8];
        { float runf = 0.f, runr = 0.f; const LAS float* gf = GLf + (c & 1) * (64 * GLP) + (8 * w) * GLP + l; const LAS float* gr = GLr + (c & 1) * (64 * GLP) + (8 * w) * GLP + l;
#pragma unroll
          for (int k = 0; k < 8; ++k) { runf += gf[k * GLP]; csf[k] = runf; exr[k] = runr; runr += gr[k * GLP]; }
          TTf[w * 64 + l] = runf; TTr[w * 64 + l] = runr; }
        LBAR();
        float basef = 0.f, totf = 0.f, baser = 0.f, totr = 0.f;
#pragma unroll
        for (int q = 0; q < 8; ++q) { const float tf = TTf[q * 64 + l], tr = TTr[q * 64 + l]; totf += tf; totr += tr; basef += (q < w) ? tf : 0.f; baser += (q < w) ? tr : 0.f; }
        const float etot = __builtin_amdgcn_exp2f(totf);
        { float khf[8], khr[8];
#pragma unroll
          for (int k = 0; k < 8; ++k) { const float kf = __builtin_bit_cast(float, Rk[k] << 16);
              khf[k] = kf * (etot * __builtin_amdgcn_exp2f(-(basef + csf[k]))); khr[k] = kf * __builtin_amdgcn_exp2f(Pr + baser + exr[k]); }
          u32x4 pf, pr; pf.x = pk2(khf[0], khf[1]); pf.y = pk2(khf[2], khf[3]); pf.z = pk2(khf[4], khf[5]); pf.w = pk2(khf[6], khf[7]);
          pr.x = pk2(khr[0], khr[1]); pr.y = pk2(khr[2], khr[3]); pr.z = pk2(khr[4], khr[5]); pr.w = pk2(khr[6], khr[7]);
          *(LAS u32x4*)(KHTf + l * GP + 8 * w) = pf; *(LAS u32x4*)(KHTr + l * GP + 8 * w) = pr; }
        if (w == 0) { AD[l] = etot; sumf += totf; sumr += totr; }
        Pr += totr;
#pragma unroll
        for (int u = 0; u < 2; ++u) { const int idx = F.tid + 512 * u, j = idx >> 4, ch = idx & 15; *(LAS u32x4*)(VN + j * VP + ch * 8) = Rv[u]; }
        LBAR();
        if (c + 1 < nch) GB_LOAD(c + 1);
        if (c + 1 < nch) { GB_GCOMP(gkf, c + 1); if (c + 2 < nch) GB_GKLOAD(gkf, c + 2); }
        bf16x8 Bv[2];
#pragma unroll
        for (int ks = 0; ks < 2; ++ks) Bv[ks] = ldfrag_tr(VN + (32 * ks + 8 * g4 + (l15 >> 2)) * VP + 16 * w + 4 * (l & 3), VP);
#pragma unroll
        for (int dt = 0; dt < 4; ++dt) { const f32x4 av = *(const LAS f32x4*)(AD + 16 * dt + 4 * g4); Sf[dt] = Sf[dt] * av;
#pragma unroll
            for (int ks = 0; ks < 2; ++ks) { Sf[dt] = mfma16(ldfrag(KHTf + (16 * dt + l15) * GP + 32 * ks + 8 * g4), Bv[ks], Sf[dt]);
                                             Sr[dt] = mfma16(ldfrag(KHTr + (16 * dt + l15) * GP + 32 * ks + 8 * g4), Bv[ks], Sr[dt]); } }
        LBAR();
    }
#undef GB_GKLOAD
#undef GB_GCOMP
#undef GB_LOAD
    if (ctx || blk <= 14) { const int seq = bh * 2, seg = ctx ? 0 : blk + 1;
        bf16_t* dst = (bf16_t*)(F.ws + WS_USG) + ((size_t)seq * 17 + seg) * 8192 + w * 1024 + l * 16;
#pragma unroll
        for (int dt = 0; dt < 4; ++dt) st_bf4(dst + dt * 4, Sf[dt]);
        if (w == 0) ((float*)(F.ws + WS_ASG))[((size_t)seq * 17 + seg) * 64 + l] = sumf; }
    if (ctx || blk >= 1) { const int seq = bh * 2 + 1, seg = ctx ? 0 : 16 - blk;
        bf16_t* dst = (bf16_t*)(F.ws + WS_USG) + ((size_t)seq * 17 + seg) * 8192 + w * 1024 + l * 16;
#pragma unroll
        for (int dt = 0; dt < 4; ++dt) st_bf4(dst + dt * 4, Sr[dt]);
        if (w == 0) ((float*)(F.ws + WS_ASG))[((size_t)seq * 17 + seg) * 64 + l] = sumr; }
}

struct SsdRegs { u32x4 c[2], bm[2], x[4]; unsigned dtraw; };
template <bool OUT> __device__ __forceinline__ void ssd_load1(SsdRegs& R, const Ctx& F, int rlo, int dir, int g) {
    const char* P = (const char*)(F.ws + WS_P); const char* XBC = (const char*)(F.ws + WS_XBC);
#pragma unroll
    for (int u = 0; u < 2; ++u) { const int idx = F.tid + 512 * u, j = idx >> 4, ch = idx & 15, row = dir ? rlo + 63 - j : rlo + j;
        R.bm[u] = *(const u32x4*)(XBC + (unsigned)(row * 1024 + 512 + g * 128 + ch * 8) * 2u); }
    R.dtraw = 0u;
    if (F.wave < 4) { const int row = dir ? rlo + 63 - F.lane : rlo + F.lane; R.dtraw = *(const unsigned short*)(P + (unsigned)(row * NP + CDT + g * 4 + F.wave) * 2u); }
}
template <bool OUT> __device__ __forceinline__ void ssd_load2(SsdRegs& R, const Ctx& F, int rlo, int dir, int g) {
    const char* XBC = (const char*)(F.ws + WS_XBC);
    if (OUT) {
#pragma unroll
        for (int u = 0; u < 2; ++u) { const int idx = F.tid + 512 * u, j = idx >> 4, ch = idx & 15, row = dir ? rlo + 63 - j : rlo + j;
            R.c[u] = *(const u32x4*)(XBC + (unsigned)(row * 1024 + 768 + g * 128 + ch * 8) * 2u); } }
#pragma unroll
    for (int u = 0; u < 4; ++u) { const int idx = F.tid + 512 * u, j = idx >> 5, ch = idx & 31, row = dir ? rlo + 63 - j : rlo + j;
        R.x[u] = *(const u32x4*)(XBC + (unsigned)(row * 1024 + g * 256 + ch * 8) * 2u); }
}
template <bool OUT> __device__ __forceinline__ void ssd_item(const Ctx& F, int sg, int seg) {
    const int b = sg >> 2, g = (sg >> 1) & 1, dir = sg & 1;
    const int l = F.lane, g4 = l >> 4, l15 = l & 15, w = F.wave, r = w >> 1, ph = w & 1;
    LAS bf16_t* CM = (LAS bf16_t*)(F.lds + SL_CM); LAS bf16_t* BM = (LAS bf16_t*)(F.lds + SL_BM); LAS bf16_t* XM = (LAS bf16_t*)(F.lds + SL_XM); LAS bf16_t* MM = (LAS bf16_t*)(F.lds + SL_MM);
    LAS float* AC = (LAS float*)(F.lds + SL_AC); LAS float* DTl = (LAS float*)(F.lds + SL_DT); LAS float* Wl = (LAS float*)(F.lds + SL_W); LAS float* El = (LAS float*)(F.lds + SL_E); LAS float* DAl = (LAS float*)(F.lds + SL_DA);
    bf16_t* OS = (bf16_t*)(F.ws + WS_OS); LAS bf16_t* YT = (LAS bf16_t*)(F.lds + SL_YT);
#define SSD_FLUSH(rl) do { _Pragma("unroll") for (int u = 0; u < 4; ++u) { const int idx = F.tid + 512 * u, i = idx >> 5, ch = idx & 31, row = dir ? (rl) + 63 - i : (rl) + i; \
        *(u32x4*)((char*)OS + (unsigned)((dir * TL + row) * 512 + g * 256 + ch * 8) * 2u) = *(const LAS u32x4*)(YT + i * XP + ch * 8); } } while (0)
    f32x4 ST[8][2];
    if (OUT) { const bf16_t* src = (const bf16_t*)(F.ws + WS_SSS) + ((size_t)sg * 16 + (seg - 1)) * 32768 + w * 4096 + l * 64;
#pragma unroll
        for (int st = 0; st < 8; ++st)
#pragma unroll
            for (int nt = 0; nt < 2; ++nt) ST[st][nt] = ld_bf4(src + (st * 2 + nt) * 4); }
    else {
#pragma unroll
        for (int st = 0; st < 8; ++st)
#pragma unroll
            for (int nt = 0; nt < 2; ++nt) ST[st][nt] = (f32x4){0.f, 0.f, 0.f, 0.f}; }
    const int hh4 = (w < 4) ? (g * 4 + w) : 0;
    const float Ah = -__expf(GIN(F, IN_ALOG)[dir * 8 + hh4]) * 1.4426950408889634f, dtb = GIN(F, IN_DTBIAS)[dir * 8 + hh4];
    float segsum = 0.f;
    const int nch = (seg == 0) ? 4 : 8;
    SsdRegs R; ssd_load1<OUT>(R, F, chunk_rlo(b, dir, seg, 0), dir, g); ssd_load2<OUT>(R, F, chunk_rlo(b, dir, seg, 0), dir, g);
#pragma unroll 1
    for (int c = 0; c < nch; ++c) {
        const int rlo = chunk_rlo(b, dir, seg, c);
#pragma unroll
        for (int u = 0; u < 2; ++u) { const int idx = F.tid + 512 * u, j = idx >> 4, ch = idx & 15;
            if (OUT) *(LAS u32x4*)(CM + j * VP + ch * 8) = R.c[u];
            *(LAS u32x4*)(BM + j * VP + ch * 8) = R.bm[u]; }
#pragma unroll
        for (int u = 0; u < 4; ++u) { const int idx = F.tid + 512 * u, j = idx >> 5, ch = idx & 31; *(LAS u32x4*)(XM + j * XP + ch * 8) = R.x[u]; }
        if (w < 4) { const float dtx = __builtin_bit_cast(float, R.dtraw << 16) + dtb;
            const float dt = fmaxf(dtx, 0.f) + 0.6931471805599453f * __builtin_amdgcn_logf(1.f + __builtin_amdgcn_exp2f(-fabsf(dtx) * 1.4426950408889634f)); float a = dt * Ah;
#pragma unroll
            for (int off = 1; off < 64; off <<= 1) { const float t = __shfl_up(a, off); if (l >= off) a += t; }
            const float alast = __shfl(a, 63);
            AC[w * 64 + l] = a; DTl[w * 64 + l] = dt; Wl[w * 64 + l] = __builtin_amdgcn_exp2f(alast - a) * dt; El[w * 64 + l] = __builtin_amdgcn_exp2f(a);
            if (l == 0) DAl[w] = __builtin_amdgcn_exp2f(alast);
            segsum += alast; }
        LBAR();
        if (c + 1 < nch) ssd_load1<OUT>(R, F, chunk_rlo(b, dir, seg, c + 1), dir, g);
        if (OUT) {
            const int jt = w & 3;
#pragma unroll
            for (int ii = 0; ii < 2; ++ii) { const int it = 2 * (w >> 2) + ii; f32x4 acc = (f32x4){0.f, 0.f, 0.f, 0.f};
                if (jt <= it) {
#pragma unroll
                    for (int ks = 0; ks < 4; ++ks) acc = mfma16(ldfrag(BM + (16 * jt + l15) * VP + 32 * ks + 8 * g4), ldfrag(CM + (16 * it + l15) * VP + 32 * ks + 8 * g4), acc); }
                const int i = 16 * it + l15, j0 = 16 * jt + 4 * g4;
#pragma unroll
                for (int rr = 0; rr < 4; ++rr) { const float ai = AC[rr * 64 + i]; const f32x4 aj = *(const LAS f32x4*)(AC + rr * 64 + j0), dj = *(const LAS f32x4*)(DTl + rr * 64 + j0);
                    float m[4];
#pragma unroll
                    for (int q = 0; q < 4; ++q) m[q] = (j0 + q <= i) ? acc[q] * __builtin_amdgcn_exp2f(fminf(ai - aj[q], 0.f)) * dj[q] : 0.f;
                    u32x2 pk; pk.x = pk2(m[0], m[1]); pk.y = pk2(m[2], m[3]);
                    *(LAS u32x2*)(MM + (rr * 64 + i) * GP + j0) = pk; } }
            LBAR();
        }
        const int p0 = 64 * r + 32 * ph;
        if (OUT) {
#pragma unroll
            for (int nt = 0; nt < 2; ++nt) {
                f32x4 ay[4];
#pragma unroll
                for (int it = 0; it < 4; ++it) ay[it] = (f32x4){0.f, 0.f, 0.f, 0.f};
                bf16x8 Ac[4], An[4];
#pragma unroll
                for (int it = 0; it < 4; ++it) Ac[it] = ldfrag_perm(CM + (16 * it + l15) * VP + 4 * g4);
#pragma unroll
                for (int ks = 0; ks < 4; ++ks) {
                    if (ks < 3) {
#pragma unroll
                        for (int it = 0; it < 4; ++it) An[it] = ldfrag_perm(CM + (16 * it + l15) * VP + 32 * (ks + 1) + 4 * g4); }
                    else {
#pragma unroll
                        for (int it = 0; it < 4; ++it) An[it] = ldfrag(MM + (r * 64 + 16 * it + l15) * GP + 8 * g4); }
                    const bf16x8 Bst = acc2frag(ST[2 * ks][nt], ST[2 * ks + 1][nt]);
#pragma unroll
                    for (int it = 0; it < 4; ++it) ay[it] = mfma16(Bst, Ac[it], ay[it]);
                    __builtin_amdgcn_sched_barrier(0);
#pragma unroll
                    for (int it = 0; it < 4; ++it) Ac[it] = An[it]; }
                bf16x8 Bx0 = ldfrag_tr(XM + (8 * g4 + (l15 >> 2)) * XP + p0 + 16 * nt + 4 * (l & 3), XP);
                const bf16x8 Bx1 = ldfrag_tr(XM + (32 + 8 * g4 + (l15 >> 2)) * XP + p0 + 16 * nt + 4 * (l & 3), XP);
#pragma unroll
                for (int it = 0; it < 4; ++it) { const float ev = El[r * 64 + 16 * it + l15]; ay[it] = ay[it] * ev; }
#pragma unroll
                for (int it = 0; it < 4; ++it) An[it] = ldfrag(MM + (r * 64 + 16 * it + l15) * GP + 32 + 8 * g4);
#pragma unroll
                for (int it = 0; it < 4; ++it) ay[it] = mfma16(Bx0, Ac[it], ay[it]);
                __builtin_amdgcn_sched_barrier(0);
#pragma unroll
                for (int it = 0; it < 4; ++it) ay[it] = mfma16(Bx1, An[it], ay[it]);
#pragma unroll
                for (int it = 0; it < 4; ++it) {
                    const int i = 16 * it + l15, row = dir ? rlo + 63 - i : rlo + i; u32x2 ow; ow.x = pk2(ay[it][0], ay[it][1]); ow.y = pk2(ay[it][2], ay[it][3]);
                    *(u32x2*)((char*)OS + (unsigned)((dir * TL + row) * 512 + g * 256 + p0 + 16 * nt + 4 * g4) * 2u) = ow; }
                __builtin_amdgcn_sched_barrier(0);
            }
        }
        if (c + 1 < nch) ssd_load2<OUT>(R, F, chunk_rlo(b, dir, seg, c + 1), dir, g);
        { const float dA = DAl[r];
          bf16x8 Bx[2][2];
#pragma unroll
          for (int ks = 0; ks < 2; ++ks)
#pragma unroll
              for (int nt = 0; nt < 2; ++nt) Bx[ks][nt] = ldfrag_tr(XM + (32 * ks + 8 * g4 + (l15 >> 2)) * XP + p0 + 16 * nt + 4 * (l & 3), XP);
          bf16x8 Af[2]; Af[0] = ldfrag_tr(BM + (8 * g4 + (l15 >> 2)) * VP + 4 * (l & 3), VP); Af[1] = ldfrag_tr(BM + (32 + 8 * g4 + (l15 >> 2)) * VP + 4 * (l & 3), VP);
          bf16x8 Bw[2][2];
#pragma unroll
          for (int ks = 0; ks < 2; ++ks) { const f32x4 w0 = *(const LAS f32x4*)(Wl + r * 64 + 32 * ks + 8 * g4), w1 = *(const LAS f32x4*)(Wl + r * 64 + 32 * ks + 8 * g4 + 4);
#pragma unroll
              for (int nt = 0; nt < 2; ++nt) { const u32x4 xv = __builtin_bit_cast(u32x4, Bx[ks][nt]); u32x4 o;
                  o.x = pk2(bflo(xv.x) * w0[0], bfhi(xv.x) * w0[1]); o.y = pk2(bflo(xv.y) * w0[2], bfhi(xv.y) * w0[3]);
                  o.z = pk2(bflo(xv.z) * w1[0], bfhi(xv.z) * w1[1]); o.w = pk2(bflo(xv.w) * w1[2], bfhi(xv.w) * w1[3]);
                  Bw[ks][nt] = __builtin_bit_cast(bf16x8, o); } }
#pragma unroll
          for (int st = 0; st < 8; ++st) { ST[st][0] = ST[st][0] * dA; ST[st][1] = ST[st][1] * dA;
              bf16x8 Ag[2]; if (st < 7) { Ag[0] = ldfrag_tr(BM + (8 * g4 + (l15 >> 2)) * VP + 16 * (st + 1) + 4 * (l & 3), VP); Ag[1] = ldfrag_tr(BM + (32 + 8 * g4 + (l15 >> 2)) * VP + 16 * (st + 1) + 4 * (l & 3), VP); }
              else { Ag[0] = Af[0]; Ag[1] = Af[1]; }
#pragma unroll
              for (int ks = 0; ks < 2; ++ks) { ST[st][0] = mfma16(Af[ks], Bw[ks][0], ST[st][0]); ST[st][1] = mfma16(Af[ks], Bw[ks][1], ST[st][1]); }
              __builtin_amdgcn_sched_barrier(0);
              Af[0] = Ag[0]; Af[1] = Ag[1]; } }
        LBAR();
    }
#undef SSD_FLUSH
    if (!OUT) { bf16_t* dst = (bf16_t*)(F.ws + WS_USS) + ((size_t)sg * 17 + seg) * 32768 + w * 4096 + l * 64;
#pragma unroll
        for (int st = 0; st < 8; ++st)
#pragma unroll
            for (int nt = 0; nt < 2; ++nt) st_bf4(dst + (st * 2 + nt) * 4, ST[st][nt]);
        if (w < 4 && l == 0) ((float*)(F.ws + WS_ASS))[((size_t)sg * 17 + seg) * 4 + w] = segsum; }
}

__device__ __forceinline__ void ph_scan_a(Ctx& F, int types = 3) {
    if (F.G == 256) {
        if (F.bid >= 128) {
            if (types & 1) { const int it = 2 * (F.bid - 128); gla_item_a2(F, it >> 4, it & 15); gla_item_a2(F, (it + 1) >> 4, (it + 1) & 15); }
        } else {
            const int bg = F.bid >> 4, blk = F.bid & 15;
            if ((types & 1) && (blk == 0 || blk == 15)) gla_item_a2(F, bg * 2 + (blk == 15 ? 1 : 0), -1);
            if (types & 2) {
                if (blk <= 14) ssd_item<false>(F, bg * 2, blk + 1);
                if (blk >= 1) ssd_item<false>(F, bg * 2 + 1, 16 - blk);
                if (blk == 0 || blk == 15) ssd_item<false>(F, bg * 2 + (blk == 15 ? 1 : 0), 0);
            }
        }
        return;
    }
    if (types & 1) {
        for (int it = F.bid; it < 256 + 16; it += F.G) { if (it < 256) gla_item_a2(F, it >> 4, it & 15); else gla_item_a2(F, it - 256, -1); }
    }
    if (types & 2) {
        for (int item = F.bid; item < 240 + 16; item += F.G) { if (item < 240) ssd_item<false>(F, item / 15, 1 + item % 15); else ssd_item<false>(F, item - 240, 0); }
    }
}
__device__ __forceinline__ void ph_scan_b(Ctx& F) {
    const int gt = F.bid * 512 + F.tid, NT = F.G * 512;
    for (int it = gt; it < 32 * 2048 + 16 * 8192; it += NT) {
        if (it < 32 * 2048) {
            const int seq = it >> 11, e4 = it & 2047, e = e4 * 4, lane = (e >> 4) & 63, dt = (e >> 2) & 3, d0 = 16 * dt + 4 * (lane >> 4);
            const bf16_t* U = (const bf16_t*)(F.ws + WS_USG) + (size_t)seq * 17 * 8192 + e; const float* A = (const float*)(F.ws + WS_ASG) + (size_t)seq * 17 * 64 + d0;
            bf16_t* O = (bf16_t*)(F.ws + WS_SSG) + (size_t)seq * 16 * 8192 + e;
            u32x2 uu[16]; f32x4 aa[16];
#pragma unroll
            for (int m = 0; m < 16; ++m) { uu[m] = *(const u32x2*)(U + (size_t)m * 8192); aa[m] = *(const f32x4*)(A + m * 64); }
            f32x4 S = (f32x4){bflo(uu[0].x), bfhi(uu[0].x), bflo(uu[0].y), bfhi(uu[0].y)}; st_bf4(O, S);
#pragma unroll
            for (int m = 1; m < 16; ++m) { const f32x4 u = (f32x4){bflo(uu[m].x), bfhi(uu[m].x), bflo(uu[m].y), bfhi(uu[m].y)}; const f32x4 a = aa[m];
                S.x = __builtin_amdgcn_exp2f(a.x) * S.x + u.x; S.y = __builtin_amdgcn_exp2f(a.y) * S.y + u.y; S.z = __builtin_amdgcn_exp2f(a.z) * S.z + u.z; S.w = __builtin_amdgcn_exp2f(a.w) * S.w + u.w;
                st_bf4(O + (size_t)m * 8192, S); }
        } else {
            const int q = it - 32 * 2048, sg = q >> 13, e4 = q & 8191, e = e4 * 4, r = (e >> 12) >> 1;
            const bf16_t* U = (const bf16_t*)(F.ws + WS_USS) + (size_t)sg * 17 * 32768 + e; const float* A = (const float*)(F.ws + WS_ASS) + (size_t)sg * 17 * 4 + r;
            bf16_t* O = (bf16_t*)(F.ws + WS_SSS) + (size_t)sg * 16 * 32768 + e;
            u32x2 uu[16]; float aa[16];
#pragma unroll
            for (int m = 0; m < 16; ++m) { uu[m] = *(const u32x2*)(U + (size_t)m * 32768); aa[m] = A[m * 4]; }
            f32x4 S = (f32x4){bflo(uu[0].x), bfhi(uu[0].x), bflo(uu[0].y), bfhi(uu[0].y)}; st_bf4(O, S);
#pragma unroll
            for (int m = 1; m < 16; ++m) { const f32x4 u = (f32x4){bflo(uu[m].x), bfhi(uu[m].x), bflo(uu[m].y), bfhi(uu[m].y)}; const float a = __builtin_amdgcn_exp2f(aa[m]);
                S = S * a + u; st_bf4(O + (size_t)m * 32768, S); }
        }
    }
}
__device__ __forceinline__ void combine_gla_block(const Ctx& F, int b, int h, int seg) {
    const char* OG = (const char*)(F.ws + WS_OG); const char* P = (const char*)(F.ws + WS_P); char* Y = (char*)(F.ws + WS_Y);
    int l = F.lane; asm volatile("" : "+v"(l));
    const int sub = l >> 4, c8 = (l & 15) * 8, row0 = b * SEQ + 512 * (seg - 1);
    float nw[8]; { const f32x4 n0 = *(const f32x4*)(GIN(F, IN_GLANORM) + c8), n1 = *(const f32x4*)(GIN(F, IN_GLANORM) + c8 + 4); nw[0] = n0.x; nw[1] = n0.y; nw[2] = n0.z; nw[3] = n0.w; nw[4] = n1.x; nw[5] = n1.y; nw[6] = n1.z; nw[7] = n1.w; }
    constexpr int U = 4;
    for (int t0 = F.wave * 4 * U; t0 < 512; t0 += 8 * 4 * U) {
        u32x4 a[U], c[U], g[U];
#pragma unroll
        for (int u = 0; u < U; ++u) { const int row = row0 + t0 + 4 * u + sub;
            a[u] = *(const u32x4*)(OG + (unsigned)(row * 512 + h * 128 + c8) * 2u); c[u] = *(const u32x4*)(OG + (unsigned)((TL + row) * 512 + h * 128 + c8) * 2u);
            g[u] = *(const u32x4*)(P + (unsigned)(row * NP + CG + h * 128 + c8) * 2u); }
#pragma unroll
        for (int u = 0; u < U; ++u) { const int row = row0 + t0 + 4 * u + sub;
            float o[8], gt[8];
            o[0] = bflo(a[u].x) + bflo(c[u].x); o[1] = bfhi(a[u].x) + bfhi(c[u].x); o[2] = bflo(a[u].y) + bflo(c[u].y); o[3] = bfhi(a[u].y) + bfhi(c[u].y);
            o[4] = bflo(a[u].z) + bflo(c[u].z); o[5] = bfhi(a[u].z) + bfhi(c[u].z); o[6] = bflo(a[u].w) + bflo(c[u].w); o[7] = bfhi(a[u].w) + bfhi(c[u].w);
            gt[0] = bflo(g[u].x); gt[1] = bfhi(g[u].x); gt[2] = bflo(g[u].y); gt[3] = bfhi(g[u].y); gt[4] = bflo(g[u].z); gt[5] = bfhi(g[u].z); gt[6] = bflo(g[u].w); gt[7] = bfhi(g[u].w);
            float ss = 0.f;
#pragma unroll
            for (int i = 0; i < 8; ++i) ss += o[i] * o[i];
            ss += __shfl_xor(ss, 1); ss += __shfl_xor(ss, 2); ss += __shfl_xor(ss, 4); ss += __shfl_xor(ss, 8);
            const float rstd = rsqrtf(ss * (1.f / 128.f) + EPS);
#pragma unroll
            for (int i = 0; i < 8; ++i) o[i] = o[i] * rstd * nw[i] * silu_f(gt[i]);
            u32x2 w; w.x = pg8::pk4_fp8(o[0] * YSCALE8, o[1] * YSCALE8, o[2] * YSCALE8, o[3] * YSCALE8); w.y = pg8::pk4_fp8(o[4] * YSCALE8, o[5] * YSCALE8, o[6] * YSCALE8, o[7] * YSCALE8);
            *(u32x2*)(Y + (unsigned)(row * 1024 + h * 128 + c8)) = w; }
    }
}
__device__ __forceinline__ void combine_ssd_block(const Ctx& F, int b, int g, int seg) {
    const char* OS = (const char*)(F.ws + WS_OS); const char* P = (const char*)(F.ws + WS_P); const char* XBC = (const char*)(F.ws + WS_XBC); char* Y = (char*)(F.ws + WS_Y);
    int l = F.lane; asm volatile("" : "+v"(l));
    const int sub = l >> 5, c0 = g * 256 + (l & 31) * 8, row0 = b * SEQ + 512 * (seg - 1);
    float nw[8]; { const f32x4 n0 = *(const f32x4*)(GIN(F, IN_SSDNORM) + c0), n1 = *(const f32x4*)(GIN(F, IN_SSDNORM) + c0 + 4); nw[0] = n0.x; nw[1] = n0.y; nw[2] = n0.z; nw[3] = n0.w; nw[4] = n1.x; nw[5] = n1.y; nw[6] = n1.z; nw[7] = n1.w; }
    const float Dh = GIN(F, IN_SSDD)[c0 >> 6];
    constexpr int U = 4;
    for (int t0 = F.wave * 2 * U; t0 < 512; t0 += 8 * 2 * U) {
        u32x4 a[U], c[U], z[U], x[U];
#pragma unroll
        for (int u = 0; u < U; ++u) { const int row = row0 + t0 + 2 * u + sub;
            a[u] = *(const u32x4*)(OS + (unsigned)(row * 512 + c0) * 2u); c[u] = *(const u32x4*)(OS + (unsigned)((TL + row) * 512 + c0) * 2u);
            z[u] = *(const u32x4*)(P + (unsigned)(row * NP + CZ + c0) * 2u); x[u] = *(const u32x4*)(XBC + (unsigned)(row * 1024 + c0) * 2u); }
#pragma unroll
        for (int u = 0; u < U; ++u) { const int row = row0 + t0 + 2 * u + sub;
            float v[8];
#define SSDV(i, A, C, X, Z) v[i] = (A + C + Dh * X) * silu_f(Z)
            SSDV(0, bflo(a[u].x), bflo(c[u].x), bflo(x[u].x), bflo(z[u].x)); SSDV(1, bfhi(a[u].x), bfhi(c[u].x), bfhi(x[u].x), bfhi(z[u].x));
            SSDV(2, bflo(a[u].y), bflo(c[u].y), bflo(x[u].y), bflo(z[u].y)); SSDV(3, bfhi(a[u].y), bfhi(c[u].y), bfhi(x[u].y), bfhi(z[u].y));
            SSDV(4, bflo(a[u].z), bflo(c[u].z), bflo(x[u].z), bflo(z[u].z)); SSDV(5, bfhi(a[u].z), bfhi(c[u].z), bfhi(x[u].z), bfhi(z[u].z));
            SSDV(6, bflo(a[u].w), bflo(c[u].w), bflo(x[u].w), bflo(z[u].w)); SSDV(7, bfhi(a[u].w), bfhi(c[u].w), bfhi(x[u].w), bfhi(z[u].w));
#undef SSDV
            float ss = 0.f;
#pragma unroll
            for (int i = 0; i < 8; ++i) ss += v[i] * v[i];
            ss += __shfl_xor(ss, 1); ss += __shfl_xor(ss, 2); ss += __shfl_xor(ss, 4); ss += __shfl_xor(ss, 8); ss += __shfl_xor(ss, 16);
            const float rstd = rsqrtf(ss * (1.f / 256.f) + EPS);
            const float rs = rstd * YSCALE8;
            u32x2 w; w.x = pg8::pk4_fp8(v[0] * rs * nw[0], v[1] * rs * nw[1], v[2] * rs * nw[2], v[3] * rs * nw[3]); w.y = pg8::pk4_fp8(v[4] * rs * nw[4], v[5] * rs * nw[5], v[6] * rs * nw[6], v[7] * rs * nw[7]);
            *(u32x2*)(Y + (unsigned)(row * 1024 + 512 + c0)) = w; }
    }
}
__device__ __forceinline__ void ph_scan_c(Ctx& F) {
    const bool deal = (F.G == 256);
    const int first = deal ? (F.bid < 128 ? F.bid : 128 + 2 * (F.bid - 128)) : F.bid;
    const int count = deal ? (F.bid < 128 ? 1 : 2) : (384 - F.bid + F.G - 1) / F.G;
    const int step = deal ? 1 : F.G;
#pragma unroll 1
    for (int k2 = 0; k2 < 2 * count; ++k2) {
        const int pit = first + (k2 >> 1) * step, d = k2 & 1;
        { GAS unsigned char* g = (GAS unsigned char*)F.ws; asm volatile("" : "+s"(g)); F.ws = (unsigned char*)g; }
        if (pit < 128) { const int seg = 1 + (pit & 15); ssd_item<true>(F, (pit >> 4) * 2 + d, d ? 17 - seg : seg); }
        else { const int seg = 1 + ((pit - 128) & 15); gla_item<true>(F, ((pit - 128) >> 4) * 2 + d, d ? 17 - seg : seg); }
        if (d) {
            asm volatile("s_waitcnt vmcnt(0)" ::: "memory"); __syncthreads();
            if (pit < 128) combine_ssd_block(F, pit >> 5, (pit >> 4) & 1, 1 + (pit & 15));
            else combine_gla_block(F, (pit - 128) >> 6, ((pit - 128) >> 4) & 3, 1 + ((pit - 128) & 15));
        }
    }
}

#define UNP(dst, w0, w1) dst[0] = bflo(w0.x); dst[1] = bfhi(w0.x); dst[2] = bflo(w0.y); dst[3] = bfhi(w0.y); dst[4] = bflo(w0.z); dst[5] = bfhi(w0.z); dst[6] = bflo(w0.w); dst[7] = bfhi(w0.w); \
        dst[8] = bflo(w1.x); dst[9] = bfhi(w1.x); dst[10] = bflo(w1.y); dst[11] = bfhi(w1.y); dst[12] = bflo(w1.z); dst[13] = bfhi(w1.z); dst[14] = bflo(w1.w); dst[15] = bfhi(w1.w)
__device__ __forceinline__ void ph_combine(Ctx& F) {
    const bf16_t* P = (const bf16_t*)(F.ws + WS_P); const bf16_t* XBC = (const bf16_t*)(F.ws + WS_XBC);
    const bf16_t* OG = (const bf16_t*)(F.ws + WS_OG); const bf16_t* OS = (const bf16_t*)(F.ws + WS_OS); bf16_t* Y = (bf16_t*)(F.ws + WS_Y);
    const int gw = F.bid * 8 + F.wave, NGW = F.G * 8, l = F.lane;
    const bool gla = l < 32; const int c0 = gla ? 16 * l : 16 * (l - 32);
    float nwv[16]; { const float* nw = gla ? GIN(F, IN_GLANORM) + (c0 & 127) : GIN(F, IN_SSDNORM) + c0;
#pragma unroll
        for (int i = 0; i < 16; ++i) nwv[i] = nw[i]; }
    const float Dh = GIN(F, IN_SSDD)[c0 >> 6];
    constexpr int U = 4;
    for (int r0 = gw * U; r0 < TL; r0 += NGW * U) {
        u32x4 a0[U], a1[U], b0[U], b1[U], g0[U], g1[U], x0[U], x1[U];
#pragma unroll
        for (int u = 0; u < U; ++u) { const int r = r0 + u;
            const bf16_t* o0 = (gla ? OG : OS) + (size_t)r * 512 + c0; const bf16_t* o1 = o0 + (size_t)TL * 512;
            const bf16_t* gz = P + (size_t)r * NP + (gla ? CG : CZ) + c0; const bf16_t* xp = XBC + (size_t)r * 1024 + c0;
            a0[u] = *(const u32x4*)o0; a1[u] = *(const u32x4*)(o0 + 8); b0[u] = *(const u32x4*)o1; b1[u] = *(const u32x4*)(o1 + 8); g0[u] = *(const u32x4*)gz; g1[u] = *(const u32x4*)(gz + 8);
            x0[u] = (u32x4){0u, 0u, 0u, 0u}; x1[u] = x0[u];
            if (!gla) { x0[u] = *(const u32x4*)xp; x1[u] = *(const u32x4*)(xp + 8); } }
#pragma unroll
        for (int u = 0; u < U; ++u) { const int r = r0 + u;
            float v[16], gt[16], t0[16], t1[16], xv[16]; UNP(t0, a0[u], a1[u]); UNP(t1, b0[u], b1[u]); UNP(gt, g0[u], g1[u]); UNP(xv, x0[u], x1[u]);
#pragma unroll
            for (int i = 0; i < 16; ++i) { const float sg = silu_f(gt[i]); v[i] = gla ? (t0[i] + t1[i]) : (t0[i] + t1[i] + Dh * xv[i]) * sg; gt[i] = sg; }
            float ss = 0.f;
#pragma unroll
            for (int i = 0; i < 16; ++i) ss += v[i] * v[i];
            ss += __shfl_xor(ss, 1); ss += __shfl_xor(ss, 2); ss += __shfl_xor(ss, 4);
            const float s8 = __shfl_xor(ss, 8); if (!gla) ss += s8;
            const float rstd = rsqrtf(ss * (gla ? (1.f / 128.f) : (1.f / 256.f)) + EPS);
            float o[16];
#pragma unroll
            for (int i = 0; i < 16; ++i) { float y = v[i] * rstd * nwv[i]; if (gla) y *= gt[i]; o[i] = y; }
            u32x4 w0, w1; w0.x = pk2(o[0], o[1]); w0.y = pk2(o[2], o[3]); w0.z = pk2(o[4], o[5]); w0.w = pk2(o[6], o[7]); w1.x = pk2(o[8], o[9]); w1.y = pk2(o[10], o[11]); w1.z = pk2(o[12], o[13]); w1.w = pk2(o[14], o[15]);
            bf16_t* yp = Y + (size_t)r * 1024 + (gla ? 0 : 512) + c0;
            *(u32x4*)yp = w0; *(u32x4*)(yp + 8) = w1; }
    }
}

constexpr int WRP = 1032;
__device__ __forceinline__ void ph_router(Ctx& F, const XcdBarrier* xb = nullptr, unsigned* sbw = nullptr) {
    const float* mod = (const float*)(F.ws + WS_MOD); unsigned char* H2 = (unsigned char*)(F.ws + WS_H);
    unsigned* ctl = (unsigned*)(F.ws + WS_CTL);
    int* tok_e = (int*)(F.ws + WS_TOKE); int* tok_p = (int*)(F.ws + WS_TOKP); float* tok_g = (float*)(F.ws + WS_TOKG); int* rowtok = (int*)(F.ws + WS_ROWTOK);
    LAS bf16_t* WTh = (LAS bf16_t*)F.lds;
    LAS bf16_t* WTl = WTh + 32 * WRP;
    static_assert(2 * 32 * WRP * 2 <= MISC_OFF, "split router weights fit below the MISC tables");
    LAS int* lcnt = (LAS int*)(F.lds + MISC_OFF);
    LAS int* gbase = lcnt + 32;
    LAS int* rec_e = gbase + 32;
    LAS int* rec_p = rec_e + 512;
    LAS float* biasl = (LAS float*)(rec_p + 512);
    LAS float* rsl = biasl + 32;
    LAS float* wpl = rsl + 128;
    LAS float* shl = wpl + 1024;
    const int l = F.lane, i16 = l & 15, kk = l >> 4, w = F.wave;
    if (F.bid == 0) { for (int i = F.tid; i < 256; i += 512) ((unsigned*)(H2 + (size_t)ZROW * DM))[i] = 0u; }
    int cur_b = -1;
    for (int tile = F.bid; tile < TL / 128; tile += F.G) {
        const int b = (tile * 128) >> 13;
        if (b != cur_b) {
            cur_b = b;
            __syncthreads();
            const float* sh = mod + b * 6144 + 3 * 1024; const float* scl = sh + 1024;
            for (int k = F.tid; k < 1024; k += 512) { wpl[k] = GIN(F, IN_NORM2)[k] * (1.f + scl[k]); shl[k] = sh[k]; }
            if (F.tid < 32) lcnt[F.tid] = 0;
            __syncthreads();
            { float ba = 0.f;
#pragma unroll 16
              for (int j = 0; j < 64; ++j) { const int i = F.tid + 512 * j, k = i >> 5, e = i & 31; const float wr = GIN(F, IN_WR)[i]; const float wv = wr * wpl[k]; ba += shl[k] * wr;
                const unsigned hb = pk2(wv, 0.f) & 0xffffu; const float hi = __builtin_bit_cast(float, hb << 16);
                WTh[e * WRP + k] = (bf16_t)hb; WTl[e * WRP + k] = (bf16_t)(pk2(wv - hi, 0.f) & 0xffffu); }
              LAS float* red = (LAS float*)(rec_e);
              red[(F.tid >> 5) * 32 + (F.tid & 31)] = ba; }
            __syncthreads();
            if (F.tid < 32) { float a = GIN(F, IN_BR)[F.tid];
#pragma unroll
                for (int q = 0; q < 16; ++q) a += ((LAS float*)rec_e)[q * 32 + F.tid];
                biasl[F.tid] = a; }
            __syncthreads();
        }
        if (sbw) { if (F.tid == 0) sb_wait(*xb, sbw); __syncthreads(); sbw = nullptr; }
        const int row = tile * 128 + w * 16 + i16;
        const bf16_t* X1 = (const bf16_t*)(F.ws + WS_X1);
        const bf16_t* xr = X1 + (size_t)row * DM + 8 * kk;
        const LAS bf16_t* wh0 = WTh + i16 * WRP + 8 * kk; const LAS bf16_t* wl0 = WTl + i16 * WRP + 8 * kk;
        f32x4 a0 = (f32x4){0.f, 0.f, 0.f, 0.f}, a1 = a0;
        float rstd_i;
        { const f32x4* sp = (const f32x4*)((const float*)(F.ws + WS_G) + (size_t)row * 16); const f32x4 s0 = sp[0], s1 = sp[1], s2 = sp[2], s3 = sp[3];
          const f32x4 st = (s0 + s1) + (s2 + s3); rstd_i = rsqrtf(((st.x + st.y) + (st.z + st.w)) * (1.f / DM) + EPS); }
        unsigned char* hrow = H2 + (size_t)row * DM + 8 * kk;
#pragma unroll 1
        for (int qh = 0; qh < 32; qh += 16) {
            u32x4 xq[16];
#pragma unroll
            for (int q = 0; q < 16; ++q) xq[q] = *(const u32x4*)(xr + 32 * (qh + q));
#pragma unroll
            for (int q = 0; q < 16; ++q) { const u32x4 xb = xq[q]; const bf16x8 xa = __builtin_bit_cast(bf16x8, xb); const int qq = qh + q;
                const bf16x8 h0 = *(const LAS bf16x8*)(wh0 + 32 * qq), h1 = *(const LAS bf16x8*)(wh0 + 16 * WRP + 32 * qq), l0 = *(const LAS bf16x8*)(wl0 + 32 * qq), l1 = *(const LAS bf16x8*)(wl0 + 16 * WRP + 32 * qq);
                a0 = __builtin_amdgcn_mfma_f32_16x16x32_bf16(xa, h0, a0, 0, 0, 0); a1 = __builtin_amdgcn_mfma_f32_16x16x32_bf16(xa, h1, a1, 0, 0, 0);
                a0 = __builtin_amdgcn_mfma_f32_16x16x32_bf16(xa, l0, a0, 0, 0, 0); a1 = __builtin_amdgcn_mfma_f32_16x16x32_bf16(xa, l1, a1, 0, 0, 0);
                { const int c = 32 * qq + 8 * kk;
                  const f32x4 wa = *(const LAS f32x4*)(wpl + c) * HSCALE8, wb = *(const LAS f32x4*)(wpl + c + 4) * HSCALE8, sa = *(const LAS f32x4*)(shl + c) * HSCALE8, sb = *(const LAS f32x4*)(shl + c + 4) * HSCALE8;
                  const f32x4 va = (f32x4){bflo(xb.x), bfhi(xb.x), bflo(xb.y), bfhi(xb.y)} * rstd_i * wa + sa, vb = (f32x4){bflo(xb.z), bfhi(xb.z), bflo(xb.w), bfhi(xb.w)} * rstd_i * wb + sb;
                  u32x2 o; o.x = pg8::pk4_fp8(va.x, va.y, va.z, va.w); o.y = pg8::pk4_fp8(vb.x, vb.y, vb.z, vb.w);
                  *(u32x2*)(hrow + 32 * qq) = o; } }
        }
        if (kk == 0) rsl[w * 16 + i16] = rstd_i;
        LDS_WAIT(); asm volatile("" ::: "memory");
        const f32x4 rs4 = *(const LAS f32x4*)(rsl + w * 16 + 4 * kk);
        const float bz0 = biasl[i16], bz1 = biasl[16 + i16];
        float v0[4], v1[4];
#pragma unroll
        for (int r = 0; r < 4; ++r) { v0[r] = a0[r] * rs4[r] + bz0; v1[r] = a1[r] * rs4[r] + bz1; }
        int ei[4][4]; float ev[4][4];
#pragma unroll
        for (int k = 0; k < 4; ++k)
#pragma unroll
            for (int r = 0; r < 4; ++r) { float bv = v0[r]; int bi = i16; if (v1[r] > bv) { bv = v1[r]; bi = 16 + i16; }
#pragma unroll
#define TOP_STEP(ctrl) do { const float ov = __builtin_bit_cast(float, __builtin_amdgcn_update_dpp(0, __builtin_bit_cast(int, bv), ctrl, 0xf, 0xf, false)); \
                    const int oi = __builtin_amdgcn_update_dpp(0, bi, ctrl, 0xf, 0xf, false); const bool take = (ov > bv) | ((ov == bv) & (oi < bi)); bv = take ? ov : bv; bi = take ? oi : bi; } while (0)
                TOP_STEP(0xB1); TOP_STEP(0x4E); TOP_STEP(0x141); TOP_STEP(0x140);
#undef TOP_STEP
                ei[k][r] = bi; ev[k][r] = bv; if (bi == i16) v0[r] = -3.3e38f; if (bi == 16 + i16) v1[r] = -3.3e38f; }
        if (i16 == 0) {
#pragma unroll
            for (int r = 0; r < 4; ++r) { const int tl = w * 16 + 4 * kk + r, rr = tile * 128 + tl;
                const float e1 = __expf(ev[1][r] - ev[0][r]), e2 = __expf(ev[2][r] - ev[0][r]), e3 = __expf(ev[3][r] - ev[0][r]); const float inv = 1.f / (1.f + e1 + e2 + e3);
                const float gts[4] = {inv, e1 * inv, e2 * inv, e3 * inv};
#pragma unroll
                for (int k = 0; k < 4; ++k) { const int lp = __hip_atomic_fetch_add(lcnt + ei[k][r], 1, __ATOMIC_RELAXED, __HIP_MEMORY_SCOPE_WORKGROUP);
                    rec_e[tl * 4 + k] = ei[k][r]; rec_p[tl * 4 + k] = lp; tok_g[(size_t)rr * 4 + k] = gts[k]; } }
        }
        __syncthreads();
        if (F.tid < 32) gbase[F.tid] = (int)__hip_atomic_fetch_add(ctl + CW_CNT + 64 * F.tid, (unsigned)lcnt[F.tid], __ATOMIC_RELAXED, __HIP_MEMORY_SCOPE_AGENT);
        __syncthreads();
        { const int tl = F.tid >> 2, r = tile * 128 + tl; const int e = rec_e[F.tid], pos = gbase[e] + rec_p[F.tid];
          tok_e[(size_t)r * 4 + (F.tid & 3)] = e; tok_p[(size_t)r * 4 + (F.tid & 3)] = pos; rowtok[(size_t)e * TL + pos] = r; }
        __syncthreads();
        if (F.tid < 32) lcnt[F.tid] = 0;
        __syncthreads();
    }
}

__device__ __forceinline__ void moe_tables(Ctx& F, LAS int*& cn, LAS int*& tb) {
    const unsigned* ctl = (const unsigned*)(F.ws + WS_CTL);
    cn = (LAS int*)(F.lds + MISC_OFF); tb = cn + 32;
    __syncthreads();
    if (F.tid < 32) cn[F.tid] = (int)__hip_atomic_load(ctl + CW_CNT + 64 * F.tid, __ATOMIC_RELAXED, __HIP_MEMORY_SCOPE_AGENT);
    __syncthreads();
    if (F.tid == 0) { int s = 0; for (int e = 0; e < 32; ++e) { tb[e] = s; s += (cn[e] + 255) >> 8; } tb[32] = s; }
    __syncthreads();
}

__device__ __forceinline__ void ph_final(Ctx& F, float* dst) {
    int lane_ = threadIdx.x & 63; asm volatile("" : "+v"(lane_));
    LAS int* cn; LAS int* tb; moe_tables(F, cn, tb);
    const float* mod = (const float*)(F.ws + WS_MOD); const unsigned char* YP = (const unsigned char*)(F.ws + WS_YP);
    const int* tok_e = (const int*)(F.ws + WS_TOKE); const int* tok_p = (const int*)(F.ws + WS_TOKP); const float* tok_g = (const float*)(F.ws + WS_TOKG);
    const int gw = F.bid * 8 + F.wave, NGW = F.G * 8;
    f32x4 fn[4];
#pragma unroll
    for (int q = 0; q < 4; ++q) fn[q] = *(const f32x4*)(GIN(F, IN_FNORM) + 4 * (lane_ + 64 * q));
    constexpr int U = 2;
    int4 ne[U], np[U]; f32x4 ng[U];
#pragma unroll
    for (int u = 0; u < U; ++u) { const int r = gw * U + u; ne[u] = *(const int4*)(tok_e + (size_t)r * 4); np[u] = *(const int4*)(tok_p + (size_t)r * 4); ng[u] = *(const f32x4*)(tok_g + (size_t)r * 4); }
    for (int r0 = gw * U; r0 < TL; r0 += NGW * U) {
        const unsigned char* yr[U][4]; float gt[U][4];
#pragma unroll
        for (int u = 0; u < U; ++u) { const int4 e4 = ne[u], p4 = np[u]; const f32x4 g4 = ng[u];
            yr[u][0] = YP + ((size_t)tb[e4.x] * 256 + p4.x) * DM; yr[u][1] = YP + ((size_t)tb[e4.y] * 256 + p4.y) * DM; yr[u][2] = YP + ((size_t)tb[e4.z] * 256 + p4.z) * DM; yr[u][3] = YP + ((size_t)tb[e4.w] * 256 + p4.w) * DM;
            gt[u][0] = g4.x * (1.0f / PSCALE8); gt[u][1] = g4.y * (1.0f / PSCALE8); gt[u][2] = g4.z * (1.0f / PSCALE8); gt[u][3] = g4.w * (1.0f / PSCALE8); }
        unsigned yw[U][4][4]; f32x4 xv[U][4];
        if (r0 + NGW * U < TL) {
#pragma unroll
            for (int u = 0; u < U; ++u) { const int r = r0 + NGW * U + u; ne[u] = *(const int4*)(tok_e + (size_t)r * 4); np[u] = *(const int4*)(tok_p + (size_t)r * 4); ng[u] = *(const f32x4*)(tok_g + (size_t)r * 4); } }
#pragma unroll
        for (int u = 0; u < U; ++u) {
#pragma unroll
            for (int k = 0; k < 4; ++k)
#pragma unroll
                for (int q = 0; q < 4; ++q) yw[u][k][q] = *(const unsigned*)(yr[u][k] + 4 * (lane_ + 64 * q));
#pragma unroll
            for (int q = 0; q < 4; ++q) { const u32x2 xb = ((const u32x2*)((const bf16_t*)(F.ws + WS_X1) + (size_t)(r0 + u) * DM))[lane_ + 64 * q]; xv[u][q] = (f32x4){bflo(xb.x), bfhi(xb.x), bflo(xb.y), bfhi(xb.y)}; } }
#pragma unroll
        for (int u = 0; u < U; ++u) { const int r = r0 + u; const int b = r >> 13; const float* g2 = mod + b * 6144 + 5 * 1024;
            f32x4 v[4]; float ss = 0.f;
#pragma unroll
            for (int q = 0; q < 4; ++q) { f32x4 m = (f32x4){0.f, 0.f, 0.f, 0.f};
#pragma unroll
                for (int k = 0; k < 4; ++k) { const unsigned w = yw[u][k][q]; const f32x2 lo = __builtin_amdgcn_cvt_pk_f32_fp8((int)w, false), hi = __builtin_amdgcn_cvt_pk_f32_fp8((int)w, true); m += (f32x4){lo.x, lo.y, hi.x, hi.y} * gt[u][k]; }
                v[q] = xv[u][q] + *(const f32x4*)(g2 + 4 * (lane_ + 64 * q)) * m;
                ss += (v[q].x * v[q].x + v[q].y * v[q].y) + (v[q].z * v[q].z + v[q].w * v[q].w); }
            const float rstd = rsqrtf(wave_sum(ss) * (1.f / DM) + EPS);
#pragma unroll
            for (int q = 0; q < 4; ++q) ((f32x4*)(dst + (size_t)r * DM))[lane_ + 64 * q] = v[q] * rstd * fn[q]; }
    }
}

__device__ __forceinline__ void inproj_skinny(Ctx& F, int pm) {
    constexpr int WP = 1032;
    LAS bf16_t* Wl = (LAS bf16_t*)F.lds;
    const bf16_t* WinT = (const bf16_t*)(F.ws + WS_WIN) + (size_t)3072 * 1024;
    for (int i = F.tid; i < 32 * 128; i += 512) { const int n = i >> 7, c = i & 127; *(LAS u32x4*)(Wl + n * WP + c * 8) = *(const u32x4*)(WinT + (size_t)n * 1024 + c * 8); }
    __syncthreads();
    int l = F.lane; asm volatile("" : "+v"(l));
    const int i16 = l & 15, kk = l >> 4, w = F.wave;
    const int r0 = pm * 256 + 32 * w;
    const bf16_t* a0p = (const bf16_t*)(F.ws + WS_H) + (size_t)(r0 + i16) * DM + 8 * kk; const bf16_t* a1p = a0p + (size_t)16 * DM;
    const LAS bf16_t* b0p = Wl + i16 * WP + 8 * kk; const LAS bf16_t* b1p = b0p + 16 * WP;
    f32x4 acc[2][2];
#pragma unroll
    for (int t = 0; t < 2; ++t)
#pragma unroll
        for (int nt = 0; nt < 2; ++nt) acc[t][nt] = (f32x4){0.f, 0.f, 0.f, 0.f};
#pragma unroll 1
    for (int sh = 0; sh < 32; sh += 8) {
        u32x4 xa[8], xb[8];
#pragma unroll
        for (int q = 0; q < 8; ++q) { xa[q] = *(const u32x4*)(a0p + 32 * (sh + q)); xb[q] = *(const u32x4*)(a1p + 32 * (sh + q)); }
#pragma unroll
        for (int q = 0; q < 8; ++q) { const bf16x8 h0 = *(const LAS bf16x8*)(b0p + 32 * (sh + q)), h1 = *(const LAS bf16x8*)(b1p + 32 * (sh + q));
            const bf16x8 fa = __builtin_bit_cast(bf16x8, xa[q]), fb = __builtin_bit_cast(bf16x8, xb[q]);
            acc[0][0] = mfma16(fa, h0, acc[0][0]); acc[0][1] = mfma16(fa, h1, acc[0][1]); acc[1][0] = mfma16(fb, h0, acc[1][0]); acc[1][1] = mfma16(fb, h1, acc[1][1]); }
    }
    bf16_t* P = (bf16_t*)(F.ws + WS_P);
#pragma unroll
    for (int t = 0; t < 2; ++t)
#pragma unroll
        for (int nt = 0; nt < 2; ++nt)
#pragma unroll
            for (int r = 0; r < 4; ++r) P[(size_t)(r0 + 16 * t + 4 * kk + r) * NP + 3072 + 16 * nt + i16] = (bf16_t)(pk2(acc[t][nt][r], 0.f) & 0xffffu);
    __syncthreads();
}

constexpr int NPHASE = 13;
__global__ void __launch_bounds__(512, 2) mega(Params p) {
    extern __shared__ __attribute__((aligned(16))) unsigned char lds_raw[];
    Ctx F;
    F.lds = (LAS unsigned char*)lds_raw; F.tid = threadIdx.x; F.lane = F.tid & 63; F.wave = __builtin_amdgcn_readfirstlane(F.tid >> 6); F.bid = blockIdx.x; F.G = gridDim.x;
    F.in = p.in; F.out = (float*)(GAS float*)p.out; F.ws = (unsigned char*)(GAS unsigned char*)p.ws;
    const int lo = p.ph_lo, hi = p.ph_hi;
#ifndef PH_MASK
#define PH_MASK 0x1fff
#endif
#define IN(k) (((PH_MASK >> (k)) & 1) && lo <= (k) && (k) < hi)
#ifndef PH_REP
#define PH_REP 0
#endif
#ifndef XBAR_EXTRA
#define XBAR_EXTRA 0
#endif
#define REPS(k) (1 + ((PH_REP >> (k)) & 1))
#define RUN(k, ...) do { if (IN(k)) { if (REPS(k) > 1) { const int _rep = 0; __VA_ARGS__; __syncthreads(); } { const int _rep = REPS(k) - 1; __VA_ARGS__; } } } while (0)
#define RUN1(k, ...) do { if (IN(k)) { __VA_ARGS__; } } while (0)
#if MK_FUSED
    volatile LAS unsigned* bst = (volatile LAS unsigned*)(F.lds + LDS_BYTES - 64);
    if (F.tid < 16) bst[F.tid] = 0u;
    __syncthreads();
    XcdBarrier bar = xcd_barrier_post((unsigned*)(F.ws + WS_CTL) + CW_BAR, bst);
#define SEAM(k) do { if (IN(k) && IN((k) + 1)) { xcd_barrier(bar); } } while (0)
#else
#define SEAM(k) do { } while (0)
#endif
#if MK_FUSED
    RUN1(0, { unsigned* sbm = (unsigned*)(F.ws + WS_CTL) + CW_SB + 2 * 2048;
        ph_prologue(F, 1); asm volatile("s_waitcnt vmcnt(0)" ::: "memory"); __syncthreads(); if (F.tid == 0) sb_arrive(bar, sbm);
        ph_prologue(F, 2);
        if (IN(1)) { if (F.tid == 0) sb_wait(bar, sbm); __syncthreads(); } });
#else
    RUN(0, ph_prologue(F)); SEAM(0);
#endif
    RUN(1, ph_norm1(F)); SEAM(1);
#if MK_FUSED
    for (int _x = 0; _x < XBAR_EXTRA; ++_x) xcd_barrier(bar);
#endif
    RUN1(2, {
        constexpr int NCT = NP / 256 - 1;
        constexpr int NSETS = (NEXP * 8 * 64 + NEXP * 8 * 32) / 8, NTILE = (TT / 256) * NCT, CPT = 8;
        const int c_hi = NTILE % F.G == 0 ? F.G : NTILE % F.G;
        const int n_lo = (NSETS - CPT * (F.G - c_hi) + F.G - 1) / F.G < 0 ? 0 : (NSETS - CPT * (F.G - c_hi) + F.G - 1) / F.G, n_hi = n_lo + CPT;
        const int grp = (F.bid >> 3) & 7, cut = __builtin_amdgcn_readfirstlane(grp == 7 ? (1 << 20) : grp);
        _Pragma("unroll 1") for (int part = 0; part < 2; ++part) {
            if (part) { __syncthreads(); expert_weight_copies(F, c_hi, n_lo, n_hi); __syncthreads(); }
            const pg8::DenseOrder S{TT / 256, NCT, F.G, F.bid, (const char*)(F.ws + WS_WIN), 2048u, 1, part ? cut : 0, part ? (1 << 20) : cut};
            const pg8::EpiBf16 E{(bf16_t*)(F.ws + WS_P), NP, nullptr, 0, 1.0f};
            pg8::gemm_phase<pg8::EpiBf16, pg8::DenseOrder, true>(F.lds, (const bf16_t*)(F.ws + WS_H), S, E);
        }
        __syncthreads();
        for (int pm = F.bid - c_hi; pm < TT / 256; pm += F.G) if (pm >= 0) inproj_skinny(F, pm);
    }); SEAM(2);
#if MK_FUSED && !MK_NAIVE_SCAN
    RUN1(3, { ph_conv_g(F); asm volatile("s_waitcnt vmcnt(0)" ::: "memory"); __syncthreads(); if (F.tid == 0) sb_arrive(bar, (unsigned*)(F.ws + WS_CTL) + CW_SB + 3 * 2048); });
#else
    RUN(3, ph_conv_g(F)); SEAM(3);
#endif
#if MK_NAIVE_SCAN
    RUN(4, ph_scan_naive(F)); SEAM(4); SEAM(5);
#else
#if MK_FUSED
    RUN1(4, { ph_scan_a(F, 1); if (F.tid == 0) sb_wait(bar, (unsigned*)(F.ws + WS_CTL) + CW_SB + 3 * 2048); __syncthreads(); ph_scan_a(F, 2); }); SEAM(4);
#else
    RUN(4, ph_scan_a(F)); SEAM(4);
#endif
    RUN(5, ph_scan_b(F)); SEAM(5);
    RUN(6, ph_scan_c(F));
#endif
    SEAM(6);
    RUN1(8, {
        pg8::DenseOrder S{TL / 256, DM / 256, F.G, F.bid, (const char*)(F.ws + WS_WOUT), 1024u, REPS(8)};
        pg8::EpiResGate E{GIN(F, IN_X), (bf16_t*)(F.ws + WS_X1), (const float*)(F.ws + WS_MOD), 1.0f / (YSCALE8 * WSCALE8), (float*)(F.ws + WS_G)};
        pg8::gemm_phase<pg8::EpiResGate, pg8::DenseOrder, true, true>(F.lds, (const bf16_t*)(F.ws + WS_Y), S, E);
#if MK_FUSED
        if (IN(9) && F.tid == 0) sb_arrive(bar, (unsigned*)(F.ws + WS_CTL) + CW_SB + 4 * 2048);
    });
#else
    }); SEAM(8);
#endif
#if MK_FUSED
    RUN1(9, ph_router(F, &bar, (unsigned*)(F.ws + WS_CTL) + CW_SB + 4 * 2048)); SEAM(9);
#else
    RUN(9, ph_router(F)); SEAM(9);
#endif
#if MK_FUSED
    RUN1(10, {
        LAS int* cn; LAS int* tb; moe_tables(F, cn, tb);
        const int nMt = __builtin_amdgcn_readfirstlane(tb[32]);
        unsigned* sb1 = (unsigned*)(F.ws + WS_CTL) + CW_SB; unsigned* sb2 = sb1 + 2048;
        int a1;
        {   pg8::MoeOrder<true> S{nMt, 8, F.G, F.bid, (const char*)(F.ws + WS_WGU), 2048, tb, cn, (const int*)(F.ws + WS_ROWTOK), 1024u, 0};
            pg8::EpiSwiglu E{(unsigned char*)(F.ws + WS_ACT), GIN(F, IN_BGU), 1.0f / (HSCALE8 * WSCALE8), ASCALE8, (LAS float*)(F.lds + MISC_OFF + 2048)};
            a1 = (S.trips() * 3) / 4; a1 = a1 < 1 ? 1 : a1;
            ArriveSync Y{&bar, sb1, a1, false};
            pg8::gemm_phase<pg8::EpiSwiglu, pg8::MoeOrder<true>, true, true, ArriveSync>(F.lds, (const bf16_t*)(F.ws + WS_H), S, E, &Y);
            if (F.tid == 0) { if (!Y.done) sb_arrive(bar, sb1); sb_arrive(bar, sb2); }
        }
        if (IN(11)) {
            if (F.tid == 0) sb_wait(bar, sb1);
            __syncthreads();
            pg8::MoeOrder<false> S{nMt, 4, F.G, F.bid, (const char*)(F.ws + WS_WD), 1024, tb, cn, nullptr, 1024u, 8};
            pg8::EpiFp8 E{(unsigned char*)(F.ws + WS_YP), DM, GIN(F, IN_BD), 1024, 1.0f / (ASCALE8 * WSCALE8), PSCALE8, (LAS float*)(F.lds + MISC_OFF + 2048)};
            WaitSync<pg8::MoeOrder<false>> Y{&bar, sb2, a1, false, &S, 8};
            pg8::gemm_phase<pg8::EpiFp8, pg8::MoeOrder<false>, true, true, WaitSync<pg8::MoeOrder<false>>>(F.lds, (const bf16_t*)(F.ws + WS_ACT), S, E, &Y);
        }
    }); SEAM(11);
#else
    RUN1(10, {
        LAS int* cn; LAS int* tb; moe_tables(F, cn, tb);
        pg8::MoeOrder<true> S{__builtin_amdgcn_readfirstlane(tb[32]), 8, F.G, F.bid, (const char*)(F.ws + WS_WGU), 2048, tb, cn, (const int*)(F.ws + WS_ROWTOK), 1024u, 0};
        pg8::EpiSwiglu E{(unsigned char*)(F.ws + WS_ACT), GIN(F, IN_BGU), 1.0f / (HSCALE8 * WSCALE8), ASCALE8, (LAS float*)(F.lds + MISC_OFF + 2048)};
        pg8::gemm_phase<pg8::EpiSwiglu, pg8::MoeOrder<true>, true, true>(F.lds, (const bf16_t*)(F.ws + WS_H), S, E);
    });
    RUN1(11, {
        LAS int* cn; LAS int* tb; moe_tables(F, cn, tb);
        pg8::MoeOrder<false> S{__builtin_amdgcn_readfirstlane(tb[32]), 4, F.G, F.bid, (const char*)(F.ws + WS_WD), 1024, tb, cn, nullptr, 1024u, 0};
        pg8::EpiFp8 E{(unsigned char*)(F.ws + WS_YP), DM, GIN(F, IN_BD), 1024, 1.0f / (ASCALE8 * WSCALE8), PSCALE8, (LAS float*)(F.lds + MISC_OFF + 2048)};
        pg8::gemm_phase<pg8::EpiFp8, pg8::MoeOrder<false>, true, true>(F.lds, (const bf16_t*)(F.ws + WS_ACT), S, E);
    });
#endif
    RUN(12, ph_final(F, (_rep + 1 < REPS(12)) ? (float*)(F.ws + WS_ACT) : F.out));
#undef IN
#undef SEAM
#undef RUN
#undef RUN1
}

extern "C" void kernel_launch(void* const* d_in, const int* in_sizes, int n_in, void* d_out, int out_size, void* d_ws, size_t ws_size, hipStream_t stream) {
    static int grid = 0;
    if (grid == 0) {
        if (n_in != 26 || out_size != TL * DM || ws_size < WS_END) { fprintf(stderr, "kernel_launch: unexpected problem (n_in %d, out %d, ws %zu)\n", n_in, out_size, ws_size); grid = -1; return; }
        int dev = 0, cus = 0, per_cu = 0;
        if (hipGetDevice(&dev) != hipSuccess || hipDeviceGetAttribute(&cus, hipDeviceAttributeMultiprocessorCount, dev) != hipSuccess) { grid = -1; return; }
        if (hipFuncSetAttribute((const void*)mega, hipFuncAttributeMaxDynamicSharedMemorySize, LDS_BYTES) != hipSuccess) { fprintf(stderr, "kernel_launch: hipFuncSetAttribute failed\n"); grid = -1; return; }
        if (hipOccupancyMaxActiveBlocksPerMultiprocessor(&per_cu, (const void*)mega, 512, LDS_BYTES) != hipSuccess || per_cu < 1) { fprintf(stderr, "kernel_launch: occupancy query says %d\n", per_cu); per_cu = 1; }
        (void)hipGetLastError();
        grid = cus;
    }
    if (grid < 0) return;
    (void)hipMemsetAsync((char*)d_ws + WS_CTL, 0, CTL_ZERO, stream);
    Params a{};
    for (int i = 0; i < 26; ++i) a.in[i] = (const float*)d_in[i];
    a.out = (float*)d_out; a.ws = (unsigned char*)d_ws;
#if MK_FUSED
    a.ph_lo = 0; a.ph_hi = NPHASE;
    hipLaunchKernelGGL(mega, dim3(grid), dim3(512), LDS_BYTES, stream, a);
#else
    for (int ph = 0; ph < NPHASE; ++ph) {
        a.ph_lo = ph; a.ph_hi = ph + 1;
        hipLaunchKernelGGL(mega, dim3(grid), dim3(512), LDS_BYTES, stream, a);
    }
#endif
}
```
